# Optimizing an MI355X kernel written in HIP

```python
import math
import jax, jax.numpy as jnp
from jax import lax
import numpy as np

D_MODEL = 1024
BATCH = 32
SEQ = 2048
DEPTH = 2

HEAD_DIM = 64
D_MIX = D_MODEL
SSM_GROUP = 16
SSM_WIDTH = D_MIX // 4
SSM_GROUPS = SSM_WIDTH // SSM_GROUP
SSM_STATE = 64
DSA_HEADS = (D_MIX - SSM_WIDTH) // (2 * HEAD_DIM)
FOX_HEADS = DSA_HEADS
DSA_WIDTH = DSA_HEADS * HEAD_DIM
FOX_WIDTH = FOX_HEADS * HEAD_DIM
DSA_PATTERNS = ((128, 1), (512, 4), (2048, 16))
DSA_BLOCK = 128
FOX_BLOCK = 128
D_FF = ((8 * D_MODEL // 3 + 255) // 256) * 256
IN_SIZES = (SSM_WIDTH, 3 * DSA_WIDTH, 3 * FOX_WIDTH, FOX_HEADS)
N_IN = sum(IN_SIZES)
RMS_EPS = 1e-6

kernel_name = 'hybrid_s5_dilated_fox_block'


def rms_norm(x, g):
    xf = x.astype(jnp.float32)
    y = xf * lax.rsqrt(jnp.mean(xf * xf, axis=-1, keepdims=True) + RMS_EPS)
    return (y * g.astype(jnp.float32)).astype(x.dtype)


def _complex_affine_combine(e1, e2):
    a1r, a1i, b1r, b1i = e1
    a2r, a2i, b2r, b2i = e2
    ar = a2r * a1r - a2i * a1i
    ai = a2r * a1i + a2i * a1r
    br = a2r * b1r - a2i * b1i + b2r
    bi = a2r * b1i + a2i * b1r + b2i
    return (ar, ai, br, bi)


def s5_mixer(u, log_dt, a_re, a_im, b_re, b_im, c_re, c_im, d_skip, w_glu, b_glu):
    bsz, seq, _ = u.shape
    dtype = u.dtype
    f32 = jnp.float32
    dt = jnp.exp(log_dt.astype(f32))[:, None]
    ar, ai = a_re.astype(f32), a_im.astype(f32)
    decay = jnp.exp(ar * dt)
    abar_re = decay * jnp.cos(ai * dt)
    abar_im = decay * jnp.sin(ai * dt)
    mag2 = ar * ar + ai * ai
    coef_re = ((abar_re - 1.0) * ar + abar_im * ai) / mag2
    coef_im = (abar_im * ar - (abar_re - 1.0) * ai) / mag2
    br, bi = b_re.astype(f32), b_im.astype(f32)
    bbar_re = coef_re[..., None] * br - coef_im[..., None] * bi
    bbar_im = coef_re[..., None] * bi + coef_im[..., None] * br
    ug = u.reshape(bsz, seq, SSM_GROUPS, SSM_GROUP)
    x_re = jnp.einsum('bsgc,gpc->sbgp', ug, bbar_re.astype(dtype))
    x_im = jnp.einsum('bsgc,gpc->sbgp', ug, bbar_im.astype(dtype))
    shape = x_re.shape
    elems = (jnp.broadcast_to(abar_re.astype(dtype), shape),
             jnp.broadcast_to(abar_im.astype(dtype), shape), x_re, x_im)
    _, _, h_re, h_im = lax.associative_scan(_complex_affine_combine, elems, axis=0)
    y = (jnp.einsum('sbgp,gcp->bsgc', h_re, c_re)
         - jnp.einsum('sbgp,gcp->bsgc', h_im, c_im))
    y = y.reshape(bsz, seq, SSM_WIDTH) + d_skip * u
    g = jax.nn.gelu(y)
    return g * jax.nn.sigmoid(g @ w_glu + b_glu)


def dilated_window_branch(q, k, v, window, dilation):
    bsz, seq, nh, dh = q.shape
    span = window // dilation
    blk = DSA_BLOCK
    length = seq // dilation
    nb = -(-length // blk)
    lp = nb * blk

    def to_strided(t):
        t = t.reshape(bsz, length, dilation, nh, dh)
        return jnp.pad(t, ((0, 0), (0, lp - length), (0, 0), (0, 0), (0, 0)))

    def key_blocks(t):
        t = jnp.pad(to_strided(t), ((0, 0), (blk, 0), (0, 0), (0, 0), (0, 0)))
        t = t.reshape(bsz, nb + 1, blk, dilation, nh, dh)
        return jnp.concatenate([t[:, :-1], t[:, 1:]], axis=2)

    qs = to_strided(q).reshape(bsz, nb, blk, dilation, nh, dh)
    ks, vs = key_blocks(k), key_blocks(v)
    s = jnp.einsum('bnqrhd,bnkrhd->bnrhqk', qs, ks).astype(jnp.float32)
    qi = jnp.arange(blk)[:, None]
    ki = jnp.arange(2 * blk)[None, :]
    dist = blk + qi - ki
    key_row = (jnp.arange(nb) * blk - blk)[:, None, None] + ki[None]
    valid = (dist >= 0) & (dist <= span) & (key_row >= 0)
    s = jnp.where(valid[None, :, None, None], s, -jnp.inf)
    m = jnp.max(s, axis=-1, keepdims=True)
    p = jnp.exp(s - m)
    den = jnp.sum(p, axis=-1, keepdims=True)
    o = jnp.einsum('bnrhqk,bnkrhd->bnqrhd', (p / den).astype(v.dtype), vs)
    lse = (m + jnp.log(den))[..., 0]
    o = o.reshape(bsz, lp, dilation, nh, dh)[:, :length].reshape(bsz, seq, nh, dh)
    lse = lse.transpose(0, 1, 4, 2, 3).reshape(bsz, lp, dilation, nh)[:, :length]
    return o, lse.reshape(bsz, seq, nh)


def dilated_attention(q, k, v):
    results = [dilated_window_branch(q, k, v, w, d) for (w, d) in DSA_PATTERNS]
    outs = jnp.stack([r[0] for r in results], axis=0)
    lses = jnp.stack([r[1] for r in results], axis=0)
    wts = jax.nn.softmax(lses, axis=0).astype(q.dtype)
    return jnp.einsum('pbsh,pbshd->bshd', wts, outs)


def forgetting_attention(q, k, v, log_f):
    bsz, seq, nh, dh = q.shape
    cum = jnp.cumsum(log_f, axis=1).transpose(0, 2, 1)
    outs = []
    for i in range(seq // FOX_BLOCK):
        q0, q1 = i * FOX_BLOCK, (i + 1) * FOX_BLOCK
        s = jnp.einsum('bqhd,bkhd->bhqk', q[:, q0:q1], k[:, :q1]).astype(jnp.float32)
        bias = cum[:, :, q0:q1, None] - cum[:, :, None, :q1]
        causal = jnp.arange(q0, q1)[:, None] >= jnp.arange(q1)[None, :]
        p = jax.nn.softmax(jnp.where(causal, s + bias, -jnp.inf), axis=-1)
        outs.append(jnp.einsum('bhqk,bkhd->bqhd', p.astype(v.dtype), v[:, :q1]))
    return jnp.concatenate(outs, axis=1)


def setup_inputs(seed: int = 0) -> dict:
    key = jax.random.key(seed)
    ks = jax.random.split(key, 24)
    f32 = jnp.float32
    L, D, G, P, C = DEPTH, D_MODEL, SSM_GROUPS, SSM_STATE, SSM_GROUP

    def nrm(k, shape, scale):
        return jax.random.normal(k, shape, f32) * scale

    def gain(k, shape):
        return 1.0 + 0.02 * jax.random.normal(k, shape, f32)

    n_idx = jnp.arange(P, dtype=f32)
    return {
        'x': jax.random.normal(ks[0], (BATCH, SEQ, D), f32),
        'g_pre_mix': gain(ks[1], (L, D)),
        'w_in': nrm(ks[2], (L, D, N_IN), D ** -0.5),
        'b_f': 1.0 + 3.0 * jax.random.uniform(ks[3], (L, FOX_HEADS), f32),
        'ssm_log_dt': jax.random.uniform(ks[4], (L, G), f32, math.log(1e-3), math.log(1e-1)),
        'ssm_a_re': -0.5 + 0.01 * jax.random.normal(ks[5], (L, G, P), f32),
        'ssm_a_im': math.pi * n_idx + 0.01 * jax.random.normal(ks[6], (L, G, P), f32),
        'ssm_b_re': nrm(ks[7], (L, G, P, C), (2 * C) ** -0.5),
        'ssm_b_im': nrm(ks[8], (L, G, P, C), (2 * C) ** -0.5),
        'ssm_c_re': nrm(ks[9], (L, G, C, P), (2 * P) ** -0.5),
        'ssm_c_im': nrm(ks[10], (L, G, C, P), (2 * P) ** -0.5),
        'ssm_d': nrm(ks[11], (L, SSM_WIDTH), 1.0),
        'w_glu': nrm(ks[12], (L, SSM_WIDTH, SSM_WIDTH), SSM_WIDTH ** -0.5),
        'b_glu': nrm(ks[13], (L, SSM_WIDTH), 0.01),
        'g_mix': gain(ks[14], (L, D_MIX)),
        'w_out': nrm(ks[15], (L, D_MIX, D), D_MIX ** -0.5),
        'g_post_mix': gain(ks[16], (L, D)),
        'g_pre_ffn': gain(ks[17], (L, D)),
        'w_gate_up': nrm(ks[18], (L, D, 2 * D_FF), D ** -0.5),
        'w_down': nrm(ks[19], (L, D_FF, D), D_FF ** -0.5),
        'g_post_ffn': gain(ks[20], (L, D)),
    }


def reference(x, g_pre_mix, w_in, b_f, ssm_log_dt, ssm_a_re, ssm_a_im, ssm_b_re, ssm_b_im,
              ssm_c_re, ssm_c_im, ssm_d, w_glu, b_glu, g_mix, w_out, g_post_mix,
              g_pre_ffn, w_gate_up, w_down, g_post_ffn):
    bsz, seq, _ = x.shape
    scale = HEAD_DIM ** -0.5
    offsets = [int(o) for o in np.cumsum(IN_SIZES)[:-1]]
    for l in range(DEPTH):
        h = rms_norm(x, g_pre_mix[l])
        proj = h @ w_in[l]
        u_ssm, qkv_dsa, qkv_fox, f_logit = jnp.split(proj, offsets, axis=-1)

        y_ssm = s5_mixer(u_ssm, ssm_log_dt[l], ssm_a_re[l], ssm_a_im[l], ssm_b_re[l],
                         ssm_b_im[l], ssm_c_re[l], ssm_c_im[l], ssm_d[l], w_glu[l], b_glu[l])

        qkv_dsa = qkv_dsa.reshape(bsz, seq, 3, DSA_HEADS, HEAD_DIM)
        y_dsa = dilated_attention(qkv_dsa[:, :, 0] * scale, qkv_dsa[:, :, 1], qkv_dsa[:, :, 2])

        qkv_fox = qkv_fox.reshape(bsz, seq, 3, FOX_HEADS, HEAD_DIM)
        log_f = jax.nn.log_sigmoid((f_logit + b_f[l]).astype(jnp.float32))
        y_fox = forgetting_attention(qkv_fox[:, :, 0] * scale, qkv_fox[:, :, 1],
                                     qkv_fox[:, :, 2], log_f)

        gm = g_mix[l]
        mixed = jnp.concatenate([
            rms_norm(y_ssm, gm[:SSM_WIDTH]),
            rms_norm(y_dsa.reshape(bsz, seq, DSA_WIDTH), gm[SSM_WIDTH:SSM_WIDTH + DSA_WIDTH]),
            rms_norm(y_fox.reshape(bsz, seq, FOX_WIDTH), gm[SSM_WIDTH + DSA_WIDTH:]),
        ], axis=-1)
        x = x + rms_norm(mixed @ w_out[l], g_post_mix[l])

        h = rms_norm(x, g_pre_ffn[l])
        gate, up = jnp.split(h @ w_gate_up[l], 2, axis=-1)
        x = x + rms_norm((jax.nn.silu(gate) * up) @ w_down[l], g_post_ffn[l])
    return x
```

```cpp
#define MEGA 1
#include <hip/hip_runtime.h>
#include <hip/hip_cooperative_groups.h>
#include <cstdio>
#include <cstdint>
namespace cg = cooperative_groups;
namespace pg8 {
#define PG8_LAS __attribute__((address_space(3)))
typedef unsigned short bf16_t;
typedef short bf16x8 __attribute__((ext_vector_type(8)));
typedef float f32x4 __attribute__((ext_vector_type(4)));
typedef unsigned u32x4 __attribute__((ext_vector_type(4)));
constexpr int BM = 256, BK = 64, HALF = 128, HTB = HALF * BK * 2  , STAGE_BYTES = 8 * HTB, NXCD = 8, WGM = 8;

__host__ __device__ __forceinline__ int lds_byte(int r, int c) { const int st = (r >> 4) * 2 + (c >> 5), rr = r & 15, cc = c & 31, ob = rr * 64 + cc * 2; return st * 1024 + (ob ^ (((ob >> 9) & 1) << 5)); }
__host__ __device__ __forceinline__ void stage_rc(int b, int& R, int& C) { const int st = b / 1024, sb = b % 1024, swz = sb ^ (((sb >> 9) & 1) << 5); R = (st >> 1) * 16 + swz / 64; C = (st & 1) * 32 + (swz % 64) / 2; }
__host__ __device__ __forceinline__ int perm32(int rho) { const int n = rho >> 4, i = rho & 15; return 8 * (i >> 2) + 4 * n + (i & 3); }

struct Unit { int pm, pn; };
struct Gemm { const bf16_t* A; const bf16_t* Bt; int M, N, K; };

struct StaticOrder {
    int nM, nN, nwg, G, c;
    __host__ __device__ void init(int M, int N, int G_, int c_) { nM = M / BM; nN = N / BM; nwg = nM * nN; G = G_; c = c_; }
    __host__ __device__ bool next(int i, Unit& u) const {
        const long L = (long)i * G + c; if (L >= nwg) return false;
        int wgid = (int)L; { const int q = nwg / NXCD, r = nwg % NXCD, xcd = wgid % NXCD, off = wgid / NXCD; wgid = (xcd < r ? xcd * (q + 1) : r * (q + 1) + (xcd - r) * q) + off; }
        const int nig = WGM * nN, gid = wgid / nig, fm = gid * WGM, gsz = (nM - fm) < WGM ? (nM - fm) : WGM;
        u.pm = fm + ((wgid % nig) % gsz); u.pn = (wgid % nig) / gsz; return true;
    }
    __device__ __forceinline__ void a_ready(const Unit&) const {}
    __device__ __forceinline__ void done(const Unit&) const {}
};

__device__ __forceinline__ unsigned cvt_pk_bf16(float lo, float hi) { unsigned r; asm volatile("v_cvt_pk_bf16_f32 %0, %1, %2" : "=v"(r) : "v"(lo), "v"(hi)); return r; }
typedef float f32x2 __attribute__((ext_vector_type(2)));
__device__ __forceinline__ f32x2 gelu_pk(f32x2 v) {
    const f32x2 av = __builtin_elementwise_abs(v), d = av * 0.2316418882f + 1.0f;
    f32x2 t; t.x = __builtin_amdgcn_rcpf(d.x); t.y = __builtin_amdgcn_rcpf(d.y);
    f32x2 q = t * 0.5307027145f + (-0.7265760135f); q = q * t + 0.7107068705f; q = q * t + (-0.142248368f); q = q * t + 0.127414796f; q = q * t;
    const f32x2 s = (v * v) * (-0.72134752044f);
    f32x2 e; e.x = __builtin_amdgcn_exp2f(s.x); e.y = __builtin_amdgcn_exp2f(s.y);
    const f32x2 m = v * (q * e), r = v - m;
    f32x2 o; o.x = v.x < 0.f ? m.x : r.x; o.y = v.y < 0.f ? m.y : r.y; return o;
}

template <int ACT  > struct EpiBf16 {
    static constexpr bool PERM = true, AFTER_DRAIN = false; static_assert(ACT == 0 || ACT == 1, "EpiBf16: ACT is 0 (none) or 1 (gelu_pk)");
    bf16_t* O; int ldc; const float* bias; int split_cols; size_t split_stride; float scale0;
    __device__ __forceinline__ void operator()(const f32x4 (&acc)[2][2][4][2], const Unit& u, int wr, int wc, int fr, int fq) const {
        const int row0 = u.pm * BM + wr * 64 + fr; int colt = u.pn * BM; bf16_t* base = O;
        float sc = 1.f; if (split_cols) { const int t = colt / split_cols; base += (size_t)t * split_stride; colt -= t * split_cols; if (t == 0) sc = scale0; }
        const int col0 = colt + wc * 32 + 8 * fq, bcol0 = u.pn * BM + wc * 32 + 8 * fq;
        f32x4 bv[2][2];
#pragma unroll
        for (int bj = 0; bj < 2; ++bj)
#pragma unroll
            for (int n = 0; n < 2; ++n) bv[bj][n] = bias ? *(const f32x4*)(bias + bcol0 + bj * HALF + 4 * n) : (f32x4){0.f, 0.f, 0.f, 0.f};
#pragma unroll
        for (int ai = 0; ai < 2; ++ai)
#pragma unroll
            for (int m = 0; m < 4; ++m) { bf16_t* rowp = base + (size_t)(row0 + ai * HALF + m * 16) * ldc + col0;
#pragma unroll
                for (int bj = 0; bj < 2; ++bj) { f32x4 v0 = acc[ai][bj][m][0] + bv[bj][0], v1 = acc[ai][bj][m][1] + bv[bj][1];
                    if (ACT == 1) { f32x2 a = gelu_pk((f32x2){v0[0], v0[1]}), b = gelu_pk((f32x2){v0[2], v0[3]}), c = gelu_pk((f32x2){v1[0], v1[1]}), d = gelu_pk((f32x2){v1[2], v1[3]});
                        v0 = (f32x4){a.x, a.y, b.x, b.y}; v1 = (f32x4){c.x, c.y, d.x, d.y}; }
                    v0 = v0 * sc; v1 = v1 * sc; u32x4 w; w.x = cvt_pk_bf16(v0[0], v0[1]); w.y = cvt_pk_bf16(v0[2], v0[3]); w.z = cvt_pk_bf16(v1[0], v1[1]); w.w = cvt_pk_bf16(v1[2], v1[3]);
                    *(u32x4*)(rowp + bj * HALF) = w; } }
    }
};
template <class Epi, class Sched, bool ALIGN_EPI = false, bool SP2 = false>
__device__ __forceinline__ void gemm_phase(PG8_LAS unsigned char* lds, const Gemm g, const Sched& S, const Epi& E, const int wave_in) {
    int lane_l; asm volatile("v_mbcnt_lo_u32_b32 %0, -1, 0\n\tv_mbcnt_hi_u32_b32 %0, -1, %0" : "=v"(lane_l));
    const int wid = wave_in, lane = lane_l, tid = wid * 64 + lane, wr = wid >> 2, wc = wid & 3, fr = lane & 15, fq = lane >> 4;
    const int K = g.K, nt = K / BK;
    unsigned voffA[2], voffB[2];
#pragma unroll
    for (int i = 0; i < 2; ++i) { int R, C; stage_rc(tid * 16 + i * 8192, R, C); const int Rb = Epi::PERM ? ((R & ~31) + perm32(R & 31)) : R;
        voffA[i] = (unsigned)(R * K + C) * 2u; voffB[i] = (unsigned)(Rb * K + C) * 2u; }
    const size_t kstep = (size_t)(BK * 2);
    const size_t hstep = (size_t)HALF * K * 2;
    const size_t tstep = 2 * hstep;
    const unsigned ldsw = (unsigned)wid * 1024u;
    const int aoff = lds_byte(wr * 64 + fr, fq * 8), boff = lds_byte(wc * 32 + fr, fq * 8);
#define PG8_SA(b, h) (((b) * 2 + (h)) * HTB)
#define PG8_SB(b, h) ((4 + (b) * 2 + (h)) * HTB)
#define PG8_STAGE(bufoff, gbase, voff) do { _Pragma("unroll") for (int _i = 0; _i < 2; ++_i) \
        __builtin_amdgcn_global_load_lds((const unsigned*)((const char*)(gbase) + (voff)[_i]), (PG8_LAS unsigned*)(lds + (bufoff) + ldsw + _i * 8192), 16, 0, 0); } while (0)
#define PG8_LDA(dst, b, h) do { _Pragma("unroll") for (int m = 0; m < 4; ++m) _Pragma("unroll") for (int k = 0; k < 2; ++k) dst[m][k] = *(const PG8_LAS bf16x8*)(lds + PG8_SA(b, h) + aoff + m * 2048 + k * 1024); } while (0)
#define PG8_LDB(dst, b, h) do { _Pragma("unroll") for (int n = 0; n < 2; ++n) _Pragma("unroll") for (int k = 0; k < 2; ++k) dst[n][k] = *(const PG8_LAS bf16x8*)(lds + PG8_SB(b, h) + boff + n * 2048 + k * 1024); } while (0)
#define PG8_MMA(ai, bj, At, Bt) do { __builtin_amdgcn_s_setprio(1); _Pragma("unroll") for (int m = 0; m < 4; ++m) _Pragma("unroll") for (int n = 0; n < 2; ++n) _Pragma("unroll") for (int k = 0; k < 2; ++k) \
        acc[ai][bj][m][n] = __builtin_amdgcn_mfma_f32_16x16x32_bf16(Bt[n][k], At[m][k], acc[ai][bj][m][n], 0, 0, 0); __builtin_amdgcn_s_setprio(0); } while (0)
#define PG8_WAIT_V(n) asm volatile("s_waitcnt vmcnt(" #n ")" ::: "memory")
#define PG8_WAIT_L(n) asm volatile("s_waitcnt lgkmcnt(" #n ")" ::: "memory")
#define PG8_BAR __builtin_amdgcn_s_barrier()
#define PG8_SCHED __builtin_amdgcn_sched_barrier(0)
    Unit cur, nxt; int ui = 0;
    if (!S.next(0, cur)) return;
    f32x4 acc[2][2][4][2];
#pragma unroll
    for (int a = 0; a < 2; ++a)
#pragma unroll
        for (int b = 0; b < 2; ++b)
#pragma unroll
            for (int m = 0; m < 4; ++m)
#pragma unroll
                for (int n = 0; n < 2; ++n) acc[a][b][m][n] = (f32x4){0.f, 0.f, 0.f, 0.f};
    bf16x8 At[4][2], B0[2][2], B1[2][2];
    const char* cA = (const char*)g.A + (size_t)cur.pm * tstep; const char* cB = (const char*)g.Bt + (size_t)cur.pn * tstep;
    S.a_ready(cur);
    if constexpr (SP2) {
        PG8_STAGE(PG8_SB(0, 0), cB, voffB); PG8_STAGE(PG8_SB(0, 1), cB + hstep, voffB); PG8_STAGE(PG8_SA(0, 0), cA, voffA); PG8_STAGE(PG8_SA(0, 1), cA + hstep, voffA);
        if (wr == 1) PG8_BAR;
        PG8_WAIT_V(2); PG8_BAR;
        PG8_STAGE(PG8_SB(1, 0), cB + kstep, voffB); PG8_STAGE(PG8_SA(1, 0), cA + kstep, voffA); PG8_STAGE(PG8_SB(1, 1), cB + hstep + kstep, voffB);
        PG8_WAIT_V(6); PG8_BAR;
    } else {
        PG8_STAGE(PG8_SB(0, 0), cB, voffB); PG8_STAGE(PG8_SA(0, 0), cA, voffA); PG8_STAGE(PG8_SB(0, 1), cB + hstep, voffB); PG8_STAGE(PG8_SA(0, 1), cA + hstep, voffA);
        if (wr == 1) PG8_BAR;
        PG8_WAIT_V(4); PG8_BAR;
        PG8_STAGE(PG8_SB(1, 0), cB + kstep, voffB); PG8_STAGE(PG8_SA(1, 0), cA + kstep, voffA); PG8_STAGE(PG8_SB(1, 1), cB + hstep + kstep, voffB);
        PG8_WAIT_V(6); PG8_BAR;
    }
    for (;;) {
        const bool has_next = S.next(ui + 1, nxt);
        const char* nA = has_next ? (const char*)g.A + (size_t)nxt.pm * tstep : cA; const char* nB = has_next ? (const char*)g.Bt + (size_t)nxt.pn * tstep : cB;
        for (int t = 0; t < nt; t += 2) {
            const bool last = (t == nt - 2);
            const char* a1 = cA + (size_t)(t + 1) * kstep;
            const char* a2 = last ? nA : cA + (size_t)(t + 2) * kstep; const char* b2 = last ? nB : cB + (size_t)(t + 2) * kstep;
            const char* a3 = a2 + kstep; const char* b3 = b2 + kstep;
            if (last && has_next) S.a_ready(nxt);
            if constexpr (SP2) {
            PG8_LDB(B0, 0, 0); PG8_LDB(B1, 0, 1); PG8_SCHED; PG8_LDA(At, 0, 0); PG8_STAGE(PG8_SA(1, 1), a1 + hstep, voffA);
            PG8_WAIT_V(8); PG8_WAIT_L(0); PG8_BAR; PG8_MMA(0, 0, At, B0); PG8_MMA(0, 1, At, B1); PG8_BAR; PG8_SCHED;
            PG8_LDA(At, 0, 1); PG8_STAGE(PG8_SB(0, 0), b2, voffB); PG8_STAGE(PG8_SB(0, 1), b2 + hstep, voffB); PG8_STAGE(PG8_SA(0, 0), a2, voffA);
            PG8_WAIT_V(8); PG8_WAIT_L(0); PG8_BAR; PG8_MMA(1, 0, At, B0); PG8_MMA(1, 1, At, B1); PG8_BAR; PG8_SCHED;
            PG8_LDB(B0, 1, 0); PG8_LDB(B1, 1, 1); PG8_SCHED; PG8_LDA(At, 1, 0); PG8_STAGE(PG8_SA(0, 1), a2 + hstep, voffA);
            PG8_WAIT_V(8); PG8_WAIT_L(0); PG8_BAR; PG8_MMA(0, 0, At, B0); PG8_MMA(0, 1, At, B1); PG8_BAR; PG8_SCHED;
            PG8_LDA(At, 1, 1); PG8_STAGE(PG8_SB(1, 0), b3, voffB); PG8_STAGE(PG8_SB(1, 1), b3 + hstep, voffB); PG8_STAGE(PG8_SA(1, 0), a3, voffA);
            PG8_WAIT_V(8); PG8_WAIT_L(0); PG8_BAR; PG8_MMA(1, 0, At, B0); PG8_MMA(1, 1, At, B1); PG8_BAR; PG8_SCHED;
            } else {
            PG8_LDB(B0, 0, 0); PG8_SCHED; PG8_LDA(At, 0, 0); PG8_STAGE(PG8_SA(1, 1), a1 + hstep, voffA);
            PG8_WAIT_L(8); PG8_BAR; PG8_WAIT_L(0); PG8_MMA(0, 0, At, B0); PG8_BAR; PG8_SCHED;
            PG8_LDB(B1, 0, 1); PG8_STAGE(PG8_SB(0, 0), b2, voffB);
            PG8_BAR; PG8_WAIT_L(0); PG8_MMA(0, 1, At, B1); PG8_BAR;
            PG8_LDA(At, 0, 1); PG8_STAGE(PG8_SA(0, 0), a2, voffA);
            PG8_BAR; PG8_WAIT_L(0); PG8_MMA(1, 0, At, B0); PG8_BAR; PG8_SCHED;
            PG8_STAGE(PG8_SB(0, 1), b2 + hstep, voffB);
            PG8_WAIT_V(6); PG8_BAR; PG8_MMA(1, 1, At, B1); PG8_BAR;
            PG8_LDB(B0, 1, 0); PG8_SCHED; PG8_LDA(At, 1, 0); PG8_STAGE(PG8_SA(0, 1), a2 + hstep, voffA);
            PG8_WAIT_L(8); PG8_BAR; PG8_WAIT_L(0); PG8_MMA(0, 0, At, B0); PG8_BAR; PG8_SCHED;
            PG8_LDB(B1, 1, 1); PG8_STAGE(PG8_SB(1, 0), b3, voffB);
            PG8_BAR; PG8_WAIT_L(0); PG8_MMA(0, 1, At, B1); PG8_BAR;
            PG8_LDA(At, 1, 1); PG8_STAGE(PG8_SA(1, 0), a3, voffA);
            PG8_BAR; PG8_WAIT_L(0); PG8_MMA(1, 0, At, B0); PG8_BAR; PG8_SCHED;
            PG8_STAGE(PG8_SB(1, 1), b3 + hstep, voffB);
            PG8_WAIT_V(6); PG8_BAR; PG8_MMA(1, 1, At, B1); PG8_BAR;
            }
        }
        if constexpr (ALIGN_EPI) { if (wr == 0) PG8_BAR; }
        if constexpr (!Epi::AFTER_DRAIN) { E(acc, cur, wr, wc, fr, fq); S.done(cur); }
        if (!has_next) break;
#pragma unroll
        for (int a = 0; a < 2; ++a)
#pragma unroll
            for (int b = 0; b < 2; ++b)
#pragma unroll
                for (int m = 0; m < 4; ++m)
#pragma unroll
                    for (int n = 0; n < 2; ++n) acc[a][b][m][n] = (f32x4){0.f, 0.f, 0.f, 0.f};
        cur = nxt; cA = nA; cB = nB; ++ui;
        if constexpr (ALIGN_EPI) { if (wr == 1) PG8_BAR; }
    }
    PG8_WAIT_V(0);
    if constexpr (!ALIGN_EPI) { if (wr == 0) PG8_BAR; }
    PG8_BAR;
    if constexpr (Epi::AFTER_DRAIN) { E.fused(acc, cur, wr, wc, fr, fq, lds, wid, lane); S.done(cur); }
#undef PG8_SA
#undef PG8_SB
#undef PG8_STAGE
#undef PG8_LDA
#undef PG8_LDB
#undef PG8_MMA
#undef PG8_WAIT_V
#undef PG8_WAIT_L
#undef PG8_BAR
#undef PG8_SCHED
}
}
#define LAS __attribute__((address_space(3)))
#define GAS __attribute__((address_space(1)))
typedef unsigned short bf16_t;
typedef short bf16x8 __attribute__((ext_vector_type(8)));
typedef float f32x4 __attribute__((ext_vector_type(4)));
typedef float f32x16 __attribute__((ext_vector_type(16)));
typedef unsigned u32x4 __attribute__((ext_vector_type(4)));
typedef unsigned u32x2 __attribute__((ext_vector_type(2)));
constexpr int NB = 32, SEQ = 2048, DM = 1024, M = NB * SEQ;
constexpr int NIN = 2566, NINP = 2816, DFF = 2816, NGU = 5632, LDP = 2816;
constexpr int COL_DQ = 256, COL_DK = 640, COL_DV = 1024, COL_FQ = 1408, COL_FK = 1792, COL_FV = 2176;
constexpr float EPS = 1e-6f, LOG2E = 1.4426950408889634f, QK_C = 0.125f * 1.4426950408889634f;
constexpr size_t MiB = (size_t)1 << 20;
constexpr size_t WS_WIN = 0, WS_WOUT = 11 * MiB, WS_WGU = 15 * MiB, WS_WDN = 37 * MiB, WS_WGLU = 48 * MiB;
constexpr size_t WS_ABAR = 49 * MiB, WS_BB = 49 * MiB + 65536, WS_CC = 49 * MiB + 262144, WS_FL = 50 * MiB, WS_LSE = 52 * MiB;
constexpr size_t WS_BUFA = 64 * MiB, WS_BUFB = 192 * MiB, WS_PROJ = 320 * MiB, WS_DSAO = 672 * MiB, WS_FOXO = 816 * MiB, WS_G = 864 * MiB, WS_SSMO = 896 * MiB, WS_END = 928 * MiB;
constexpr int LDS_BYTES = 147456;
constexpr size_t WS_CTL = 59 * MiB;

struct Params { const float* in[21]; float* out; unsigned char* ws; };
enum { I_X = 0, I_GPRE, I_WIN, I_BF, I_LDT, I_ARE, I_AIM, I_BRE, I_BIM, I_CRE, I_CIM, I_SD, I_WGLU, I_BGLU, I_GMIX, I_WOUT, I_GPOST, I_GPREF, I_WGU, I_WDN, I_GPOSTF };

__device__ __forceinline__ unsigned cvtpk(float lo, float hi) { typedef float f2 __attribute__((ext_vector_type(2))); typedef __bf16 b2 __attribute__((ext_vector_type(2))); f2 v = {lo, hi}; b2 b = __builtin_convertvector(v, b2); return __builtin_bit_cast(unsigned, b); }
__device__ __forceinline__ float bf2f(unsigned v) { return __uint_as_float(v << 16); }
__device__ __forceinline__ float bflo(unsigned w) { return __uint_as_float(w << 16); }
__device__ __forceinline__ float bfhi(unsigned w) { return __uint_as_float(w & 0xffff0000u); }
__device__ __forceinline__ float wave_sum(float v) {
#pragma unroll
    for (int o = 1; o < 64; o <<= 1) v += __shfl_xor(v, o);
    return v;
}
__device__ __forceinline__ float sigmoidf_(float x) { return __builtin_amdgcn_rcpf(1.0f + __expf(-x)); }
__device__ __forceinline__ float gelu_tanh(float y) { const float u = 0.7978845608028654f * (y + 0.044715f * y * y * y); return y * __builtin_amdgcn_rcpf(1.0f + __expf(-2.0f * u)); }
__device__ __forceinline__ float logsig(float z) { return fminf(z, 0.f) - __logf(1.0f + __expf(-fabsf(z))); }
#define LDS_WAIT() asm volatile("s_waitcnt lgkmcnt(0)" ::: "memory")

namespace pg8 {
struct EpiProj {
    static constexpr bool PERM = true, AFTER_DRAIN = false;
    bf16_t* O; float* FL; const float* bf;
    __device__ __forceinline__ void operator()(const f32x4 (&acc)[2][2][4][2], const Unit& u, int wr, int wc, int fr, int fq) const {
        const int row0 = u.pm * BM + wr * 64 + fr, col0 = u.pn * BM + wc * 32 + 8 * fq;
#pragma unroll
        for (int ai = 0; ai < 2; ++ai)
#pragma unroll
            for (int m = 0; m < 4; ++m) { bf16_t* rowp = O + (size_t)(row0 + ai * HALF + m * 16) * LDP + col0;
#pragma unroll
                for (int bj = 0; bj < 2; ++bj) { const f32x4 v0 = acc[ai][bj][m][0], v1 = acc[ai][bj][m][1];
                    u32x4 w; w.x = cvtpk(v0[0], v0[1]); w.y = cvtpk(v0[2], v0[3]); w.z = cvtpk(v1[0], v1[1]); w.w = cvtpk(v1[2], v1[3]);
                    *(u32x4*)(rowp + bj * HALF) = w; } }
        if (u.pn == 10 && wc == 0 && fq == 0) {
            float b6[6];
#pragma unroll
            for (int j = 0; j < 6; ++j) b6[j] = bf[j];
#pragma unroll
            for (int ai = 0; ai < 2; ++ai)
#pragma unroll
                for (int m = 0; m < 4; ++m) { float* fp = FL + (size_t)(row0 + ai * HALF + m * 16) * 8; const f32x4 v0 = acc[ai][0][m][0], v1 = acc[ai][0][m][1];
                    f32x4 o0, o1; o0[0] = logsig(v0[0] + b6[0]); o0[1] = logsig(v0[1] + b6[1]); o0[2] = logsig(v0[2] + b6[2]); o0[3] = logsig(v0[3] + b6[3]);
                    o1[0] = logsig(v1[0] + b6[4]); o1[1] = logsig(v1[1] + b6[5]); o1[2] = 0.f; o1[3] = 0.f;
                    *(f32x4*)fp = o0; *(f32x4*)(fp + 4) = o1; }
        }
    }
};
struct EpiSwiGLU {
    static constexpr bool PERM = true, AFTER_DRAIN = false;
    bf16_t* H;
    __device__ __forceinline__ void operator()(const f32x4 (&acc)[2][2][4][2], const Unit& u, int wr, int wc, int fr, int fq) const {
        const int row0 = u.pm * BM + wr * 64 + fr, col0 = u.pn * HALF + wc * 32 + 8 * fq;
#pragma unroll
        for (int ai = 0; ai < 2; ++ai)
#pragma unroll
            for (int m = 0; m < 4; ++m) { bf16_t* rowp = H + (size_t)(row0 + ai * HALF + m * 16) * DFF + col0;
                float h[8];
#pragma unroll
                for (int n = 0; n < 2; ++n)
#pragma unroll
                    for (int i = 0; i < 4; ++i) { const float g = acc[ai][0][m][n][i], up = acc[ai][1][m][n][i]; h[n * 4 + i] = g * sigmoidf_(g) * up; }
                u32x4 w; w.x = cvtpk(h[0], h[1]); w.y = cvtpk(h[2], h[3]); w.z = cvtpk(h[4], h[5]); w.w = cvtpk(h[6], h[7]);
                *(u32x4*)rowp = w; }
    }
};
struct EpiGLU {
    static constexpr bool PERM = true, AFTER_DRAIN = false;
    const bf16_t* G; bf16_t* O; const float* bg;
    __device__ __forceinline__ void operator()(const f32x4 (&acc)[2][2][4][2], const Unit& u, int wr, int wc, int fr, int fq) const {
        const int row0 = u.pm * BM + wr * 64 + fr, col0 = wc * 32 + 8 * fq;
#pragma unroll
        for (int bj = 0; bj < 2; ++bj) {
#pragma unroll
            for (int ai = 0; ai < 2; ++ai)
#pragma unroll
                for (int m = 0; m < 4; ++m) { const size_t off = (size_t)(row0 + ai * HALF + m * 16) * 256 + col0 + bj * HALF;
                    const f32x4 b0 = *(const f32x4*)(bg + col0 + bj * HALF), b1 = *(const f32x4*)(bg + col0 + bj * HALF + 4);
                    const u32x4 gw = *(const u32x4*)(G + off); const f32x4 v0 = acc[ai][bj][m][0] + b0, v1 = acc[ai][bj][m][1] + b1;
                    u32x4 w; w.x = cvtpk(bflo(gw.x) * sigmoidf_(v0[0]), bfhi(gw.x) * sigmoidf_(v0[1])); w.y = cvtpk(bflo(gw.y) * sigmoidf_(v0[2]), bfhi(gw.y) * sigmoidf_(v0[3]));
                    w.z = cvtpk(bflo(gw.z) * sigmoidf_(v1[0]), bfhi(gw.z) * sigmoidf_(v1[1])); w.w = cvtpk(bflo(gw.w) * sigmoidf_(v1[2]), bfhi(gw.w) * sigmoidf_(v1[3]));
                    *(u32x4*)(O + off) = w; asm volatile("" ::: "memory"); } }
    }
};
struct EpiGLUNorm {
    static constexpr bool PERM = true, AFTER_DRAIN = true;
    const bf16_t* G; bf16_t* MIX; const float* bg; const float* gm;
    __device__ __forceinline__ void fused(f32x4 (&acc)[2][2][4][2], const Unit& u, int wr, int wc, int fr, int fq, PG8_LAS unsigned char* lds, int wid, int lane) const {
        PG8_LAS float* Pss = (PG8_LAS float*)lds;
        const int row0 = u.pm * BM + wr * 64 + fr, col0 = wc * 32 + 8 * fq;
#pragma unroll
        for (int bj = 0; bj < 2; ++bj) { const f32x4 b0 = *(const f32x4*)(bg + col0 + bj * HALF), b1 = *(const f32x4*)(bg + col0 + bj * HALF + 4);
#pragma unroll
            for (int ai = 0; ai < 2; ++ai)
#pragma unroll
                for (int m = 0; m < 4; ++m) { const size_t off = (size_t)(row0 + ai * HALF + m * 16) * 256 + col0 + bj * HALF;
                    const u32x4 gw = *(const u32x4*)(G + off); const f32x4 v0 = acc[ai][bj][m][0] + b0, v1 = acc[ai][bj][m][1] + b1;
                    acc[ai][bj][m][0] = (f32x4){bflo(gw.x) * sigmoidf_(v0[0]), bfhi(gw.x) * sigmoidf_(v0[1]), bflo(gw.y) * sigmoidf_(v0[2]), bfhi(gw.y) * sigmoidf_(v0[3])};
                    acc[ai][bj][m][1] = (f32x4){bflo(gw.z) * sigmoidf_(v1[0]), bfhi(gw.z) * sigmoidf_(v1[1]), bflo(gw.w) * sigmoidf_(v1[2]), bfhi(gw.w) * sigmoidf_(v1[3])};
                    asm volatile("" ::: "memory"); } }
#pragma unroll
        for (int ai = 0; ai < 2; ++ai)
#pragma unroll
            for (int m = 0; m < 4; ++m) { float ss = 0.f;
#pragma unroll
                for (int bj = 0; bj < 2; ++bj)
#pragma unroll
                    for (int n = 0; n < 2; ++n) { const f32x4 x = acc[ai][bj][m][n]; ss += (x[0] * x[0] + x[1] * x[1]) + (x[2] * x[2] + x[3] * x[3]); }
                ss += __shfl_xor(ss, 16); ss += __shfl_xor(ss, 32);
                if (fq == 0) Pss[(ai * HALF + wr * 64 + m * 16 + fr) * 4 + wc] = ss; }
        asm volatile("s_waitcnt lgkmcnt(0)" ::: "memory"); __builtin_amdgcn_s_barrier(); asm volatile("" ::: "memory");
#pragma unroll
        for (int ai = 0; ai < 2; ++ai)
#pragma unroll
            for (int m = 0; m < 4; ++m) { const f32x4 q = *(const PG8_LAS f32x4*)(Pss + (ai * HALF + wr * 64 + m * 16 + fr) * 4);
                const float rs = 1.0f / sqrtf(((q[0] + q[1]) + (q[2] + q[3])) * (1.0f / 256.0f) + 1e-6f);
#pragma unroll
                for (int bj = 0; bj < 2; ++bj) { const f32x4 g0 = *(const f32x4*)(gm + col0 + bj * HALF), g1 = *(const f32x4*)(gm + col0 + bj * HALF + 4);
                    const f32x4 o0 = acc[ai][bj][m][0] * rs * g0, o1 = acc[ai][bj][m][1] * rs * g1;
                    u32x4 w; w.x = cvtpk(o0[0], o0[1]); w.y = cvtpk(o0[2], o0[3]); w.z = cvtpk(o1[0], o1[1]); w.w = cvtpk(o1[2], o1[3]);
                    *(u32x4*)(MIX + (size_t)(row0 + ai * HALF + m * 16) * 1024 + col0 + bj * HALF) = w; } }
        asm volatile("s_waitcnt lgkmcnt(0)" ::: "memory"); __builtin_amdgcn_s_barrier(); asm volatile("" ::: "memory");
    }
};
}
#define XB_TMO      128
#define XB_XCNT(j)  (256  + 64 * (j))
#define XB_XSUB(j)  (1280 + 64 * (j))
#define XB_XGEN(j)  (2304 + 64 * (j))
#define XB_TOP      3328
#define XB_TOPGEN   3392
#define XCD_BAR_WORDS 3456
#define XB_SPIN_CAP (1u << 18)

__device__ __forceinline__ unsigned xb_ld(unsigned* p)              { return __hip_atomic_load(p, __ATOMIC_RELAXED, __HIP_MEMORY_SCOPE_AGENT); }
__device__ __forceinline__ unsigned xb_add(unsigned* p, unsigned v) { return __hip_atomic_fetch_add(p, v, __ATOMIC_RELAXED, __HIP_MEMORY_SCOPE_AGENT); }
__device__ __forceinline__ unsigned xb_xcc_id() { return (unsigned)__builtin_amdgcn_s_getreg((3 << 11) | 20) & 0xFu; }
#define XB_SPIN(cond, bar) do { unsigned _sp = 0; while (cond) { __builtin_amdgcn_s_sleep(1); \
    if ((++_sp & 255u) == 0u) { if (xb_ld(&(bar)[XB_TMO])) break; if (_sp > XB_SPIN_CAP) { atomicAdd(&(bar)[XB_TMO], 1u); break; } } } } while (0)

struct XcdBarrier {
    unsigned* bar; unsigned x;
    volatile LAS unsigned* st;
};

__device__ __forceinline__ XcdBarrier xcd_barrier_post(unsigned* bar, volatile LAS unsigned* st, const int tid) {
    XcdBarrier b; b.bar = bar; b.x = xb_xcc_id(); b.st = st;
    if (tid == 0) (void)xb_add(&bar[XB_XCNT(b.x)], 1u);
    return b;
}
__device__ __forceinline__ void xcd_barrier_complete(unsigned* bar, unsigned x, unsigned& nloc, unsigned& nx) {
    const unsigned G = gridDim.x * gridDim.y * gridDim.z;
    unsigned sum, cnt, mine, sp = 0u;
    for (;;) {
        sum = 0u; cnt = 0u; mine = 0u;
#pragma unroll
        for (unsigned j = 0; j < 16; ++j) { const unsigned c = xb_ld(&bar[XB_XCNT(j)]); sum += c; cnt += (c > 0u) ? 1u : 0u; mine = (j == x) ? c : mine; }
        if (sum == G) break;
        __builtin_amdgcn_s_sleep(1);
        if ((++sp & 255u) == 0u) { if (xb_ld(&bar[XB_TMO])) break; if (sp > XB_SPIN_CAP) { atomicAdd(&bar[XB_TMO], 1u); break; } }
    }
    nloc = mine > 0u ? mine : 1u; nx = cnt > 0u ? cnt : 1u;
}

__device__ __forceinline__ void xcd_barrier(const XcdBarrier& b, const int tid) {
    asm volatile("s_waitcnt vmcnt(0)" ::: "memory");
    __syncthreads();
    if (tid == 0) {
        unsigned* bar = b.bar;
        __builtin_amdgcn_s_waitcnt(0);
        unsigned nloc = b.st[0], nx = b.st[1];
        if (nloc == 0u) { xcd_barrier_complete(bar, b.x, nloc, nx); b.st[0] = nloc; b.st[1] = nx; }
        const unsigned old = xb_add(&bar[XB_XSUB(b.x)], 1u);
        const unsigned gen = old / nloc;
        if (old + 1u == (gen + 1u) * nloc) {
            __builtin_amdgcn_fence(__ATOMIC_RELEASE, "agent");
            asm volatile("s_waitcnt vmcnt(0)" ::: "memory");
            const unsigned og = xb_add(&bar[XB_TOP], 1u);
            const unsigned tg = og / nx;
            if (og + 1u == (tg + 1u) * nx) xb_add(&bar[XB_TOPGEN], 1u);
            else XB_SPIN(xb_ld(&bar[XB_TOPGEN]) == tg, bar);
            __builtin_amdgcn_fence(__ATOMIC_ACQUIRE, "agent");
            xb_add(&bar[XB_XGEN(b.x)], 1u);
            asm volatile("s_waitcnt vmcnt(0)" ::: "memory");
        } else {
            XB_SPIN(xb_ld(&bar[XB_XGEN(b.x)]) == gen, bar);
            __builtin_amdgcn_fence(__ATOMIC_ACQUIRE, "agent");
            asm volatile("s_waitcnt vmcnt(0)" ::: "memory");
        }
    }
    __syncthreads();
}
__device__ __forceinline__ void tr_item(const float* W, int K, int N, bf16_t* WT, int k0, int n0, int drow0, LAS float* scr, int lane) {
    const int n = n0 + (lane & 31);
#pragma unroll 8
    for (int i = 0; i < 32; ++i) { const int kk = 2 * i + (lane >> 5); scr[kk * 33 + (lane & 31)] = (n < N) ? W[(size_t)(k0 + kk) * N + n] : 0.f; }
    LDS_WAIT(); __builtin_amdgcn_wave_barrier();
    const int c = lane & 7;
#pragma unroll
    for (int j = 0; j < 4; ++j) { const int nn = (lane >> 3) + 8 * j; const LAS float* s = scr + (8 * c) * 33 + nn;
        u32x4 o; o.x = cvtpk(s[0 * 33], s[1 * 33]); o.y = cvtpk(s[2 * 33], s[3 * 33]); o.z = cvtpk(s[4 * 33], s[5 * 33]); o.w = cvtpk(s[6 * 33], s[7 * 33]);
        *(u32x4*)(WT + (size_t)(drow0 + nn) * K + k0 + 8 * c) = o; }
    LDS_WAIT(); __builtin_amdgcn_wave_barrier();
}
__device__ __forceinline__ void sincos_rr(float x, float& s, float& c) {
    const float q = rintf(x * 0.6366197723675814f);
    float r = fmaf(-q, 1.57079637050628662109375f, x); r = fmaf(-q, -4.37113900018624283e-8f, r);
    const float r2 = r * r;
    const float sp = r + r * r2 * (-1.6666654611e-1f + r2 * (8.3321608736e-3f + r2 * (-1.9515295891e-4f)));
    const float cp = 1.0f - 0.5f * r2 + r2 * r2 * (4.166664568298827e-2f + r2 * (-1.388731625493765e-3f + r2 * 2.443315711809948e-5f));
    const int n = ((int)q) & 3;
    s = (n == 0) ? sp : (n == 1) ? cp : (n == 2) ? -sp : -cp;
    c = (n == 0) ? cp : (n == 1) ? -sp : (n == 2) ? -cp : sp;
}
struct RowIn { f32x4 x[4]; u32x2 xb[4]; u32x2 y[4]; float rinv; };
template <bool HAS_Y, int XIN> __device__ __forceinline__ void row_load(RowIn& r, const void* xin, const float* rn, size_t m, const bf16_t* y, int lane) {
#pragma unroll
    for (int j = 0; j < 4; ++j) {
        if (XIN != 0) r.xb[j] = *(const u32x2*)((const bf16_t*)xin + m * 1024 + 4 * lane + 256 * j); else r.x[j] = *(const f32x4*)((const float*)xin + m * 1024 + 4 * lane + 256 * j);
        if (HAS_Y) r.y[j] = *(const u32x2*)(y + m * 1024 + 4 * lane + 256 * j); }
    if (XIN == 2) r.rinv = rn[m];
}
template <bool HAS_Y, int XIN, int XOUT> __device__ __forceinline__ void row_compute(const RowIn& r, const f32x4 (&gi)[4], const f32x4 (&gp)[4], void* xout, float* rn, size_t m, const f32x4 (&gq)[4], bf16_t* xn, int lane) {
    f32x4 xv[4];
#pragma unroll
    for (int j = 0; j < 4; ++j) { if (XIN != 0) { const u32x2 w = r.xb[j]; xv[j] = (f32x4){bflo(w.x), bfhi(w.x), bflo(w.y), bfhi(w.y)}; if (XIN == 2) xv[j] = xv[j] * r.rinv * gi[j]; } else xv[j] = r.x[j]; }
    if (HAS_Y) {
        f32x4 yv[4]; float ss = 0.f;
#pragma unroll
        for (int j = 0; j < 4; ++j) { const u32x2 w = r.y[j]; yv[j] = (f32x4){bflo(w.x), bfhi(w.x), bflo(w.y), bfhi(w.y)};
            ss += (yv[j][0] * yv[j][0] + yv[j][1] * yv[j][1]) + (yv[j][2] * yv[j][2] + yv[j][3] * yv[j][3]); }
        const float ry = 1.0f / sqrtf(wave_sum(ss) * (1.0f / 1024.0f) + EPS);
#pragma unroll
        for (int j = 0; j < 4; ++j) { xv[j] = xv[j] + yv[j] * ry * gp[j];
            if (XOUT == 1) { u32x2 w; w.x = cvtpk(xv[j][0], xv[j][1]); w.y = cvtpk(xv[j][2], xv[j][3]); *(u32x2*)((bf16_t*)xout + m * 1024 + 4 * lane + 256 * j) = w; }
            if (XOUT == 0) *(f32x4*)((float*)xout + m * 1024 + 4 * lane + 256 * j) = xv[j]; }
    }
    if (xn) {
        float ss = 0.f;
#pragma unroll
        for (int j = 0; j < 4; ++j) ss += (xv[j][0] * xv[j][0] + xv[j][1] * xv[j][1]) + (xv[j][2] * xv[j][2] + xv[j][3] * xv[j][3]);
        const float ms = wave_sum(ss) * (1.0f / 1024.0f) + EPS, rx = 1.0f / sqrtf(ms);
        if (XOUT == 2 && lane == 0) rn[m] = sqrtf(ms);
#pragma unroll
        for (int j = 0; j < 4; ++j) { const f32x4 o = xv[j] * rx * gq[j];
            u32x2 w; w.x = cvtpk(o[0], o[1]); w.y = cvtpk(o[2], o[3]); *(u32x2*)(xn + m * 1024 + 4 * lane + 256 * j) = w; }
    }
}
template <bool HAS_Y, int XIN, int XOUT> __device__ __forceinline__ void row_phase(const void* xin, const float* gin, float* rn, const bf16_t* y, const float* gpost, void* xout, const float* gpre, bf16_t* xn, int gw, int NGW, int lane) {
    f32x4 gp[4], gq[4], gi[4];
#pragma unroll
    for (int j = 0; j < 4; ++j) { gp[j] = HAS_Y ? *(const f32x4*)(gpost + 4 * lane + 256 * j) : (f32x4){0.f, 0.f, 0.f, 0.f}; gq[j] = xn ? *(const f32x4*)(gpre + 4 * lane + 256 * j) : (f32x4){0.f, 0.f, 0.f, 0.f};
        if (XIN == 2) { const f32x4 g = *(const f32x4*)(gin + 4 * lane + 256 * j); gi[j] = (f32x4){1.0f / g[0], 1.0f / g[1], 1.0f / g[2], 1.0f / g[3]}; } else gi[j] = (f32x4){1.f, 1.f, 1.f, 1.f}; }
    RowIn cur, nxt, nx2;
    int m = gw;
    if (m < M) row_load<HAS_Y, XIN>(cur, xin, rn, (size_t)m, y, lane);
    if (m + NGW < M) row_load<HAS_Y, XIN>(nxt, xin, rn, (size_t)(m + NGW), y, lane);
    for (; m < M; m += NGW) {
        const int m2 = m + 2 * NGW;
        if (m2 < M) row_load<HAS_Y, XIN>(nx2, xin, rn, (size_t)m2, y, lane);
        row_compute<HAS_Y, XIN, XOUT>(cur, gi, gp, xout, rn, (size_t)m, gq, xn, lane);
        cur = nxt; nxt = nx2;
    }
}

constexpr int XP = 132, HP = 136, SSM_WAVE_LDS = 16 * XP * 4 + 16 * HP * 2;
__device__ __forceinline__ void ssm_wave(const bf16_t* PROJ_, const float* ABAR, const bf16_t* BB, const bf16_t* CC, const float* dsk, bf16_t* G_, LAS unsigned char* wl, int b, int g, int lane) {
    LAS float* XT = (LAS float*)wl; LAS bf16_t* HT = (LAS bf16_t*)(wl + 16 * XP * 4);
    const GAS bf16_t* PROJg = (const GAS bf16_t*)PROJ_; GAS bf16_t* Gg = (GAS bf16_t*)G_;
#define PROJ PROJg
#define G Gg
    const int c16 = lane & 15, q4 = lane >> 4;
    const float ar = ABAR[(g * 64 + lane) * 2], ai = ABAR[(g * 64 + lane) * 2 + 1];
    bf16x8 bfr[8], cfr[4]; const bf16x8 zero8 = {0, 0, 0, 0, 0, 0, 0, 0};
#pragma unroll
    for (int j = 0; j < 8; ++j) bfr[j] = (q4 < 2) ? *(const bf16x8*)(BB + ((size_t)g * 128 + 16 * j + c16) * 16 + 8 * q4) : zero8;
#pragma unroll
    for (int ks = 0; ks < 4; ++ks) cfr[ks] = *(const bf16x8*)(CC + ((size_t)g * 16 + c16) * 128 + 32 * ks + 8 * q4);
    const float dk = dsk[g * 16 + c16];
    float hr = 0.f, hi = 0.f;
    const size_t m0 = (size_t)b * SEQ;
    const GAS bf16_t* up = PROJ + (m0 + c16) * LDP + g * 16 + 8 * (q4 & 1);
    bf16x8 anext = *(const GAS bf16x8*)up;
    const GAS bf16_t* usk = PROJ + (m0 + 4 * q4) * LDP + g * 16 + c16;
    unsigned short un0 = usk[0], un1 = usk[LDP], un2 = usk[2 * LDP], un3 = usk[3 * LDP];
    for (int tile = 0; tile < SEQ / 16; ++tile) {
        const bf16x8 acur = (q4 < 2) ? anext : zero8;
        if (tile + 1 < SEQ / 16) anext = *(const GAS bf16x8*)(up + (size_t)(tile + 1) * 16 * LDP);
        const float uc[4] = {bf2f(un0), bf2f(un1), bf2f(un2), bf2f(un3)};
        if (tile + 1 < SEQ / 16) { const GAS bf16_t* q = usk + (size_t)(tile + 1) * 16 * LDP; un0 = q[0]; un1 = q[LDP]; un2 = q[2 * LDP]; un3 = q[3 * LDP]; }
f32x4 xa[8];
#pragma unroll
        for (int j = 0; j < 8; ++j) xa[j] = __builtin_amdgcn_mfma_f32_16x16x32_bf16(acur, bfr[j], (f32x4){0.f, 0.f, 0.f, 0.f}, 0, 0, 0);
        asm volatile("s_nop 15\n\ts_nop 15" : "+v"(xa[0]), "+v"(xa[1]), "+v"(xa[2]), "+v"(xa[3]), "+v"(xa[4]), "+v"(xa[5]), "+v"(xa[6]), "+v"(xa[7]));
#pragma unroll
        for (int j = 0; j < 8; ++j)
#pragma unroll
            for (int i = 0; i < 4; ++i) XT[(4 * q4 + i) * XP + 16 * j + c16] = xa[j][i];
        LDS_WAIT(); __builtin_amdgcn_wave_barrier();
#pragma unroll
        for (int t = 0; t < 16; ++t) { const float xr = XT[t * XP + lane], xi = XT[t * XP + 64 + lane];
            const float nr = fmaf(ar, hr, fmaf(-ai, hi, xr)), ni = fmaf(ar, hi, fmaf(ai, hr, xi)); hr = nr; hi = ni;
            *(LAS unsigned*)(HT + t * HP + 2 * lane) = cvtpk(hr, hi); }
        LDS_WAIT(); __builtin_amdgcn_wave_barrier();
        f32x4 ya = {0.f, 0.f, 0.f, 0.f};
#pragma unroll
        for (int ks = 0; ks < 4; ++ks) { const bf16x8 a = *(const LAS bf16x8*)(HT + c16 * HP + 32 * ks + 8 * q4); ya = __builtin_amdgcn_mfma_f32_16x16x32_bf16(a, cfr[ks], ya, 0, 0, 0); }
        asm volatile("s_nop 15\n\ts_nop 15" : "+v"(ya));
#pragma unroll
        for (int i = 0; i < 4; ++i) { const size_t mrow = m0 + tile * 16 + 4 * q4 + i; const float u = uc[i];
            const float yv = ya[i] + dk * u; G[mrow * 256 + g * 16 + c16] = (bf16_t)(cvtpk(gelu_tanh(yv), 0.f) & 0xffffu); }
        LDS_WAIT(); __builtin_amdgcn_wave_barrier();
    }
}

#undef PROJ
#undef G
constexpr int KP = 72;
struct AttnSt { f32x16 o0, o1; float m, l; };
__device__ __forceinline__ bf16x8 pack8(const f32x16& p, int s) { u32x4 w; w.x = cvtpk(p[8 * s + 0], p[8 * s + 1]); w.y = cvtpk(p[8 * s + 2], p[8 * s + 3]); w.z = cvtpk(p[8 * s + 4], p[8 * s + 5]); w.w = cvtpk(p[8 * s + 6], p[8 * s + 7]); return __builtin_bit_cast(bf16x8, w); }
typedef float f32x2_ __attribute__((ext_vector_type(2)));
template <bool BIAS>
__device__ __forceinline__ void attn_tile(AttnSt& st, const bf16x8 (&qf)[4], const LAS bf16_t* Ks, const LAS bf16_t* Vt, int r32, int hi,
                                          float cq, const LAS float* ck, int klo, int khi, int kbase, bool need_mask) {
    f32x16 p0, p1;
#pragma unroll
    for (int r = 0; r < 16; ++r) { p0[r] = 0.f; p1[r] = 0.f; }
#pragma unroll
    for (int ds = 0; ds < 4; ++ds) { const bf16x8 a0 = *(const LAS bf16x8*)(Ks + r32 * KP + ds * 16 + hi * 8), a1 = *(const LAS bf16x8*)(Ks + (32 + r32) * KP + ds * 16 + hi * 8);
        p0 = __builtin_amdgcn_mfma_f32_32x32x16_bf16(a0, qf[ds], p0, 0, 0, 0); p1 = __builtin_amdgcn_mfma_f32_32x32x16_bf16(a1, qf[ds], p1, 0, 0, 0); }
    if (BIAS) {
#pragma unroll
        for (int g = 0; g < 4; ++g) {
            const f32x4 c0 = *(const LAS f32x4*)(ck + 8 * g + 4 * hi), c1 = *(const LAS f32x4*)(ck + 32 + 8 * g + 4 * hi);
#pragma unroll
            for (int i = 0; i < 4; i += 2) { const int r = 4 * g + i;
                const f32x2_ a2 = (f32x2_){p0[r], p0[r + 1]} * QK_C + (f32x2_){c0[i], c0[i + 1]}, b2 = (f32x2_){p1[r], p1[r + 1]} * QK_C + (f32x2_){c1[i], c1[i + 1]};
                p0[r] = a2.x; p0[r + 1] = a2.y; p1[r] = b2.x; p1[r + 1] = b2.y; }
        }
    }
    if (need_mask) {
        const unsigned nml = (unsigned)(kbase + 4 * hi - klo), range = (unsigned)(khi - klo);
#pragma unroll
        for (int r = 0; r < 16; ++r) { const unsigned c = (unsigned)((r & 3) + 8 * (r >> 2));
            if (nml + c > range) p0[r] = -INFINITY;
            if (nml + (c + 32u) > range) p1[r] = -INFINITY; }
    }
#define MX3(a, b, c) __builtin_fmaxf(__builtin_fmaxf((a), (b)), (c))
    float rm;
    { float ma = MX3(p0[0], p0[1], p1[0]), mb = MX3(p0[2], p0[3], p1[1]); ma = MX3(ma, p1[2], p1[3]);
#pragma unroll
      for (int r = 4; r < 16; r += 4) { ma = MX3(ma, p0[r], p0[r + 1]); mb = MX3(mb, p0[r + 2], p0[r + 3]); ma = MX3(ma, p1[r], p1[r + 1]); mb = MX3(mb, p1[r + 2], p1[r + 3]); }
      rm = __builtin_fmaxf(ma, mb); }
#undef MX3
    rm = fmaxf(rm, __shfl_xor(rm, 32));
    const float mnew = fmaxf(st.m, rm);
    const float SC = BIAS ? 1.0f : QK_C;
    const float alpha = __builtin_amdgcn_exp2f((st.m - mnew) * SC), nm = -mnew * SC;
    st.m = mnew;
    f32x2_ sum2 = {0.f, 0.f};
#pragma unroll
    for (int r = 0; r < 16; r += 2) {
        const f32x2_ a2 = BIAS ? (f32x2_){p0[r], p0[r + 1]} + nm : (f32x2_){p0[r], p0[r + 1]} * QK_C + nm, b2 = BIAS ? (f32x2_){p1[r], p1[r + 1]} + nm : (f32x2_){p1[r], p1[r + 1]} * QK_C + nm;
        p0[r] = __builtin_amdgcn_exp2f(a2.x); p0[r + 1] = __builtin_amdgcn_exp2f(a2.y); p1[r] = __builtin_amdgcn_exp2f(b2.x); p1[r + 1] = __builtin_amdgcn_exp2f(b2.y);
        sum2 += (f32x2_){p0[r], p0[r + 1]} + (f32x2_){p1[r], p1[r + 1]}; }
    st.l = st.l * alpha + (sum2.x + sum2.y);
#pragma unroll
    for (int r = 0; r < 16; ++r) { st.o0[r] *= alpha; st.o1[r] *= alpha; }
    const int sw0 = ((r32 >> 3) & 7) << 3, sw1 = (((32 + r32) >> 3) & 7) << 3;
#pragma unroll
    for (int T = 0; T < 2; ++T)
#pragma unroll
        for (int s = 0; s < 2; ++s) { const bf16x8 pf = pack8(T == 0 ? p0 : p1, s); const int kvb = 32 * T + 16 * s + 4 * hi;
            { const u32x2 lo = *(const LAS u32x2*)(Vt + r32 * KP + (kvb ^ sw0)), hh = *(const LAS u32x2*)(Vt + r32 * KP + ((kvb + 8) ^ sw0));
              const u32x4 v = {lo.x, lo.y, hh.x, hh.y}; st.o0 = __builtin_amdgcn_mfma_f32_32x32x16_bf16(__builtin_bit_cast(bf16x8, v), pf, st.o0, 0, 0, 0); }
            { const u32x2 lo = *(const LAS u32x2*)(Vt + (32 + r32) * KP + (kvb ^ sw1)), hh = *(const LAS u32x2*)(Vt + (32 + r32) * KP + ((kvb + 8) ^ sw1));
              const u32x4 v = {lo.x, lo.y, hh.x, hh.y}; st.o1 = __builtin_amdgcn_mfma_f32_32x32x16_bf16(__builtin_bit_cast(bf16x8, v), pf, st.o1, 0, 0, 0); }
        }
}
__device__ __forceinline__ void attn_init(AttnSt& st) {
#pragma unroll
    for (int r = 0; r < 16; ++r) { st.o0[r] = 0.f; st.o1[r] = 0.f; }
    st.m = -1e30f; st.l = 0.f;
}
__device__ __forceinline__ void attn_store(const AttnSt& st, float inv, bf16_t* orow, int hi) {
#pragma unroll
    for (int g = 0; g < 4; ++g) {
        u32x2 w0, w1; w0.x = cvtpk(st.o0[4 * g] * inv, st.o0[4 * g + 1] * inv); w0.y = cvtpk(st.o0[4 * g + 2] * inv, st.o0[4 * g + 3] * inv);
        w1.x = cvtpk(st.o1[4 * g] * inv, st.o1[4 * g + 1] * inv); w1.y = cvtpk(st.o1[4 * g + 2] * inv, st.o1[4 * g + 3] * inv);
        *(u32x2*)(orow + 8 * g + 4 * hi) = w0; *(u32x2*)(orow + 32 + 8 * g + 4 * hi) = w1; }
}
__device__ __forceinline__ void stage_k(LAS bf16_t* Ks, int lrow, int lch, const u32x4& kreg) { *(LAS u32x4*)(Ks + lrow * KP + lch * 8) = kreg; }
__device__ __forceinline__ void stage_v2(LAS bf16_t* Vt, int rp, int c4, const u32x2& va, const u32x2& vb) {
    const int sw = ((c4 >> 1) & 7) << 3;
#pragma unroll
    for (int j = 0; j < 4; ++j) { const unsigned a = va[j >> 1], c = vb[j >> 1];
        const unsigned w = (j & 1) ? ((a >> 16) | (c & 0xffff0000u)) : ((a & 0xffffu) | (c << 16));
        *(LAS unsigned*)(Vt + (4 * c4 + j) * KP + ((2 * rp) ^ sw)) = w; }
}

__device__ __forceinline__ void fox_unit(const bf16_t* PROJ_, const float* FL_, bf16_t* FOXO_, LAS unsigned char* lds, int b, int h, int qb, int tid, int lane, int wave) {
    const GAS bf16_t* PROJ = (const GAS bf16_t*)PROJ_; const GAS float* FL = (const GAS float*)FL_; GAS bf16_t* FOXO = (GAS bf16_t*)FOXO_;
    LAS bf16_t* Ks = (LAS bf16_t*)lds; LAS bf16_t* Vt = (LAS bf16_t*)(lds + 9216); LAS float* cum = (LAS float*)(lds + 36864); LAS float* wtot = (LAS float*)(lds + 36864 + 8192);
    const int r32 = lane & 31, hi = lane >> 5;
    const int q1 = (qb + 1) * 256;
    __syncthreads();
    {
        float v[4]; const int s0 = 4 * tid;
#pragma unroll
        for (int i = 0; i < 4; ++i) v[i] = (s0 + i < q1) ? FL[((size_t)b * SEQ + s0 + i) * 8 + h] * LOG2E : 0.f;
        v[1] += v[0]; v[2] += v[1]; v[3] += v[2];
        const float tot = v[3]; float inc = tot;
#pragma unroll
        for (int off = 1; off < 64; off <<= 1) { const float t = __shfl_up(inc, off); if (lane >= off) inc += t; }
        if (lane == 63) wtot[wave] = inc;
        __syncthreads();
        float base = 0.f;
        for (int w = 0; w < wave; ++w) base += wtot[w];
        const float ex = base + inc - tot;
#pragma unroll
        for (int i = 0; i < 4; ++i) cum[s0 + i] = -(ex + v[i]);
    }
    __syncthreads();
    const int qrow0 = qb * 256 + wave * 32, qpos = qrow0 + r32;
    bf16x8 qf[4];
    { const GAS bf16_t* qp = PROJ + ((size_t)b * SEQ + qpos) * LDP + COL_FQ + h * 64 + hi * 8;
#pragma unroll
      for (int ds = 0; ds < 4; ++ds) qf[ds] = *(const GAS bf16x8*)(qp + ds * 16); }
    const float cq = 0.f;
    AttnSt st; attn_init(st);
    const int NT = q1 / 64, lrow = tid >> 3, lch = tid & 7, rp = tid >> 4, c4 = tid & 15;
    const GAS bf16_t* kg = PROJ + ((size_t)b * SEQ + lrow) * LDP + COL_FK + h * 64 + lch * 8;
    const GAS bf16_t* vg = PROJ + ((size_t)b * SEQ + 2 * rp) * LDP + COL_FV + h * 64 + c4 * 4;
    u32x4 kreg = *(const GAS u32x4*)kg; u32x2 va = *(const GAS u32x2*)vg, vb = *(const GAS u32x2*)(vg + LDP);
    stage_k(Ks, lrow, lch, kreg); stage_v2(Vt, rp, c4, va, vb);
    if (NT > 1) { kreg = *(const GAS u32x4*)(kg + (size_t)64 * LDP); va = *(const GAS u32x2*)(vg + (size_t)64 * LDP); vb = *(const GAS u32x2*)(vg + (size_t)65 * LDP); }
    __syncthreads();
    for (int kt = 0; kt < NT; ++kt) {
        LAS bf16_t* Kc = Ks + (kt & 1) * 9216; LAS bf16_t* Vc = Vt + (kt & 1) * 9216; LAS bf16_t* Kn = Ks + ((kt + 1) & 1) * 9216; LAS bf16_t* Vn = Vt + ((kt + 1) & 1) * 9216;
        if (kt + 1 < NT) { stage_k(Kn, lrow, lch, kreg); stage_v2(Vn, rp, c4, va, vb); }
        if (kt + 2 < NT) { kreg = *(const GAS u32x4*)(kg + (size_t)(kt + 2) * 64 * LDP); va = *(const GAS u32x2*)(vg + (size_t)(kt + 2) * 64 * LDP); vb = *(const GAS u32x2*)(vg + ((size_t)(kt + 2) * 64 + 1) * LDP); }
        if (kt * 64 <= qrow0 + 31) attn_tile<true>(st, qf, Kc, Vc, r32, hi, cq, cum + kt * 64, 0, qpos, kt * 64, kt * 64 + 63 > qrow0);
        __syncthreads();
    }
    const float l = st.l + __shfl_xor(st.l, 32);
    attn_store(st, 1.0f / l, (bf16_t*)(FOXO + ((size_t)b * SEQ + qpos) * 384 + h * 64), hi);
}

__device__ __forceinline__ void dsa_unit(const bf16_t* PROJ_, bf16_t* DSAO_, float* LSE_, LAS unsigned char* lds, int b, int hp, int pat, int res, int n, int tid, int lane, int wave) {
    const int job = wave >> 2, jw = wave & 3, h = 2 * hp + job, jt = tid & 255, r32 = lane & 31, hi = lane >> 5;
    const int d = (pat == 0) ? 1 : (pat == 1 ? 4 : 16);
    const GAS bf16_t* PROJ = (const GAS bf16_t*)PROJ_; GAS bf16_t* DSAO = (GAS bf16_t*)DSAO_; GAS float* LSE = (GAS float*)LSE_;
    LAS bf16_t* Ks = (LAS bf16_t*)(lds + job * 36864); LAS bf16_t* Vt = (LAS bf16_t*)(lds + job * 36864 + 9216);
    __syncthreads();
    const int qi = jw * 32 + r32;
    const size_t trow = (size_t)b * SEQ + (size_t)(n * 128 + qi) * d + res;
    bf16x8 qf[4];
    { const GAS bf16_t* qp = PROJ + trow * LDP + COL_DQ + h * 64 + hi * 8;
#pragma unroll
      for (int ds = 0; ds < 4; ++ds) qf[ds] = *(const GAS bf16x8*)(qp + ds * 16); }
    AttnSt st; attn_init(st);
    const int kt0 = (n == 0) ? 2 : 0, lch = jt & 7, lrow = jt >> 3, rp = jt >> 4, c4 = jt & 15;
    const GAS bf16_t* kbase = PROJ + ((size_t)b * SEQ + res) * LDP + COL_DK + h * 64 + lch * 8;
    const GAS bf16_t* vbase = PROJ + ((size_t)b * SEQ + res) * LDP + COL_DV + h * 64 + c4 * 4;
    const long rstep = (long)d * LDP;
    const long mk0 = (long)(n - 1) * 128 + lrow, mv0 = (long)(n - 1) * 128 + 2 * rp;
    u32x4 kreg0, kreg1; u32x2 va0, vb0, va1, vb1;
#define DSA_LOAD(kt_) do { const long o0 = (mk0 + 64 * (kt_)) * rstep, o1 = o0 + 32 * rstep, p0 = (mv0 + 64 * (kt_)) * rstep, p1 = p0 + 32 * rstep; \
        kreg0 = *(const GAS u32x4*)(kbase + o0); kreg1 = *(const GAS u32x4*)(kbase + o1); \
        va0 = *(const GAS u32x2*)(vbase + p0); vb0 = *(const GAS u32x2*)(vbase + p0 + rstep); va1 = *(const GAS u32x2*)(vbase + p1); vb1 = *(const GAS u32x2*)(vbase + p1 + rstep); } while (0)
#define DSA_STAGE(K_, V_) do { stage_k(K_, lrow, lch, kreg0); stage_k(K_, lrow + 32, lch, kreg1); stage_v2(V_, rp, c4, va0, vb0); stage_v2(V_, rp + 16, c4, va1, vb1); } while (0)
    DSA_LOAD(kt0);
    DSA_STAGE(Ks + (kt0 & 1) * 9216, Vt + (kt0 & 1) * 9216);
    DSA_LOAD(kt0 + 1);
    __syncthreads();
    const int q0 = jw * 32;
    for (int kt = kt0; kt < 4; ++kt) {
        LAS bf16_t* Kc = Ks + (kt & 1) * 9216; LAS bf16_t* Vc = Vt + (kt & 1) * 9216;
        if (kt + 1 < 4) DSA_STAGE(Ks + ((kt + 1) & 1) * 9216, Vt + ((kt + 1) & 1) * 9216);
        if (kt + 2 < 4) DSA_LOAD(kt + 2);
        const int k0 = 64 * kt;
        if (k0 + 63 >= q0 && k0 <= q0 + 31 + 128) {
            const bool allv = (k0 >= q0 + 31) && (k0 + 63 <= q0 + 128);
            attn_tile<false>(st, qf, Kc, Vc, r32, hi, 0.f, (const LAS float*)lds, qi, qi + 128, k0, !allv);
        }
        __syncthreads();
    }
#undef DSA_LOAD
#undef DSA_STAGE
    const float l = st.l + __shfl_xor(st.l, 32);
    attn_store(st, 1.0f / l, (bf16_t*)(DSAO + ((size_t)pat * M + trow) * 384 + h * 64), hi);
    if (hi == 0) LSE[((size_t)pat * M + trow) * 8 + h] = st.m * QK_C + __log2f(l);
}

__device__ __forceinline__ void merge_row(const bf16_t* SSMO, const bf16_t* DSAO, const float* LSE, const bf16_t* FOXO, const float* gm, bf16_t* OUT, size_t m, int lane) {
    float v[16];
    if (lane < 16) {
#pragma unroll
        for (int i = 0; i < 16; ++i) v[i] = 0.f;
    } else if (lane < 40) {
        const int c0 = 16 * lane - 256, h = c0 >> 6;
        const float l0 = LSE[(0 * (size_t)M + m) * 8 + h], l1 = LSE[(1 * (size_t)M + m) * 8 + h], l2 = LSE[(2 * (size_t)M + m) * 8 + h];
        const float mx = fmaxf(l0, fmaxf(l1, l2));
        float w0 = __builtin_amdgcn_exp2f(l0 - mx), w1 = __builtin_amdgcn_exp2f(l1 - mx), w2 = __builtin_amdgcn_exp2f(l2 - mx);
        const float inv = 1.0f / (w0 + w1 + w2); w0 *= inv; w1 *= inv; w2 *= inv;
#pragma unroll
        for (int i = 0; i < 16; ++i) v[i] = 0.f;
#pragma unroll
        for (int p = 0; p < 3; ++p) { const float w = (p == 0) ? w0 : (p == 1 ? w1 : w2); const bf16_t* src = DSAO + ((size_t)p * M + m) * 384 + c0;
            const u32x4 a = *(const u32x4*)src, c = *(const u32x4*)(src + 8);
#pragma unroll
            for (int i = 0; i < 4; ++i) { v[2 * i] += w * bflo(a[i]); v[2 * i + 1] += w * bfhi(a[i]); v[8 + 2 * i] += w * bflo(c[i]); v[8 + 2 * i + 1] += w * bfhi(c[i]); } }
    } else {
        const int c0 = 16 * lane - 640;
        const u32x4 a = *(const u32x4*)(FOXO + m * 384 + c0), c = *(const u32x4*)(FOXO + m * 384 + c0 + 8);
#pragma unroll
        for (int i = 0; i < 4; ++i) { v[2 * i] = bflo(a[i]); v[2 * i + 1] = bfhi(a[i]); v[8 + 2 * i] = bflo(c[i]); v[8 + 2 * i + 1] = bfhi(c[i]); }
    }
    float ss = 0.f;
#pragma unroll
    for (int i = 0; i < 16; ++i) ss += v[i] * v[i];
    const int seg = (lane < 16) ? 0 : (lane < 40 ? 1 : 2);
    const float s0 = wave_sum(seg == 0 ? ss : 0.f), s1 = wave_sum(seg == 1 ? ss : 0.f), s2 = wave_sum(seg == 2 ? ss : 0.f);
    const float rs = (seg == 0) ? 1.0f / sqrtf(s0 * (1.0f / 256.0f) + EPS) : (seg == 1) ? 1.0f / sqrtf(s1 * (1.0f / 384.0f) + EPS) : 1.0f / sqrtf(s2 * (1.0f / 384.0f) + EPS);
    u32x4 o0, o1;
#pragma unroll
    for (int i = 0; i < 4; ++i) { const f32x4 g = *(const f32x4*)(gm + 16 * lane + 4 * i);
        const unsigned lo = cvtpk(v[4 * i] * rs * g[0], v[4 * i + 1] * rs * g[1]), hh = cvtpk(v[4 * i + 2] * rs * g[2], v[4 * i + 3] * rs * g[3]);
        if (i < 2) { o0[2 * i] = lo; o0[2 * i + 1] = hh; } else { o1[2 * (i - 2)] = lo; o1[2 * (i - 2) + 1] = hh; } }
    if (lane >= 16) { *(u32x4*)(OUT + m * 1024 + 16 * lane) = o0; *(u32x4*)(OUT + m * 1024 + 16 * lane + 8) = o1; }
}
template <int PH> __device__ __forceinline__ void run_phase(const Params& P, const int l, LAS unsigned char* lds, const int wave0, const int umax = 1 << 30) {
    constexpr size_t WS_PRM = 58 * MiB; constexpr int PRM_L = 8192, PR_GPOST = 0, PR_GPREF = 1024, PR_GPOSTF = 2048, PR_GMIX = 3072, PR_GPRE = 4096, PR_BGLU = 5120, PR_SD = 5376, PR_BF = 5632;
#define WSBASE() unsigned char* ws = P.ws; asm volatile("" : "+s"(ws)); float* const Pout = P.out; const float* const Px = P.in[I_X]; (void)Pout; (void)Px; int wave_s = wave0; asm volatile("" : "+s"(wave_s)); int lane_v; asm volatile("v_mbcnt_lo_u32_b32 %0, -1, 0\n\tv_mbcnt_hi_u32_b32 %0, -1, %0" : "=v"(lane_v)); const int tid = wave_s * 64 + lane_v; int bid = blockIdx.x; asm volatile("" : "+s"(bid)); int G = gridDim.x; asm volatile("" : "+s"(G)); const int lane = lane_v, wave = wave_s, gw = bid * 8 + wave, NGW = G * 8; (void)lane; (void)gw; (void)NGW
    if constexpr (PH == 0) {
    {
        WSBASE();
        bf16_t* WinT = (bf16_t*)(ws + WS_WIN); bf16_t* WoutT = (bf16_t*)(ws + WS_WOUT); bf16_t* WguT = (bf16_t*)(ws + WS_WGU); bf16_t* WdnT = (bf16_t*)(ws + WS_WDN); bf16_t* WgluT = (bf16_t*)(ws + WS_WGLU);
        float* ABAR = (float*)(ws + WS_ABAR); bf16_t* BB = (bf16_t*)(ws + WS_BB); bf16_t* CC = (bf16_t*)(ws + WS_CC); float* PRM = (float*)(ws + WS_PRM);
        LAS float* scr = (LAS float*)(lds + wave * 16384);
        constexpr int I_IN = 16 * 88, I_OUT = 16 * 32, I_GU = 16 * 176, I_DN = 44 * 32, I_GL = 4 * 8, I_ALL = I_IN + I_OUT + I_GU + I_DN + I_GL;
        for (int it = gw; it < 2 * I_ALL; it += NGW) {
            const int l = it / I_ALL; int r = it % I_ALL;
            if (r < I_IN) { const int kb = r / 88, nb = r % 88; tr_item(P.in[I_WIN] + (size_t)l * 1024 * NIN, 1024, NIN, WinT + (size_t)l * NINP * 1024, 64 * kb, 32 * nb, 32 * nb, scr, lane); continue; } r -= I_IN;
            if (r < I_OUT) { const int kb = r / 32, nb = r % 32; tr_item(P.in[I_WOUT] + (size_t)l * 1024 * 1024, 1024, 1024, WoutT + (size_t)l * 1024 * 1024, 64 * kb, 32 * nb, 32 * nb, scr, lane); continue; } r -= I_OUT;
            if (r < I_GU) { const int kb = r / 176, nb = r % 176, c0 = 32 * nb, half = (c0 >= DFF) ? 1 : 0, cc = c0 - half * DFF, dr = 256 * (cc / 128) + 128 * half + (cc % 128);
                tr_item(P.in[I_WGU] + (size_t)l * 1024 * NGU, 1024, NGU, WguT + (size_t)l * NGU * 1024, 64 * kb, c0, dr, scr, lane); continue; } r -= I_GU;
            if (r < I_DN) { const int kb = r / 32, nb = r % 32; tr_item(P.in[I_WDN] + (size_t)l * DFF * 1024, DFF, 1024, WdnT + (size_t)l * 1024 * DFF, 64 * kb, 32 * nb, 32 * nb, scr, lane); continue; } r -= I_DN;
            { const int kb = r / 8, nb = r % 8; tr_item(P.in[I_WGLU] + (size_t)l * 256 * 256, 256, 256, WgluT + (size_t)l * 256 * 256, 64 * kb, 32 * nb, 32 * nb, scr, lane); }
        }
        for (int e = bid * 512 + tid; e < 2 * 16 * 64; e += G * 512) {
            const int lg = e >> 6, p = e & 63;
            const float dt = expf(P.in[I_LDT][lg]), ar = P.in[I_ARE][e], ai = P.in[I_AIM][e];
            const float decay = expf(ar * dt); float sn, cs; sincos_rr(ai * dt, sn, cs);
            const float are = decay * cs, aim = decay * sn, mag2 = ar * ar + ai * ai;
            const float cre = ((are - 1.0f) * ar + aim * ai) / mag2, cim = (aim * ar - (are - 1.0f) * ai) / mag2;
            ABAR[2 * e] = are; ABAR[2 * e + 1] = aim;
            for (int c = 0; c < 16; ++c) { const float br = P.in[I_BRE][(size_t)e * 16 + c], bi = P.in[I_BIM][(size_t)e * 16 + c];
                BB[((size_t)lg * 128 + p) * 16 + c] = (bf16_t)(cvtpk(cre * br - cim * bi, 0.f) & 0xffffu);
                BB[((size_t)lg * 128 + 64 + p) * 16 + c] = (bf16_t)(cvtpk(cre * bi + cim * br, 0.f) & 0xffffu);
                *(unsigned*)(CC + ((size_t)lg * 16 + c) * 128 + 2 * p) = cvtpk(P.in[I_CRE][((size_t)lg * 16 + c) * 64 + p], -P.in[I_CIM][((size_t)lg * 16 + c) * 64 + p]); }
        }
        for (int e = bid * 512 + tid; e < 2 * 1024; e += G * 512) { const int l = e >> 10, c = e & 1023; float* pr = PRM + l * PRM_L;
            pr[PR_GPOST + c] = P.in[I_GPOST][e]; pr[PR_GPREF + c] = P.in[I_GPREF][e]; pr[PR_GPOSTF + c] = P.in[I_GPOSTF][e]; pr[PR_GMIX + c] = P.in[I_GMIX][e]; pr[PR_GPRE + c] = P.in[I_GPRE][e];
            if (c < 256) { pr[PR_BGLU + c] = P.in[I_BGLU][l * 256 + c]; pr[PR_SD + c] = P.in[I_SD][l * 256 + c]; }
            if (c < 8) pr[PR_BF + c] = (c < 6) ? P.in[I_BF][l * 6 + c] : 0.f; }
        row_phase<false, 0, 2>(Px, nullptr, (float*)(ws + 60 * MiB), (const bf16_t*)(ws + WS_BUFB), nullptr, nullptr, P.in[I_GPRE], (bf16_t*)(ws + WS_BUFA), gw, NGW, lane);
    }
    }
    if constexpr (PH == 1) {
        { WSBASE(); pg8::Gemm g{(bf16_t*)(ws + WS_BUFA), (bf16_t*)(ws + WS_WIN) + (size_t)l * NINP * 1024, M, NINP, 1024}; pg8::StaticOrder S; S.init(M, NINP, G, bid);
          pg8::EpiProj E{(bf16_t*)(ws + WS_PROJ), (float*)(ws + WS_FL), (const float*)(ws + WS_PRM) + l * PRM_L + PR_BF};
          pg8::gemm_phase<pg8::EpiProj, pg8::StaticOrder, true, true>(lds, g, S, E, wave); }
    }
    if constexpr (PH == 2) {
        {
            WSBASE();
            const bf16_t* PROJ = (const bf16_t*)(ws + WS_PROJ); float* FL = (float*)(ws + WS_FL);
            constexpr int NU_SSM = 64, NU_FOX = NB * 6 * 8, NU_DSA = NB * 3 * 48;
            unsigned* qctr = (unsigned*)(ws + WS_CTL) + 64 * l; LAS int* uq = (LAS int*)(lds + LDS_BYTES - 64);
#ifdef STATIC_Q
            (void)qctr; (void)uq;
            for (int u = bid; u < NU_SSM + NU_FOX + NU_DSA; u += G) {
#else
            (void)qctr; (void)umax;
            unsigned* qb8 = (unsigned*)(ws + WS_CTL) + (size_t)(l * 8) * 64;
            const int xcd = (int)(((unsigned)__builtin_amdgcn_s_getreg((3 << 11) | 20)) & 7u);
            int qs = 0;
            for (;;) {
                __syncthreads();
                if (tid == 0) { int code = -1;
                    for (; qs < 8; ++qs) { const int xq = (xcd + qs) & 7; const int j = (int)__hip_atomic_fetch_add(qb8 + xq * 64, 1u, __ATOMIC_RELAXED, __HIP_MEMORY_SCOPE_AGENT); if (j < 776) { code = xq * 1024 + j; break; } }
                    *uq = code; }
                __syncthreads();
                const int code = __builtin_amdgcn_readfirstlane(*uq);
                if (code < 0) break;
                int u; { const int xq = code >> 10, j = code & 1023;
                    if (j < 8) u = xq * 8 + j;
                    else if (j < 200) { const int jj = j - 8; u = NU_SSM + (jj / 24) * 192 + (jj % 24) * 8 + xq; }
                    else { const int jj = j - 200, idx = (jj / 48) * 8 + xq; u = NU_SSM + NU_FOX + (idx / 3) * 144 + (idx % 3) * 48 + (jj % 48); } }
#endif
                if (u < NU_SSM) { const int wu = u * 8 + wave;
                    ssm_wave(PROJ, (const float*)(ws + WS_ABAR) + (size_t)l * 16 * 64 * 2, (const bf16_t*)(ws + WS_BB) + (size_t)l * 16 * 128 * 16, (const bf16_t*)(ws + WS_CC) + (size_t)l * 16 * 16 * 128,
                             (const float*)(ws + WS_PRM) + l * PRM_L + PR_SD, (bf16_t*)(ws + WS_G), lds + wave * SSM_WAVE_LDS, wu >> 4, wu & 15, lane);
                } else if (u < NU_SSM + NU_FOX) { const int v = u - NU_SSM, qb = 7 - v / 192, bh = v % 192;
                    fox_unit(PROJ, FL, (bf16_t*)(ws + WS_FOXO), lds, bh / 6, bh % 6, qb, tid, lane, wave);
                } else { const int v = u - NU_SSM - NU_FOX, b = v / 144, rem = v % 144, hp = rem / 48, j = rem % 48, pat = j >> 4, jj = j & 15;
                    const int res = (pat == 0) ? 0 : (pat == 1 ? (jj & 3) : jj), n = (pat == 0) ? jj : (pat == 1 ? (jj >> 2) : 0);
                    dsa_unit(PROJ, (bf16_t*)(ws + WS_DSAO), (float*)(ws + WS_LSE), lds, b, hp, pat, res, n, tid, lane, wave);
                }
            }
        }
    }
    if constexpr (PH == 3) {
        { WSBASE(); int kglu = 256; asm volatile("" : "+s"(kglu)); pg8::Gemm g{(bf16_t*)(ws + WS_G), (bf16_t*)(ws + WS_WGLU) + (size_t)l * 256 * 256, M, 256, kglu}; pg8::StaticOrder S; S.init(M, 256, G, bid);
          pg8::EpiGLUNorm E{(bf16_t*)(ws + WS_G), (bf16_t*)(ws + WS_PROJ), (const float*)(ws + WS_PRM) + l * PRM_L + PR_BGLU, (const float*)(ws + WS_PRM) + l * PRM_L + PR_GMIX};
          pg8::gemm_phase<pg8::EpiGLUNorm, pg8::StaticOrder, false, true>(lds, g, S, E, wave);
          bf16_t* d_ = (bf16_t*)(ws + WS_DSAO); float* e_ = (float*)(ws + WS_LSE); bf16_t* f_ = (bf16_t*)(ws + WS_FOXO); const float* g_ = (const float*)(ws + WS_PRM) + l * PRM_L + PR_GMIX; bf16_t* o_ = (bf16_t*)(ws + WS_PROJ);
          for (int m = gw; m < M; m += 2 * NGW) { merge_row(nullptr, d_, e_, f_, g_, o_, (size_t)m, lane); if (m + NGW < M) merge_row(nullptr, d_, e_, f_, g_, o_, (size_t)(m + NGW), lane); } }
    }
    if constexpr (PH == 4) {
    }
    if constexpr (PH == 5) {
        { WSBASE(); pg8::Gemm g{(bf16_t*)(ws + WS_PROJ), (bf16_t*)(ws + WS_WOUT) + (size_t)l * 1024 * 1024, M, 1024, 1024}; pg8::StaticOrder S; S.init(M, 1024, G, bid);
          pg8::EpiBf16<0> E{(bf16_t*)(ws + WS_BUFB), 1024, nullptr, 0, 0, 1.f};
          pg8::gemm_phase<pg8::EpiBf16<0>, pg8::StaticOrder, true, true>(lds, g, S, E, wave); }
    }
    if constexpr (PH == 6) {
        { WSBASE(); const float* xin = (l == 0) ? Px : Pout; const float* pr = (const float*)(ws + WS_PRM) + l * PRM_L;
          (void)xin; float* rn = (float*)(ws + 60 * MiB);
          row_phase<true, 2, 2>((const bf16_t*)(ws + WS_BUFA), pr + PR_GPRE, rn, (const bf16_t*)(ws + WS_BUFB), pr + PR_GPOST, nullptr, pr + PR_GPREF, (bf16_t*)(ws + WS_BUFA), gw, NGW, lane); }
    }
    if constexpr (PH == 7) {
        { WSBASE(); pg8::Gemm g{(bf16_t*)(ws + WS_BUFA), (bf16_t*)(ws + WS_WGU) + (size_t)l * NGU * 1024, M, NGU, 1024}; pg8::StaticOrder S; S.init(M, NGU, G, bid);
          pg8::EpiSwiGLU E{(bf16_t*)(ws + WS_PROJ)};
          pg8::gemm_phase<pg8::EpiSwiGLU, pg8::StaticOrder, true, true>(lds, g, S, E, wave); }
    }
    if constexpr (PH == 8) {
        { WSBASE(); pg8::Gemm g{(bf16_t*)(ws + WS_PROJ), (bf16_t*)(ws + WS_WDN) + (size_t)l * 1024 * DFF, M, 1024, DFF}; pg8::StaticOrder S; S.init(M, 1024, G, bid);
          pg8::EpiBf16<0> E{(bf16_t*)(ws + WS_BUFB), 1024, nullptr, 0, 0, 1.f};
          pg8::gemm_phase<pg8::EpiBf16<0>, pg8::StaticOrder, true, true>(lds, g, S, E, wave); }
    }
    if constexpr (PH == 9) {
        { WSBASE(); const float* pr = (const float*)(ws + WS_PRM);
          float* rn = (float*)(ws + 60 * MiB); const bf16_t* xnb = (const bf16_t*)(ws + WS_BUFA);
          if (l == 0) row_phase<true, 2, 2>(xnb, pr + l * PRM_L + PR_GPREF, rn, (const bf16_t*)(ws + WS_BUFB), pr + l * PRM_L + PR_GPOSTF, nullptr, pr + PRM_L + PR_GPRE, (bf16_t*)(ws + WS_BUFA), gw, NGW, lane);
          else row_phase<true, 2, 0>(xnb, pr + l * PRM_L + PR_GPREF, rn, (const bf16_t*)(ws + WS_BUFB), pr + l * PRM_L + PR_GPOSTF, Pout, pr + PRM_L + PR_GPRE, nullptr, gw, NGW, lane); }
    }
#undef WSBASE
}

template <int PH> __global__ void __launch_bounds__(512, 2) phase_k(Params P, int l) {
    extern __shared__ __attribute__((aligned(16))) unsigned char lds_raw[];
    const int wave0 = __builtin_amdgcn_readfirstlane(threadIdx.x >> 6);
    run_phase<PH>(P, l, (LAS unsigned char*)lds_raw, wave0);
}
#ifdef MEGA
__global__ void __launch_bounds__(512, 2) mega(Params P) {
    extern __shared__ __attribute__((aligned(16))) unsigned char lds_raw[];
    LAS unsigned char* lds = (LAS unsigned char*)lds_raw;
    const int wave0 = __builtin_amdgcn_readfirstlane(threadIdx.x >> 6);
    volatile LAS unsigned* bst = (volatile LAS unsigned*)(lds + LDS_BYTES - 32);
    if (threadIdx.x < 2) bst[threadIdx.x] = 0u;
    __syncthreads();
    unsigned* barw; { GAS unsigned char* wsg_ = (GAS unsigned char*)P.ws; barw = (unsigned*)(unsigned char*)(wsg_ + WS_CTL) + 4096; }
    XcdBarrier xb = xcd_barrier_post(barw, bst, (int)threadIdx.x);
#define GRIDBAR() do { int lane_b; asm volatile("v_mbcnt_lo_u32_b32 %0, -1, 0\n\tv_mbcnt_hi_u32_b32 %0, -1, %0" : "=v"(lane_b)); xcd_barrier(xb, wave0 * 64 + lane_b); } while (0)
    cg::this_grid().sync();
    run_phase<0>(P, 0, lds, wave0);
    GRIDBAR();
    const int tidz = (int)(blockIdx.x * 512 + threadIdx.x); (void)tidz;
#pragma unroll 1
    for (int l = 0; l < 2; ++l) {
        run_phase<1>(P, l, lds, wave0); GRIDBAR();
        run_phase<2>(P, l, lds, wave0); GRIDBAR();
#if defined(DUP_PH) && DUP_PH == 2
        if (tidz == 0) { unsigned* qc = (unsigned*)(P.ws + WS_CTL) + 64 * l; __hip_atomic_store(qc, (unsigned)DUP_UMIN, __ATOMIC_RELAXED, __HIP_MEMORY_SCOPE_AGENT); }
        GRIDBAR(); run_phase<2>(P, l, lds, wave0, DUP_UMAX); GRIDBAR();
#endif
        run_phase<3>(P, l, lds, wave0); GRIDBAR();
        run_phase<5>(P, l, lds, wave0); GRIDBAR();
        run_phase<6>(P, l, lds, wave0); GRIDBAR();
        run_phase<7>(P, l, lds, wave0); GRIDBAR();
        run_phase<8>(P, l, lds, wave0); GRIDBAR();
        run_phase<9>(P, l, lds, wave0);
        if (l == 0) GRIDBAR();
    }
#undef GRIDBAR
}
#endif


__global__ void dbg_copy(const bf16_t* src, float* out, int ld, int ncol, int planes = 1) {
    const size_t m = blockIdx.x;
    for (int c = threadIdx.x; c < 1024; c += blockDim.x) { float a = 0.f; for (int pl = 0; pl < planes; ++pl) for (int k = c; k < ncol; k += 1024) a += bf2f(src[((size_t)pl * M + m) * ld + k]); out[m * 1024 + c] = a; }
}
__global__ void dbg_prm(const unsigned char* ws, float* out) {
    const int i = blockIdx.x * blockDim.x + threadIdx.x;
    if (i < 4096) out[i] = ((const float*)(ws + WS_ABAR))[i];
    else if (i < 4096 + 65536) out[i] = bf2f(((const bf16_t*)(ws + WS_BB))[i - 4096]);
    else if (i < 4096 + 131072) out[i] = bf2f(((const bf16_t*)(ws + WS_CC))[i - 4096 - 65536]);
    else if (i < 4096 + 131072 + 16384) out[i] = ((const float*)(ws + 58 * MiB))[i - 4096 - 131072];
}
template <int PH> static void launch_phase(const Params& p, int l, int grid, hipStream_t stream) {
    static bool attr = false;
    if (!attr) { (void)hipFuncSetAttribute((const void*)phase_k<PH>, hipFuncAttributeMaxDynamicSharedMemorySize, LDS_BYTES); attr = true; }
    hipLaunchKernelGGL(phase_k<PH>, dim3(grid), dim3(512), LDS_BYTES, stream, p, l);
}
extern "C" void kernel_launch(void* const* d_in, const int* in_sizes, int n_in, void* d_out, int out_size, void* d_ws, size_t ws_size, hipStream_t stream) {
    static int grid = 0;
    if (grid == 0) {
        if (n_in != 21 || in_sizes[0] != M * DM || out_size != M * DM || ws_size < WS_END) { fprintf(stderr, "kernel_launch: unexpected shapes: n_in %d in0 %d out %d ws %zu\n", n_in, n_in > 0 ? in_sizes[0] : -1, out_size, ws_size); grid = -1; return; }
        int dev = 0, cus = 0, per_cu = 1;
        (void)hipGetDevice(&dev); (void)hipDeviceGetAttribute(&cus, hipDeviceAttributeMultiprocessorCount, dev);
#ifdef MEGA
        if (hipFuncSetAttribute((const void*)mega, hipFuncAttributeMaxDynamicSharedMemorySize, LDS_BYTES) != hipSuccess) { fprintf(stderr, "kernel_launch: hipFuncSetAttribute failed\n"); grid = -1; return; }
        if (hipOccupancyMaxActiveBlocksPerMultiprocessor(&per_cu, (const void*)mega, 512, LDS_BYTES) != hipSuccess || per_cu < 1) { fprintf(stderr, "kernel_launch: occupancy query says %d\n", per_cu); per_cu = 1; }
        (void)hipGetLastError();
#endif
        grid = cus * per_cu;
    }
    if (grid < 0) return;
    if (hipMemsetAsync((char*)d_ws + WS_CTL, 0, 65536, stream) != hipSuccess) { fprintf(stderr, "kernel_launch: memset failed\n"); return; }
    Params p{};
    for (int i = 0; i < 21; ++i) p.in[i] = (const float*)d_in[i];
    p.out = (float*)d_out; p.ws = (unsigned char*)d_ws;
#ifdef MEGA
    void* args[] = {&p};
    hipError_t e = hipLaunchCooperativeKernel((const void*)mega, dim3(grid), dim3(512), args, LDS_BYTES, stream);
    if (e != hipSuccess) fprintf(stderr, "kernel_launch: cooperative launch failed: %s (grid %d)\n", hipGetErrorString(e), grid);
#else
    launch_phase<0>(p, 0, grid, stream);
#if defined(DBG_STOP) && DBG_STOP == 100
    hipLaunchKernelGGL(dbg_prm, dim3(640), dim3(256), 0, stream, (const unsigned char*)d_ws, (float*)d_out); return;
#endif
    for (int l = 0; l < 2; ++l) {
#if defined(DBG_STOP) && DBG_STOP == 1
        launch_phase<1>(p, l, grid, stream); hipLaunchKernelGGL(dbg_copy, dim3(M), dim3(256), 0, stream, (const bf16_t*)((unsigned char*)d_ws + WS_PROJ), (float*)d_out, LDP, LDP); return;
#endif
#if defined(DBG_STOP) && DBG_STOP == 21
        launch_phase<1>(p, l, grid, stream); launch_phase<2>(p, l, grid, stream); hipLaunchKernelGGL(dbg_copy, dim3(M), dim3(256), 0, stream, (const bf16_t*)((unsigned char*)d_ws + WS_FOXO), (float*)d_out, 384, 384, 1); return;
#endif
#if defined(DBG_STOP) && DBG_STOP == 22
        launch_phase<1>(p, l, grid, stream); launch_phase<2>(p, l, grid, stream); hipLaunchKernelGGL(dbg_copy, dim3(M), dim3(256), 0, stream, (const bf16_t*)((unsigned char*)d_ws + WS_DSAO), (float*)d_out, 384, 384, 3); return;
#endif
#if defined(DBG_STOP) && DBG_STOP == 23
        launch_phase<1>(p, l, grid, stream); launch_phase<2>(p, l, grid, stream); hipLaunchKernelGGL(dbg_copy, dim3(M), dim3(256), 0, stream, (const bf16_t*)((unsigned char*)d_ws + WS_G), (float*)d_out, 256, 256, 1); return;
#endif
#if defined(DBG_STOP) && DBG_STOP == 4
        launch_phase<1>(p, l, grid, stream); launch_phase<2>(p, l, grid, stream); launch_phase<3>(p, l, grid, stream); launch_phase<4>(p, l, grid, stream);
        hipLaunchKernelGGL(dbg_copy, dim3(M), dim3(256), 0, stream, (const bf16_t*)((unsigned char*)d_ws + WS_BUFA), (float*)d_out, 1024, 1024); return;
#endif
        launch_phase<1>(p, l, grid, stream); launch_phase<2>(p, l, grid, stream); launch_phase<3>(p, l, grid, stream); launch_phase<4>(p, l, grid, stream); launch_phase<5>(p, l, grid, stream);
        launch_phase<6>(p, l, grid, stream); launch_phase<7>(p, l, grid, stream); launch_phase<8>(p, l, grid, stream); launch_phase<9>(p, l, grid, stream);
    }
#endif
}
```

```cpp
#define MEGA 1
#include <hip/hip_runtime.h>
#include <hip/hip_cooperative_groups.h>
#include <cstdio>
#include <cstdint>
namespace cg = cooperative_groups;
namespace pg8 {
#define PG8_LAS __attribute__((address_space(3)))
typedef unsigned short bf16_t;
typedef short bf16x8 __attribute__((ext_vector_type(8)));
typedef float f32x4 __attribute__((ext_vector_type(4)));
typedef unsigned u32x4 __attribute__((ext_vector_type(4)));
constexpr int BM = 256, BK = 64, HALF = 128, HTB = HALF * BK * 2  , STAGE_BYTES = 8 * HTB, NXCD = 8, WGM = 8;

__host__ __device__ __forceinline__ int lds_byte(int r, int c) { const int st = (r >> 4) * 2 + (c >> 5), rr = r & 15, cc = c & 31, ob = rr * 64 + cc * 2; return st * 1024 + (ob ^ (((ob >> 9) & 1) << 5)); }
__host__ __device__ __forceinline__ void stage_rc(int b, int& R, int& C) { const int st = b / 1024, sb = b % 1024, swz = sb ^ (((sb >> 9) & 1) << 5); R = (st >> 1) * 16 + swz / 64; C = (st & 1) * 32 + (swz % 64) / 2; }
__host__ __device__ __forceinline__ int perm32(int rho) { const int n = rho >> 4, i = rho & 15; return 8 * (i >> 2) + 4 * n + (i & 3); }

struct Unit { int pm, pn; };
struct Gemm { const bf16_t* A; const bf16_t* Bt; int M, N, K; };

struct StaticOrder {
    int nM, nN, nwg, G, c;
    __host__ __device__ void init(int M, int N, int G_, int c_) { nM = M / BM; nN = N / BM; nwg = nM * nN; G = G_; c = c_; }
    __host__ __device__ bool next(int i, Unit& u) const {
        const long L = (long)i * G + c; if (L >= nwg) return false;
        int wgid = (int)L; { const int q = nwg / NXCD, r = nwg % NXCD, xcd = wgid % NXCD, off = wgid / NXCD; wgid = (xcd < r ? xcd * (q + 1) : r * (q + 1) + (xcd - r) * q) + off; }
        const int nig = WGM * nN, gid = wgid / nig, fm = gid * WGM, gsz = (nM - fm) < WGM ? (nM - fm) : WGM;
        u.pm = fm + ((wgid % nig) % gsz); u.pn = (wgid % nig) / gsz; return true;
    }
    __device__ __forceinline__ void a_ready(const Unit&) const {}
    __device__ __forceinline__ void done(const Unit&) const {}
};

__device__ __forceinline__ unsigned cvt_pk_bf16(float lo, float hi) { unsigned r; asm volatile("v_cvt_pk_bf16_f32 %0, %1, %2" : "=v"(r) : "v"(lo), "v"(hi)); return r; }
typedef float f32x2 __attribute__((ext_vector_type(2)));
__device__ __forceinline__ f32x2 gelu_pk(f32x2 v) {
    const f32x2 av = __builtin_elementwise_abs(v), d = av * 0.2316418882f + 1.0f;
    f32x2 t; t.x = __builtin_amdgcn_rcpf(d.x); t.y = __builtin_amdgcn_rcpf(d.y);
    f32x2 q = t * 0.5307027145f + (-0.7265760135f); q = q * t + 0.7107068705f; q = q * t + (-0.142248368f); q = q * t + 0.127414796f; q = q * t;
    const f32x2 s = (v * v) * (-0.72134752044f);
    f32x2 e; e.x = __builtin_amdgcn_exp2f(s.x); e.y = __builtin_amdgcn_exp2f(s.y);
    const f32x2 m = v * (q * e), r = v - m;
    f32x2 o; o.x = v.x < 0.f ? m.x : r.x; o.y = v.y < 0.f ? m.y : r.y; return o;
}

template <int ACT  > struct EpiBf16 {
    static constexpr bool PERM = true, AFTER_DRAIN = false; static_assert(ACT == 0 || ACT == 1, "EpiBf16: ACT is 0 (none) or 1 (gelu_pk)");
    bf16_t* O; int ldc; const float* bias; int split_cols; size_t split_stride; float scale0;
    __device__ __forceinline__ void operator()(const f32x4 (&acc)[2][2][4][2], const Unit& u, int wr, int wc, int fr, int fq) const {
        const int row0 = u.pm * BM + wr * 64 + fr; int colt = u.pn * BM; bf16_t* base = O;
        float sc = 1.f; if (split_cols) { const int t = colt / split_cols; base += (size_t)t * split_stride; colt -= t * split_cols; if (t == 0) sc = scale0; }
        const int col0 = colt + wc * 32 + 8 * fq, bcol0 = u.pn * BM + wc * 32 + 8 * fq;
        f32x4 bv[2][2];
#pragma unroll
        for (int bj = 0; bj < 2; ++bj)
#pragma unroll
            for (int n = 0; n < 2; ++n) bv[bj][n] = bias ? *(const f32x4*)(bias + bcol0 + bj * HALF + 4 * n) : (f32x4){0.f, 0.f, 0.f, 0.f};
#pragma unroll
        for (int ai = 0; ai < 2; ++ai)
#pragma unroll
            for (int m = 0; m < 4; ++m) { bf16_t* rowp = base + (size_t)(row0 + ai * HALF + m * 16) * ldc + col0;
#pragma unroll
                for (int bj = 0; bj < 2; ++bj) { f32x4 v0 = acc[ai][bj][m][0] + bv[bj][0], v1 = acc[ai][bj][m][1] + bv[bj][1];
                    if (ACT == 1) { f32x2 a = gelu_pk((f32x2){v0[0], v0[1]}), b = gelu_pk((f32x2){v0[2], v0[3]}), c = gelu_pk((f32x2){v1[0], v1[1]}), d = gelu_pk((f32x2){v1[2], v1[3]});
                        v0 = (f32x4){a.x, a.y, b.x, b.y}; v1 = (f32x4){c.x, c.y, d.x, d.y}; }
                    v0 = v0 * sc; v1 = v1 * sc; u32x4 w; w.x = cvt_pk_bf16(v0[0], v0[1]); w.y = cvt_pk_bf16(v0[2], v0[3]); w.z = cvt_pk_bf16(v1[0], v1[1]); w.w = cvt_pk_bf16(v1[2], v1[3]);
                    *(u32x4*)(rowp + bj * HALF) = w; } }
    }
};
template <class Epi, class Sched, bool ALIGN_EPI = false, bool SP2 = false>
__device__ __forceinline__ void gemm_phase(PG8_LAS unsigned char* lds, const Gemm g, const Sched& S, const Epi& E, const int wave_in) {
    int lane_l; asm volatile("v_mbcnt_lo_u32_b32 %0, -1, 0\n\tv_mbcnt_hi_u32_b32 %0, -1, %0" : "=v"(lane_l));
    const int wid = wave_in, lane = lane_l, tid = wid * 64 + lane, wr = wid >> 2, wc = wid & 3, fr = lane & 15, fq = lane >> 4;
    const int K = g.K, nt = K / BK;
    unsigned voffA[2], voffB[2];
#pragma unroll
    for (int i = 0; i < 2; ++i) { int R, C; stage_rc(tid * 16 + i * 8192, R, C); const int Rb = Epi::PERM ? ((R & ~31) + perm32(R & 31)) : R;
        voffA[i] = (unsigned)(R * K + C) * 2u; voffB[i] = (unsigned)(Rb * K + C) * 2u; }
    const size_t kstep = (size_t)(BK * 2);
    const size_t hstep = (size_t)HALF * K * 2;
    const size_t tstep = 2 * hstep;
    const unsigned ldsw = (unsigned)wid * 1024u;
    const int aoff = lds_byte(wr * 64 + fr, fq * 8), boff = lds_byte(wc * 32 + fr, fq * 8);
#define PG8_SA(b, h) (((b) * 2 + (h)) * HTB)
#define PG8_SB(b, h) ((4 + (b) * 2 + (h)) * HTB)
#define PG8_STAGE(bufoff, gbase, voff) do { _Pragma("unroll") for (int _i = 0; _i < 2; ++_i) \
        __builtin_amdgcn_global_load_lds((const unsigned*)((const char*)(gbase) + (voff)[_i]), (PG8_LAS unsigned*)(lds + (bufoff) + ldsw + _i * 8192), 16, 0, 0); } while (0)
#define PG8_LDA(dst, b, h) do { _Pragma("unroll") for (int m = 0; m < 4; ++m) _Pragma("unroll") for (int k = 0; k < 2; ++k) dst[m][k] = *(const PG8_LAS bf16x8*)(lds + PG8_SA(b, h) + aoff + m * 2048 + k * 1024); } while (0)
#define PG8_LDB(dst, b, h) do { _Pragma("unroll") for (int n = 0; n < 2; ++n) _Pragma("unroll") for (int k = 0; k < 2; ++k) dst[n][k] = *(const PG8_LAS bf16x8*)(lds + PG8_SB(b, h) + boff + n * 2048 + k * 1024); } while (0)
#define PG8_MMA(ai, bj, At, Bt) do { __builtin_amdgcn_s_setprio(1); _Pragma("unroll") for (int m = 0; m < 4; ++m) _Pragma("unroll") for (int n = 0; n < 2; ++n) _Pragma("unroll") for (int k = 0; k < 2; ++k) \
        acc[ai][bj][m][n] = __builtin_amdgcn_mfma_f32_16x16x32_bf16(Bt[n][k], At[m][k], acc[ai][bj][m][n], 0, 0, 0); __builtin_amdgcn_s_setprio(0); } while (0)
#define PG8_WAIT_V(n) asm volatile("s_waitcnt vmcnt(" #n ")" ::: "memory")
#define PG8_WAIT_L(n) asm volatile("s_waitcnt lgkmcnt(" #n ")" ::: "memory")
#define PG8_BAR __builtin_amdgcn_s_barrier()
#define PG8_SCHED __builtin_amdgcn_sched_barrier(0)
    Unit cur, nxt; int ui = 0;
    if (!S.next(0, cur)) return;
    f32x4 acc[2][2][4][2];
#pragma unroll
    for (int a = 0; a < 2; ++a)
#pragma unroll
        for (int b = 0; b < 2; ++b)
#pragma unroll
            for (int m = 0; m < 4; ++m)
#pragma unroll
                for (int n = 0; n < 2; ++n) acc[a][b][m][n] = (f32x4){0.f, 0.f, 0.f, 0.f};
    bf16x8 At[4][2], B0[2][2], B1[2][2];
    const char* cA = (const char*)g.A + (size_t)cur.pm * tstep; const char* cB = (const char*)g.Bt + (size_t)cur.pn * tstep;
    S.a_ready(cur);
    if constexpr (SP2) {
        PG8_STAGE(PG8_SB(0, 0), cB, voffB); PG8_STAGE(PG8_SB(0, 1), cB + hstep, voffB); PG8_STAGE(PG8_SA(0, 0), cA, voffA); PG8_STAGE(PG8_SA(0, 1), cA + hstep, voffA);
        if (wr == 1) PG8_BAR;
        PG8_WAIT_V(2); PG8_BAR;
        PG8_STAGE(PG8_SB(1, 0), cB + kstep, voffB); PG8_STAGE(PG8_SA(1, 0), cA + kstep, voffA); PG8_STAGE(PG8_SB(1, 1), cB + hstep + kstep, voffB);
        PG8_WAIT_V(6); PG8_BAR;
    } else {
        PG8_STAGE(PG8_SB(0, 0), cB, voffB); PG8_STAGE(PG8_SA(0, 0), cA, voffA); PG8_STAGE(PG8_SB(0, 1), cB + hstep, voffB); PG8_STAGE(PG8_SA(0, 1), cA + hstep, voffA);
        if (wr == 1) PG8_BAR;
        PG8_WAIT_V(4); PG8_BAR;
        PG8_STAGE(PG8_SB(1, 0), cB + kstep, voffB); PG8_STAGE(PG8_SA(1, 0), cA + kstep, voffA); PG8_STAGE(PG8_SB(1, 1), cB + hstep + kstep, voffB);
        PG8_WAIT_V(6); PG8_BAR;
    }
    for (;;) {
        const bool has_next = S.next(ui + 1, nxt);
        const char* nA = has_next ? (const char*)g.A + (size_t)nxt.pm * tstep : cA; const char* nB = has_next ? (const char*)g.Bt + (size_t)nxt.pn * tstep : cB;
        for (int t = 0; t < nt; t += 2) {
            const bool last = (t == nt - 2);
            const char* a1 = cA + (size_t)(t + 1) * kstep;
            const char* a2 = last ? nA : cA + (size_t)(t + 2) * kstep; const char* b2 = last ? nB : cB + (size_t)(t + 2) * kstep;
            const char* a3 = a2 + kstep; const char* b3 = b2 + kstep;
            if (last && has_next) S.a_ready(nxt);
            if constexpr (SP2) {
            PG8_LDB(B0, 0, 0); PG8_LDB(B1, 0, 1); PG8_SCHED; PG8_LDA(At, 0, 0); PG8_STAGE(PG8_SA(1, 1), a1 + hstep, voffA);
            PG8_WAIT_V(8); PG8_WAIT_L(0); PG8_BAR; PG8_MMA(0, 0, At, B0); PG8_MMA(0, 1, At, B1); PG8_BAR; PG8_SCHED;
            PG8_LDA(At, 0, 1); PG8_STAGE(PG8_SB(0, 0), b2, voffB); PG8_STAGE(PG8_SB(0, 1), b2 + hstep, voffB); PG8_STAGE(PG8_SA(0, 0), a2, voffA);
            PG8_WAIT_V(8); PG8_WAIT_L(0); PG8_BAR; PG8_MMA(1, 0, At, B0); PG8_MMA(1, 1, At, B1); PG8_BAR; PG8_SCHED;
            PG8_LDB(B0, 1, 0); PG8_LDB(B1, 1, 1); PG8_SCHED; PG8_LDA(At, 1, 0); PG8_STAGE(PG8_SA(0, 1), a2 + hstep, voffA);
            PG8_WAIT_V(8); PG8_WAIT_L(0); PG8_BAR; PG8_MMA(0, 0, At, B0); PG8_MMA(0, 1, At, B1); PG8_BAR; PG8_SCHED;
            PG8_LDA(At, 1, 1); PG8_STAGE(PG8_SB(1, 0), b3, voffB); PG8_STAGE(PG8_SB(1, 1), b3 + hstep, voffB); PG8_STAGE(PG8_SA(1, 0), a3, voffA);
            PG8_WAIT_V(8); PG8_WAIT_L(0); PG8_BAR; PG8_MMA(1, 0, At, B0); PG8_MMA(1, 1, At, B1); PG8_BAR; PG8_SCHED;
            } else {
            PG8_LDB(B0, 0, 0); PG8_SCHED; PG8_LDA(At, 0, 0); PG8_STAGE(PG8_SA(1, 1), a1 + hstep, voffA);
            PG8_WAIT_L(8); PG8_BAR; PG8_WAIT_L(0); PG8_MMA(0, 0, At, B0); PG8_BAR; PG8_SCHED;
            PG8_LDB(B1, 0, 1); PG8_STAGE(PG8_SB(0, 0), b2, voffB);
            PG8_BAR; PG8_WAIT_L(0); PG8_MMA(0, 1, At, B1); PG8_BAR;
            PG8_LDA(At, 0, 1); PG8_STAGE(PG8_SA(0, 0), a2, voffA);
            PG8_BAR; PG8_WAIT_L(0); PG8_MMA(1, 0, At, B0); PG8_BAR; PG8_SCHED;
            PG8_STAGE(PG8_SB(0, 1), b2 + hstep, voffB);
            PG8_WAIT_V(6); PG8_BAR; PG8_MMA(1, 1, At, B1); PG8_BAR;
            PG8_LDB(B0, 1, 0); PG8_SCHED; PG8_LDA(At, 1, 0); PG8_STAGE(PG8_SA(0, 1), a2 + hstep, voffA);
            PG8_WAIT_L(8); PG8_BAR; PG8_WAIT_L(0); PG8_MMA(0, 0, At, B0); PG8_BAR; PG8_SCHED;
            PG8_LDB(B1, 1, 1); PG8_STAGE(PG8_SB(1, 0), b3, voffB);
            PG8_BAR; PG8_WAIT_L(0); PG8_MMA(0, 1, At, B1); PG8_BAR;
            PG8_LDA(At, 1, 1); PG8_STAGE(PG8_SA(1, 0), a3, voffA);
            PG8_BAR; PG8_WAIT_L(0); PG8_MMA(1, 0, At, B0); PG8_BAR; PG8_SCHED;
            PG8_STAGE(PG8_SB(1, 1), b3 + hstep, voffB);
            PG8_WAIT_V(6); PG8_BAR; PG8_MMA(1, 1, At, B1); PG8_BAR;
            }
        }
        if constexpr (ALIGN_EPI) { if (wr == 0) PG8_BAR; }
        if constexpr (!Epi::AFTER_DRAIN) { E(acc, cur, wr, wc, fr, fq); S.done(cur); }
        if (!has_next) break;
#pragma unroll
        for (int a = 0; a < 2; ++a)
#pragma unroll
            for (int b = 0; b < 2; ++b)
#pragma unroll
                for (int m = 0; m < 4; ++m)
#pragma unroll
                    for (int n = 0; n < 2; ++n) acc[a][b][m][n] = (f32x4){0.f, 0.f, 0.f, 0.f};
        cur = nxt; cA = nA; cB = nB; ++ui;
        if constexpr (ALIGN_EPI) { if (wr == 1) PG8_BAR; }
    }
    PG8_WAIT_V(0);
    if constexpr (!ALIGN_EPI) { if (wr == 0) PG8_BAR; }
    PG8_BAR;
    if constexpr (Epi::AFTER_DRAIN) { E.fused(acc, cur, wr, wc, fr, fq, lds, wid, lane); S.done(cur); }
#undef PG8_SA
#undef PG8_SB
#undef PG8_STAGE
#undef PG8_LDA
#undef PG8_LDB
#undef PG8_MMA
#undef PG8_WAIT_V
#undef PG8_WAIT_L
#undef PG8_BAR
#undef PG8_SCHED
}
}
#define LAS __attribute__((address_space(3)))
#define GAS __attribute__((address_space(1)))
typedef unsigned short bf16_t;
typedef short bf16x8 __attribute__((ext_vector_type(8)));
typedef float f32x4 __attribute__((ext_vector_type(4)));
typedef float f32x16 __attribute__((ext_vector_type(16)));
typedef unsigned u32x4 __attribute__((ext_vector_type(4)));
typedef unsigned u32x2 __attribute__((ext_vector_type(2)));
constexpr int NB = 32, SEQ = 2048, DM = 1024, M = NB * SEQ;
constexpr int NIN = 2566, NINP = 2816, DFF = 2816, NGU = 5632, LDP = 2816;
constexpr int COL_DQ = 256, COL_DK = 640, COL_DV = 1024, COL_FQ = 1408, COL_FK = 1792, COL_FV = 2176;
constexpr float EPS = 1e-6f, LOG2E = 1.4426950408889634f, QK_C = 0.125f * 1.4426950408889634f;
constexpr size_t MiB = (size_t)1 << 20;
constexpr size_t WS_WIN = 0, WS_WOUT = 11 * MiB, WS_WGU = 15 * MiB, WS_WDN = 37 * MiB, WS_WGLU = 48 * MiB;
constexpr size_t WS_ABAR = 49 * MiB, WS_BB = 49 * MiB + 65536, WS_CC = 49 * MiB + 262144, WS_FL = 50 * MiB, WS_LSE = 52 * MiB;
constexpr size_t WS_BUFA = 64 * MiB, WS_BUFB = 192 * MiB, WS_PROJ = 320 * MiB, WS_DSAO = 672 * MiB, WS_FOXO = 816 * MiB, WS_G = 864 * MiB, WS_SSMO = 896 * MiB, WS_END = 928 * MiB;
constexpr int LDS_BYTES = 147456;
constexpr size_t WS_CTL = 59 * MiB;

struct Params { const float* in[21]; float* out; unsigned char* ws; };
enum { I_X = 0, I_GPRE, I_WIN, I_BF, I_LDT, I_ARE, I_AIM, I_BRE, I_BIM, I_CRE, I_CIM, I_SD, I_WGLU, I_BGLU, I_GMIX, I_WOUT, I_GPOST, I_GPREF, I_WGU, I_WDN, I_GPOSTF };

__device__ __forceinline__ unsigned cvtpk(float lo, float hi) { typedef float f2 __attribute__((ext_vector_type(2))); typedef __bf16 b2 __attribute__((ext_vector_type(2))); f2 v = {lo, hi}; b2 b = __builtin_convertvector(v, b2); return __builtin_bit_cast(unsigned, b); }
__device__ __forceinline__ float bf2f(unsigned v) { return __uint_as_float(v << 16); }
__device__ __forceinline__ float bflo(unsigned w) { return __uint_as_float(w << 16); }
__device__ __forceinline__ float bfhi(unsigned w) { return __uint_as_float(w & 0xffff0000u); }
__device__ __forceinline__ float wave_sum(float v) {
#pragma unroll
    for (int o = 1; o < 64; o <<= 1) v += __shfl_xor(v, o);
    return v;
}
__device__ __forceinline__ float sigmoidf_(float x) { return __builtin_amdgcn_rcpf(1.0f + __expf(-x)); }
__device__ __forceinline__ float gelu_tanh(float y) { const float u = 0.7978845608028654f * (y + 0.044715f * y * y * y); return y * __builtin_amdgcn_rcpf(1.0f + __expf(-2.0f * u)); }
__device__ __forceinline__ float logsig(float z) { return fminf(z, 0.f) - __logf(1.0f + __expf(-fabsf(z))); }
#define LDS_WAIT() asm volatile("s_waitcnt lgkmcnt(0)" ::: "memory")

namespace pg8 {
struct EpiProj {
    static constexpr bool PERM = true, AFTER_DRAIN = false;
    bf16_t* O; float* FL; const float* bf;
    __device__ __forceinline__ void operator()(const f32x4 (&acc)[2][2][4][2], const Unit& u, int wr, int wc, int fr, int fq) const {
        const int row0 = u.pm * BM + wr * 64 + fr, col0 = u.pn * BM + wc * 32 + 8 * fq;
#pragma unroll
        for (int ai = 0; ai < 2; ++ai)
#pragma unroll
            for (int m = 0; m < 4; ++m) { bf16_t* rowp = O + (size_t)(row0 + ai * HALF + m * 16) * LDP + col0;
#pragma unroll
                for (int bj = 0; bj < 2; ++bj) { const f32x4 v0 = acc[ai][bj][m][0], v1 = acc[ai][bj][m][1];
                    u32x4 w; w.x = cvtpk(v0[0], v0[1]); w.y = cvtpk(v0[2], v0[3]); w.z = cvtpk(v1[0], v1[1]); w.w = cvtpk(v1[2], v1[3]);
                    *(u32x4*)(rowp + bj * HALF) = w; } }
        if (u.pn == 10 && wc == 0 && fq == 0) {
            float b6[6];
#pragma unroll
            for (int j = 0; j < 6; ++j) b6[j] = bf[j];
#pragma unroll
            for (int ai = 0; ai < 2; ++ai)
#pragma unroll
                for (int m = 0; m < 4; ++m) { float* fp = FL + (size_t)(row0 + ai * HALF + m * 16) * 8; const f32x4 v0 = acc[ai][0][m][0], v1 = acc[ai][0][m][1];
                    f32x4 o0, o1; o0[0] = logsig(v0[0] + b6[0]); o0[1] = logsig(v0[1] + b6[1]); o0[2] = logsig(v0[2] + b6[2]); o0[3] = logsig(v0[3] + b6[3]);
                    o1[0] = logsig(v1[0] + b6[4]); o1[1] = logsig(v1[1] + b6[5]); o1[2] = 0.f; o1[3] = 0.f;
                    *(f32x4*)fp = o0; *(f32x4*)(fp + 4) = o1; }
        }
    }
};
struct EpiSwiGLU {
    static constexpr bool PERM = true, AFTER_DRAIN = false;
    bf16_t* H;
    __device__ __forceinline__ void operator()(const f32x4 (&acc)[2][2][4][2], const Unit& u, int wr, int wc, int fr, int fq) const {
        const int row0 = u.pm * BM + wr * 64 + fr, col0 = u.pn * HALF + wc * 32 + 8 * fq;
#pragma unroll
        for (int ai = 0; ai < 2; ++ai)
#pragma unroll
            for (int m = 0; m < 4; ++m) { bf16_t* rowp = H + (size_t)(row0 + ai * HALF + m * 16) * DFF + col0;
                float h[8];
#pragma unroll
                for (int n = 0; n < 2; ++n)
#pragma unroll
                    for (int i = 0; i < 4; ++i) { const float g = acc[ai][0][m][n][i], up = acc[ai][1][m][n][i]; h[n * 4 + i] = g * sigmoidf_(g) * up; }
                u32x4 w; w.x = cvtpk(h[0], h[1]); w.y = cvtpk(h[2], h[3]); w.z = cvtpk(h[4], h[5]); w.w = cvtpk(h[6], h[7]);
                *(u32x4*)rowp = w; }
    }
};
struct EpiGLU {
    static constexpr bool PERM = true, AFTER_DRAIN = false;
    const bf16_t* G; bf16_t* O; const float* bg;
    __device__ __forceinline__ void operator()(const f32x4 (&acc)[2][2][4][2], const Unit& u, int wr, int wc, int fr, int fq) const {
        const int row0 = u.pm * BM + wr * 64 + fr, col0 = wc * 32 + 8 * fq;
#pragma unroll
        for (int bj = 0; bj < 2; ++bj) {
#pragma unroll
            for (int ai = 0; ai < 2; ++ai)
#pragma unroll
                for (int m = 0; m < 4; ++m) { const size_t off = (size_t)(row0 + ai * HALF + m * 16) * 256 + col0 + bj * HALF;
                    const f32x4 b0 = *(const f32x4*)(bg + col0 + bj * HALF), b1 = *(const f32x4*)(bg + col0 + bj * HALF + 4);
                    const u32x4 gw = *(const u32x4*)(G + off); const f32x4 v0 = acc[ai][bj][m][0] + b0, v1 = acc[ai][bj][m][1] + b1;
                    u32x4 w; w.x = cvtpk(bflo(gw.x) * sigmoidf_(v0[0]), bfhi(gw.x) * sigmoidf_(v0[1])); w.y = cvtpk(bflo(gw.y) * sigmoidf_(v0[2]), bfhi(gw.y) * sigmoidf_(v0[3]));
                    w.z = cvtpk(bflo(gw.z) * sigmoidf_(v1[0]), bfhi(gw.z) * sigmoidf_(v1[1])); w.w = cvtpk(bflo(gw.w) * sigmoidf_(v1[2]), bfhi(gw.w) * sigmoidf_(v1[3]));
                    *(u32x4*)(O + off) = w; asm volatile("" ::: "memory"); } }
    }
};
struct EpiGLUNorm {
    static constexpr bool PERM = true, AFTER_DRAIN = true;
    const bf16_t* G; bf16_t* MIX; const float* bg; const float* gm;
    __device__ __forceinline__ void fused(f32x4 (&acc)[2][2][4][2], const Unit& u, int wr, int wc, int fr, int fq, PG8_LAS unsigned char* lds, int wid, int lane) const {
        PG8_LAS float* Pss = (PG8_LAS float*)lds;
        const int row0 = u.pm * BM + wr * 64 + fr, col0 = wc * 32 + 8 * fq;
#pragma unroll
        for (int bj = 0; bj < 2; ++bj) { const f32x4 b0 = *(const f32x4*)(bg + col0 + bj * HALF), b1 = *(const f32x4*)(bg + col0 + bj * HALF + 4);
#pragma unroll
            for (int ai = 0; ai < 2; ++ai)
#pragma unroll
                for (int m = 0; m < 4; ++m) { const size_t off = (size_t)(row0 + ai * HALF + m * 16) * 256 + col0 + bj * HALF;
                    const u32x4 gw = *(const u32x4*)(G + off); const f32x4 v0 = acc[ai][bj][m][0] + b0, v1 = acc[ai][bj][m][1] + b1;
                    acc[ai][bj][m][0] = (f32x4){bflo(gw.x) * sigmoidf_(v0[0]), bfhi(gw.x) * sigmoidf_(v0[1]), bflo(gw.y) * sigmoidf_(v0[2]), bfhi(gw.y) * sigmoidf_(v0[3])};
                    acc[ai][bj][m][1] = (f32x4){bflo(gw.z) * sigmoidf_(v1[0]), bfhi(gw.z) * sigmoidf_(v1[1]), bflo(gw.w) * sigmoidf_(v1[2]), bfhi(gw.w) * sigmoidf_(v1[3])};
                    asm volatile("" ::: "memory"); } }
#pragma unroll
        for (int ai = 0; ai < 2; ++ai)
#pragma unroll
            for (int m = 0; m < 4; ++m) { float ss = 0.f;
#pragma unroll
                for (int bj = 0; bj < 2; ++bj)
#pragma unroll
                    for (int n = 0; n < 2; ++n) { const f32x4 x = acc[ai][bj][m][n]; ss += (x[0] * x[0] + x[1] * x[1]) + (x[2] * x[2] + x[3] * x[3]); }
                ss += __shfl_xor(ss, 16); ss += __shfl_xor(ss, 32);
                if (fq == 0) Pss[(ai * HALF + wr * 64 + m * 16 + fr) * 4 + wc] = ss; }
        asm volatile("s_waitcnt lgkmcnt(0)" ::: "memory"); __builtin_amdgcn_s_barrier(); asm volatile("" ::: "memory");
#pragma unroll
        for (int ai = 0; ai < 2; ++ai)
#pragma unroll
            for (int m = 0; m < 4; ++m) { const f32x4 q = *(const PG8_LAS f32x4*)(Pss + (ai * HALF + wr * 64 + m * 16 + fr) * 4);
                const float rs = 1.0f / sqrtf(((q[0] + q[1]) + (q[2] + q[3])) * (1.0f / 256.0f) + 1e-6f);
#pragma unroll
                for (int bj = 0; bj < 2; ++bj) { const f32x4 g0 = *(const f32x4*)(gm + col0 + bj * HALF), g1 = *(const f32x4*)(gm + col0 + bj * HALF + 4);
                    const f32x4 o0 = acc[ai][bj][m][0] * rs * g0, o1 = acc[ai][bj][m][1] * rs * g1;
                    u32x4 w; w.x = cvtpk(o0[0], o0[1]); w.y = cvtpk(o0[2], o0[3]); w.z = cvtpk(o1[0], o1[1]); w.w = cvtpk(o1[2], o1[3]);
                    *(u32x4*)(MIX + (size_t)(row0 + ai * HALF + m * 16) * 1024 + col0 + bj * HALF) = w; } }
        asm volatile("s_waitcnt lgkmcnt(0)" ::: "memory"); __builtin_amdgcn_s_barrier(); asm volatile("" ::: "memory");
    }
};
}
#define XB_TMO      128
#define XB_XCNT(j)  (256  + 64 * (j))
#define XB_XSUB(j)  (1280 + 64 * (j))
#define XB_XGEN(j)  (2304 + 64 * (j))
#define XB_TOP      3328
#define XB_TOPGEN   3392
#define XCD_BAR_WORDS 3456
#define XB_SPIN_CAP (1u << 18)

__device__ __forceinline__ unsigned xb_ld(unsigned* p)              { return __hip_atomic_load(p, __ATOMIC_RELAXED, __HIP_MEMORY_SCOPE_AGENT); }
__device__ __forceinline__ unsigned xb_add(unsigned* p, unsigned v) { return __hip_atomic_fetch_add(p, v, __ATOMIC_RELAXED, __HIP_MEMORY_SCOPE_AGENT); }
__device__ __forceinline__ unsigned xb_xcc_id() { return (unsigned)__builtin_amdgcn_s_getreg((3 << 11) | 20) & 0xFu; }
#define XB_SPIN(cond, bar) do { unsigned _sp = 0; while (cond) { __builtin_amdgcn_s_sleep(1); \
    if ((++_sp & 255u) == 0u) { if (xb_ld(&(bar)[XB_TMO])) break; if (_sp > XB_SPIN_CAP) { atomicAdd(&(bar)[XB_TMO], 1u); break; } } } } while (0)

struct XcdBarrier {
    unsigned* bar; unsigned x;
    volatile LAS unsigned* st;
};

__device__ __forceinline__ XcdBarrier xcd_barrier_post(unsigned* bar, volatile LAS unsigned* st, const int tid) {
    XcdBarrier b; b.bar = bar; b.x = xb_xcc_id(); b.st = st;
    if (tid == 0) (void)xb_add(&bar[XB_XCNT(b.x)], 1u);
    return b;
}
__device__ __forceinline__ void xcd_barrier_complete(unsigned* bar, unsigned x, unsigned& nloc, unsigned& nx) {
    const unsigned G = gridDim.x * gridDim.y * gridDim.z;
    unsigned sum, cnt, mine, sp = 0u;
    for (;;) {
        sum = 0u; cnt = 0u; mine = 0u;
#pragma unroll
        for (unsigned j = 0; j < 16; ++j) { const unsigned c = xb_ld(&bar[XB_XCNT(j)]); sum += c; cnt += (c > 0u) ? 1u : 0u; mine = (j == x) ? c : mine; }
        if (sum == G) break;
        __builtin_amdgcn_s_sleep(1);
        if ((++sp & 255u) == 0u) { if (xb_ld(&bar[XB_TMO])) break; if (sp > XB_SPIN_CAP) { atomicAdd(&bar[XB_TMO], 1u); break; } }
    }
    nloc = mine > 0u ? mine : 1u; nx = cnt > 0u ? cnt : 1u;
}

__device__ __forceinline__ void xcd_barrier(const XcdBarrier& b, const int tid) {
    asm volatile("s_waitcnt vmcnt(0)" ::: "memory");
    __syncthreads();
    if (tid == 0) {
        unsigned* bar = b.bar;
        __builtin_amdgcn_s_waitcnt(0);
        unsigned nloc = b.st[0], nx = b.st[1];
        if (nloc == 0u) { xcd_barrier_complete(bar, b.x, nloc, nx); b.st[0] = nloc; b.st[1] = nx; }
        const unsigned old = xb_add(&bar[XB_XSUB(b.x)], 1u);
        const unsigned gen = old / nloc;
        if (old + 1u == (gen + 1u) * nloc) {
            __builtin_amdgcn_fence(__ATOMIC_RELEASE, "agent");
            asm volatile("s_waitcnt vmcnt(0)" ::: "memory");
            const unsigned og = xb_add(&bar[XB_TOP], 1u);
            const unsigned tg = og / nx;
            if (og + 1u == (tg + 1u) * nx) xb_add(&bar[XB_TOPGEN], 1u);
            else XB_SPIN(xb_ld(&bar[XB_TOPGEN]) == tg, bar);
            __builtin_amdgcn_fence(__ATOMIC_ACQUIRE, "agent");
            xb_add(&bar[XB_XGEN(b.x)], 1u);
            asm volatile("s_waitcnt vmcnt(0)" ::: "memory");
        } else {
            XB_SPIN(xb_ld(&bar[XB_XGEN(b.x)]) == gen, bar);
            __builtin_amdgcn_fence(__ATOMIC_ACQUIRE, "agent");
            asm volatile("s_waitcnt vmcnt(0)" ::: "memory");
        }
    }
    __syncthreads();
}
__device__ __forceinline__ void tr_item(const float* W, int K, int N, bf16_t* WT, int k0, int n0, int drow0, LAS float* scr, int lane) {
    const int n = n0 + (lane & 31);
#pragma unroll 8
    for (int i = 0; i < 32; ++i) { const int kk = 2 * i + (lane >> 5); scr[kk * 33 + (lane & 31)] = (n < N) ? W[(size_t)(k0 + kk) * N + n] : 0.f; }
    LDS_WAIT(); __builtin_amdgcn_wave_barrier();
    const int c = lane & 7;
#pragma unroll
    for (int j = 0; j < 4; ++j) { const int nn = (lane >> 3) + 8 * j; const LAS float* s = scr + (8 * c) * 33 + nn;
        u32x4 o; o.x = cvtpk(s[0 * 33], s[1 * 33]); o.y = cvtpk(s[2 * 33], s[3 * 33]); o.z = cvtpk(s[4 * 33], s[5 * 33]); o.w = cvtpk(s[6 * 33], s[7 * 33]);
        *(u32x4*)(WT + (size_t)(drow0 + nn) * K + k0 + 8 * c) = o; }
    LDS_WAIT(); __builtin_amdgcn_wave_barrier();
}
__device__ __forceinline__ void sincos_rr(float x, float& s, float& c) {
    const float q = rintf(x * 0.6366197723675814f);
    float r = fmaf(-q, 1.57079637050628662109375f, x); r = fmaf(-q, -4.37113900018624283e-8f, r);
    const float r2 = r * r;
    const float sp = r + r * r2 * (-1.6666654611e-1f + r2 * (8.3321608736e-3f + r2 * (-1.9515295891e-4f)));
    const float cp = 1.0f - 0.5f * r2 + r2 * r2 * (4.166664568298827e-2f + r2 * (-1.388731625493765e-3f + r2 * 2.443315711809948e-5f));
    const int n = ((int)q) & 3;
    s = (n == 0) ? sp : (n == 1) ? cp : (n == 2) ? -sp : -cp;
    c = (n == 0) ? cp : (n == 1) ? -sp : (n == 2) ? -cp : sp;
}
struct RowIn { f32x4 x[4]; u32x2 xb[4]; u32x2 y[4]; float rinv; };
template <bool HAS_Y, int XIN> __device__ __forceinline__ void row_load(RowIn& r, const void* xin, const float* rn, size_t m, const bf16_t* y, int lane) {
#pragma unroll
    for (int j = 0; j < 4; ++j) {
        if (XIN != 0) r.xb[j] = *(const GAS u32x2*)((const GAS bf16_t*)xin + m * 1024 + 4 * lane + 256 * j); else r.x[j] = *(const GAS f32x4*)((const GAS float*)xin + m * 1024 + 4 * lane + 256 * j);
        if (HAS_Y) r.y[j] = *(const GAS u32x2*)((const GAS bf16_t*)y + m * 1024 + 4 * lane + 256 * j); }
    if (XIN == 2) r.rinv = ((const GAS float*)rn)[m];
}
template <bool HAS_Y, int XIN, int XOUT> __device__ __forceinline__ void row_compute(const RowIn& r, const f32x4 (&gi)[4], const f32x4 (&gp)[4], void* xout, float* rn, size_t m, const f32x4 (&gq)[4], bf16_t* xn, int lane) {
    f32x4 xv[4];
#pragma unroll
    for (int j = 0; j < 4; ++j) { if (XIN != 0) { const u32x2 w = r.xb[j]; xv[j] = (f32x4){bflo(w.x), bfhi(w.x), bflo(w.y), bfhi(w.y)}; if (XIN == 2) xv[j] = xv[j] * r.rinv * gi[j]; } else xv[j] = r.x[j]; }
    if (HAS_Y) {
        f32x4 yv[4]; float ss = 0.f;
#pragma unroll
        for (int j = 0; j < 4; ++j) { const u32x2 w = r.y[j]; yv[j] = (f32x4){bflo(w.x), bfhi(w.x), bflo(w.y), bfhi(w.y)};
            ss += (yv[j][0] * yv[j][0] + yv[j][1] * yv[j][1]) + (yv[j][2] * yv[j][2] + yv[j][3] * yv[j][3]); }
        const float ry = 1.0f / sqrtf(wave_sum(ss) * (1.0f / 1024.0f) + EPS);
#pragma unroll
        for (int j = 0; j < 4; ++j) { xv[j] = xv[j] + yv[j] * ry * gp[j];
            if (XOUT == 1) { u32x2 w; w.x = cvtpk(xv[j][0], xv[j][1]); w.y = cvtpk(xv[j][2], xv[j][3]); *(GAS u32x2*)((GAS bf16_t*)xout + m * 1024 + 4 * lane + 256 * j) = w; }
            if (XOUT == 0) *(GAS f32x4*)((GAS float*)xout + m * 1024 + 4 * lane + 256 * j) = xv[j]; }
    }
    if (xn) {
        float ss = 0.f;
#pragma unroll
        for (int j = 0; j < 4; ++j) ss += (xv[j][0] * xv[j][0] + xv[j][1] * xv[j][1]) + (xv[j][2] * xv[j][2] + xv[j][3] * xv[j][3]);
        const float ms = wave_sum(ss) * (1.0f / 1024.0f) + EPS, rx = 1.0f / sqrtf(ms);
        if (XOUT == 2 && lane == 0) ((GAS float*)rn)[m] = sqrtf(ms);
#pragma unroll
        for (int j = 0; j < 4; ++j) { const f32x4 o = xv[j] * rx * gq[j];
            u32x2 w; w.x = cvtpk(o[0], o[1]); w.y = cvtpk(o[2], o[3]); *(GAS u32x2*)((GAS bf16_t*)xn + m * 1024 + 4 * lane + 256 * j) = w; }
    }
}
template <bool HAS_Y, int XIN, int XOUT> __device__ __forceinline__ void row_phase(const void* xin, const float* gin, float* rn, const bf16_t* y, const float* gpost, void* xout, const float* gpre, bf16_t* xn, int gw, int NGW, int lane) {
    f32x4 gp[4], gq[4], gi[4];
#pragma unroll
    for (int j = 0; j < 4; ++j) { gp[j] = HAS_Y ? *(const GAS f32x4*)((const GAS float*)gpost + 4 * lane + 256 * j) : (f32x4){0.f, 0.f, 0.f, 0.f}; gq[j] = xn ? *(const GAS f32x4*)((const GAS float*)gpre + 4 * lane + 256 * j) : (f32x4){0.f, 0.f, 0.f, 0.f};
        if (XIN == 2) { const f32x4 g = *(const GAS f32x4*)((const GAS float*)gin + 4 * lane + 256 * j); gi[j] = (f32x4){1.0f / g[0], 1.0f / g[1], 1.0f / g[2], 1.0f / g[3]}; } else gi[j] = (f32x4){1.f, 1.f, 1.f, 1.f}; }
    RowIn cur, nxt, nx2;
    int m = gw;
    if (m < M) row_load<HAS_Y, XIN>(cur, xin, rn, (size_t)m, y, lane);
    if (m + NGW < M) row_load<HAS_Y, XIN>(nxt, xin, rn, (size_t)(m + NGW), y, lane);
    for (; m < M; m += NGW) {
        const int m2 = m + 2 * NGW;
        if (m2 < M) row_load<HAS_Y, XIN>(nx2, xin, rn, (size_t)m2, y, lane);
        row_compute<HAS_Y, XIN, XOUT>(cur, gi, gp, xout, rn, (size_t)m, gq, xn, lane);
        cur = nxt; nxt = nx2;
    }
}

constexpr int XP = 132, HP = 136, SSM_WAVE_LDS = 16 * XP * 4 + 16 * HP * 2;
__device__ __forceinline__ void ssm_wave(const bf16_t* PROJ_, const float* ABAR, const bf16_t* BB, const bf16_t* CC, const float* dsk, bf16_t* G_, LAS unsigned char* wl, int b, int g, int lane) {
    LAS float* XT = (LAS float*)wl; LAS bf16_t* HT = (LAS bf16_t*)(wl + 16 * XP * 4);
    const GAS bf16_t* PROJg = (const GAS bf16_t*)PROJ_; GAS bf16_t* Gg = (GAS bf16_t*)G_;
#define PROJ PROJg
#define G Gg
    const int c16 = lane & 15, q4 = lane >> 4;
    const float ar = ABAR[(g * 64 + lane) * 2], ai = ABAR[(g * 64 + lane) * 2 + 1];
    bf16x8 bfr[8], cfr[4]; const bf16x8 zero8 = {0, 0, 0, 0, 0, 0, 0, 0};
#pragma unroll
    for (int j = 0; j < 8; ++j) bfr[j] = (q4 < 2) ? *(const bf16x8*)(BB + ((size_t)g * 128 + 16 * j + c16) * 16 + 8 * q4) : zero8;
#pragma unroll
    for (int ks = 0; ks < 4; ++ks) cfr[ks] = *(const bf16x8*)(CC + ((size_t)g * 16 + c16) * 128 + 32 * ks + 8 * q4);
    const float dk = dsk[g * 16 + c16];
    float hr = 0.f, hi = 0.f;
    const size_t m0 = (size_t)b * SEQ;
    const GAS bf16_t* up = PROJ + (m0 + c16) * LDP + g * 16 + 8 * (q4 & 1);
    bf16x8 anext = *(const GAS bf16x8*)up;
    const GAS bf16_t* usk = PROJ + (m0 + 4 * q4) * LDP + g * 16 + c16;
    unsigned short un0 = usk[0], un1 = usk[LDP], un2 = usk[2 * LDP], un3 = usk[3 * LDP];
    for (int tile = 0; tile < SEQ / 16; ++tile) {
        const bf16x8 acur = (q4 < 2) ? anext : zero8;
        if (tile + 1 < SEQ / 16) anext = *(const GAS bf16x8*)(up + (size_t)(tile + 1) * 16 * LDP);
        const float uc[4] = {bf2f(un0), bf2f(un1), bf2f(un2), bf2f(un3)};
        if (tile + 1 < SEQ / 16) { const GAS bf16_t* q = usk + (size_t)(tile + 1) * 16 * LDP; un0 = q[0]; un1 = q[LDP]; un2 = q[2 * LDP]; un3 = q[3 * LDP]; }
f32x4 xa[8];
#pragma unroll
        for (int j = 0; j < 8; ++j) xa[j] = __builtin_amdgcn_mfma_f32_16x16x32_bf16(acur, bfr[j], (f32x4){0.f, 0.f, 0.f, 0.f}, 0, 0, 0);
        asm volatile("s_nop 15\n\ts_nop 15" : "+v"(xa[0]), "+v"(xa[1]), "+v"(xa[2]), "+v"(xa[3]), "+v"(xa[4]), "+v"(xa[5]), "+v"(xa[6]), "+v"(xa[7]));
#pragma unroll
        for (int j = 0; j < 8; ++j)
#pragma unroll
            for (int i = 0; i < 4; ++i) XT[(4 * q4 + i) * XP + 16 * j + c16] = xa[j][i];
        LDS_WAIT(); __builtin_amdgcn_wave_barrier();
#pragma unroll
        for (int t = 0; t < 16; ++t) { const float xr = XT[t * XP + lane], xi = XT[t * XP + 64 + lane];
            const float nr = fmaf(ar, hr, fmaf(-ai, hi, xr)), ni = fmaf(ar, hi, fmaf(ai, hr, xi)); hr = nr; hi = ni;
            *(LAS unsigned*)(HT + t * HP + 2 * lane) = cvtpk(hr, hi); }
        LDS_WAIT(); __builtin_amdgcn_wave_barrier();
        f32x4 ya = {0.f, 0.f, 0.f, 0.f};
#pragma unroll
        for (int ks = 0; ks < 4; ++ks) { const bf16x8 a = *(const LAS bf16x8*)(HT + c16 * HP + 32 * ks + 8 * q4); ya = __builtin_amdgcn_mfma_f32_16x16x32_bf16(a, cfr[ks], ya, 0, 0, 0); }
        asm volatile("s_nop 15\n\ts_nop 15" : "+v"(ya));
#pragma unroll
        for (int i = 0; i < 4; ++i) { const size_t mrow = m0 + tile * 16 + 4 * q4 + i; const float u = uc[i];
            const float yv = ya[i] + dk * u; G[mrow * 256 + g * 16 + c16] = (bf16_t)(cvtpk(gelu_tanh(yv), 0.f) & 0xffffu); }
        LDS_WAIT(); __builtin_amdgcn_wave_barrier();
    }
}

#undef PROJ
#undef G
constexpr int KP = 72;
struct AttnSt { f32x16 o0, o1; float m, l; };
__device__ __forceinline__ bf16x8 pack8(const f32x16& p, int s) { u32x4 w; w.x = cvtpk(p[8 * s + 0], p[8 * s + 1]); w.y = cvtpk(p[8 * s + 2], p[8 * s + 3]); w.z = cvtpk(p[8 * s + 4], p[8 * s + 5]); w.w = cvtpk(p[8 * s + 6], p[8 * s + 7]); return __builtin_bit_cast(bf16x8, w); }
typedef float f32x2_ __attribute__((ext_vector_type(2)));
template <bool BIAS>
__device__ __forceinline__ void attn_tile(AttnSt& st, const bf16x8 (&qf)[4], const LAS bf16_t* Ks, const LAS bf16_t* Vt, int r32, int hi,
                                          float cq, const LAS float* ck, int klo, int khi, int kbase, bool need_mask) {
    f32x16 p0, p1;
#pragma unroll
    for (int r = 0; r < 16; ++r) { p0[r] = 0.f; p1[r] = 0.f; }
#pragma unroll
    for (int ds = 0; ds < 4; ++ds) { const bf16x8 a0 = *(const LAS bf16x8*)(Ks + r32 * KP + ds * 16 + hi * 8), a1 = *(const LAS bf16x8*)(Ks + (32 + r32) * KP + ds * 16 + hi * 8);
        p0 = __builtin_amdgcn_mfma_f32_32x32x16_bf16(a0, qf[ds], p0, 0, 0, 0); p1 = __builtin_amdgcn_mfma_f32_32x32x16_bf16(a1, qf[ds], p1, 0, 0, 0); }
    if (BIAS) {
#pragma unroll
        for (int g = 0; g < 4; ++g) {
            const f32x4 c0 = *(const LAS f32x4*)(ck + 8 * g + 4 * hi), c1 = *(const LAS f32x4*)(ck + 32 + 8 * g + 4 * hi);
#pragma unroll
            for (int i = 0; i < 4; i += 2) { const int r = 4 * g + i;
                const f32x2_ a2 = (f32x2_){p0[r], p0[r + 1]} * QK_C + (f32x2_){c0[i], c0[i + 1]}, b2 = (f32x2_){p1[r], p1[r + 1]} * QK_C + (f32x2_){c1[i], c1[i + 1]};
                p0[r] = a2.x; p0[r + 1] = a2.y; p1[r] = b2.x; p1[r + 1] = b2.y; }
        }
    }
    if (need_mask) {
        const unsigned nml = (unsigned)(kbase + 4 * hi - klo), range = (unsigned)(khi - klo);
#pragma unroll
        for (int r = 0; r < 16; ++r) { const unsigned c = (unsigned)((r & 3) + 8 * (r >> 2));
            if (nml + c > range) p0[r] = -INFINITY;
            if (nml + (c + 32u) > range) p1[r] = -INFINITY; }
    }
#define MX3(a, b, c) __builtin_fmaxf(__builtin_fmaxf((a), (b)), (c))
    float rm;
    { float ma = MX3(p0[0], p0[1], p1[0]), mb = MX3(p0[2], p0[3], p1[1]); ma = MX3(ma, p1[2], p1[3]);
#pragma unroll
      for (int r = 4; r < 16; r += 4) { ma = MX3(ma, p0[r], p0[r + 1]); mb = MX3(mb, p0[r + 2], p0[r + 3]); ma = MX3(ma, p1[r], p1[r + 1]); mb = MX3(mb, p1[r + 2], p1[r + 3]); }
      rm = __builtin_fmaxf(ma, mb); }
#undef MX3
    rm = fmaxf(rm, __shfl_xor(rm, 32));
    const float mnew = fmaxf(st.m, rm);
    const float SC = BIAS ? 1.0f : QK_C;
    const float alpha = __builtin_amdgcn_exp2f((st.m - mnew) * SC), nm = -mnew * SC;
    st.m = mnew;
    f32x2_ sum2 = {0.f, 0.f};
#pragma unroll
    for (int r = 0; r < 16; r += 2) {
        const f32x2_ a2 = BIAS ? (f32x2_){p0[r], p0[r + 1]} + nm : (f32x2_){p0[r], p0[r + 1]} * QK_C + nm, b2 = BIAS ? (f32x2_){p1[r], p1[r + 1]} + nm : (f32x2_){p1[r], p1[r + 1]} * QK_C + nm;
        p0[r] = __builtin_amdgcn_exp2f(a2.x); p0[r + 1] = __builtin_amdgcn_exp2f(a2.y); p1[r] = __builtin_amdgcn_exp2f(b2.x); p1[r + 1] = __builtin_amdgcn_exp2f(b2.y);
        sum2 += (f32x2_){p0[r], p0[r + 1]} + (f32x2_){p1[r], p1[r + 1]}; }
    st.l = st.l * alpha + (sum2.x + sum2.y);
#pragma unroll
    for (int r = 0; r < 16; ++r) { st.o0[r] *= alpha; st.o1[r] *= alpha; }
    const int sw0 = ((r32 >> 3) & 7) << 3, sw1 = (((32 + r32) >> 3) & 7) << 3;
#pragma unroll
    for (int T = 0; T < 2; ++T)
#pragma unroll
        for (int s = 0; s < 2; ++s) { const bf16x8 pf = pack8(T == 0 ? p0 : p1, s); const int kvb = 32 * T + 16 * s + 4 * hi;
            { const u32x2 lo = *(const LAS u32x2*)(Vt + r32 * KP + (kvb ^ sw0)), hh = *(const LAS u32x2*)(Vt + r32 * KP + ((kvb + 8) ^ sw0));
              const u32x4 v = {lo.x, lo.y, hh.x, hh.y}; st.o0 = __builtin_amdgcn_mfma_f32_32x32x16_bf16(__builtin_bit_cast(bf16x8, v), pf, st.o0, 0, 0, 0); }
            { const u32x2 lo = *(const LAS u32x2*)(Vt + (32 + r32) * KP + (kvb ^ sw1)), hh = *(const LAS u32x2*)(Vt + (32 + r32) * KP + ((kvb + 8) ^ sw1));
              const u32x4 v = {lo.x, lo.y, hh.x, hh.y}; st.o1 = __builtin_amdgcn_mfma_f32_32x32x16_bf16(__builtin_bit_cast(bf16x8, v), pf, st.o1, 0, 0, 0); }
        }
}
__device__ __forceinline__ void attn_init(AttnSt& st) {
#pragma unroll
    for (int r = 0; r < 16; ++r) { st.o0[r] = 0.f; st.o1[r] = 0.f; }
    st.m = -1e30f; st.l = 0.f;
}
__device__ __forceinline__ void attn_store(const AttnSt& st, float inv, bf16_t* orow, int hi) {
#pragma unroll
    for (int g = 0; g < 4; ++g) {
        u32x2 w0, w1; w0.x = cvtpk(st.o0[4 * g] * inv, st.o0[4 * g + 1] * inv); w0.y = cvtpk(st.o0[4 * g + 2] * inv, st.o0[4 * g + 3] * inv);
        w1.x = cvtpk(st.o1[4 * g] * inv, st.o1[4 * g + 1] * inv); w1.y = cvtpk(st.o1[4 * g + 2] * inv, st.o1[4 * g + 3] * inv);
        *(u32x2*)(orow + 8 * g + 4 * hi) = w0; *(u32x2*)(orow + 32 + 8 * g + 4 * hi) = w1; }
}
__device__ __forceinline__ void stage_k(LAS bf16_t* Ks, int lrow, int lch, const u32x4& kreg) { *(LAS u32x4*)(Ks + lrow * KP + lch * 8) = kreg; }
__device__ __forceinline__ void stage_v2(LAS bf16_t* Vt, int rp, int c4, const u32x2& va, const u32x2& vb) {
    const int sw = ((c4 >> 1) & 7) << 3;
#pragma unroll
    for (int j = 0; j < 4; ++j) { const unsigned a = va[j >> 1], c = vb[j >> 1];
        const unsigned w = (j & 1) ? ((a >> 16) | (c & 0xffff0000u)) : ((a & 0xffffu) | (c << 16));
        *(LAS unsigned*)(Vt + (4 * c4 + j) * KP + ((2 * rp) ^ sw)) = w; }
}

__device__ __forceinline__ void fox_unit(const bf16_t* PROJ_, const float* FL_, bf16_t* FOXO_, LAS unsigned char* lds, int b, int h, int qb, int tid, int lane, int wave) {
    const GAS bf16_t* PROJ = (const GAS bf16_t*)PROJ_; const GAS float* FL = (const GAS float*)FL_; GAS bf16_t* FOXO = (GAS bf16_t*)FOXO_;
    LAS bf16_t* Ks = (LAS bf16_t*)lds; LAS bf16_t* Vt = (LAS bf16_t*)(lds + 9216); LAS float* cum = (LAS float*)(lds + 36864); LAS float* wtot = (LAS float*)(lds + 36864 + 8192);
    const int r32 = lane & 31, hi = lane >> 5;
    const int q1 = (qb + 1) * 256;
    __syncthreads();
    {
        float v[4]; const int s0 = 4 * tid;
#pragma unroll
        for (int i = 0; i < 4; ++i) v[i] = (s0 + i < q1) ? FL[((size_t)b * SEQ + s0 + i) * 8 + h] * LOG2E : 0.f;
        v[1] += v[0]; v[2] += v[1]; v[3] += v[2];
        const float tot = v[3]; float inc = tot;
#pragma unroll
        for (int off = 1; off < 64; off <<= 1) { const float t = __shfl_up(inc, off); if (lane >= off) inc += t; }
        if (lane == 63) wtot[wave] = inc;
        __syncthreads();
        float base = 0.f;
        for (int w = 0; w < wave; ++w) base += wtot[w];
        const float ex = base + inc - tot;
#pragma unroll
        for (int i = 0; i < 4; ++i) cum[s0 + i] = -(ex + v[i]);
    }
    __syncthreads();
    const int qrow0 = qb * 256 + wave * 32, qpos = qrow0 + r32;
    bf16x8 qf[4];
    { const GAS bf16_t* qp = PROJ + ((size_t)b * SEQ + qpos) * LDP + COL_FQ + h * 64 + hi * 8;
#pragma unroll
      for (int ds = 0; ds < 4; ++ds) qf[ds] = *(const GAS bf16x8*)(qp + ds * 16); }
    const float cq = 0.f;
    AttnSt st; attn_init(st);
    const int NT = q1 / 64, lrow = tid >> 3, lch = tid & 7, rp = tid >> 4, c4 = tid & 15;
    const GAS bf16_t* kg = PROJ + ((size_t)b * SEQ + lrow) * LDP + COL_FK + h * 64 + lch * 8;
    const GAS bf16_t* vg = PROJ + ((size_t)b * SEQ + 2 * rp) * LDP + COL_FV + h * 64 + c4 * 4;
    u32x4 kreg = *(const GAS u32x4*)kg; u32x2 va = *(const GAS u32x2*)vg, vb = *(const GAS u32x2*)(vg + LDP);
    stage_k(Ks, lrow, lch, kreg); stage_v2(Vt, rp, c4, va, vb);
    if (NT > 1) { kreg = *(const GAS u32x4*)(kg + (size_t)64 * LDP); va = *(const GAS u32x2*)(vg + (size_t)64 * LDP); vb = *(const GAS u32x2*)(vg + (size_t)65 * LDP); }
    __syncthreads();
    for (int kt = 0; kt < NT; ++kt) {
        LAS bf16_t* Kc = Ks + (kt & 1) * 9216; LAS bf16_t* Vc = Vt + (kt & 1) * 9216; LAS bf16_t* Kn = Ks + ((kt + 1) & 1) * 9216; LAS bf16_t* Vn = Vt + ((kt + 1) & 1) * 9216;
        if (kt + 1 < NT) { stage_k(Kn, lrow, lch, kreg); stage_v2(Vn, rp, c4, va, vb); }
        if (kt + 2 < NT) { kreg = *(const GAS u32x4*)(kg + (size_t)(kt + 2) * 64 * LDP); va = *(const GAS u32x2*)(vg + (size_t)(kt + 2) * 64 * LDP); vb = *(const GAS u32x2*)(vg + ((size_t)(kt + 2) * 64 + 1) * LDP); }
        if (kt * 64 <= qrow0 + 31) attn_tile<true>(st, qf, Kc, Vc, r32, hi, cq, cum + kt * 64, 0, qpos, kt * 64, kt * 64 + 63 > qrow0);
        __syncthreads();
    }
    const float l = st.l + __shfl_xor(st.l, 32);
    attn_store(st, 1.0f / l, (bf16_t*)(FOXO + ((size_t)b * SEQ + qpos) * 384 + h * 64), hi);
}

__device__ __forceinline__ void dsa_unit(const bf16_t* PROJ_, bf16_t* DSAO_, float* LSE_, LAS unsigned char* lds, int b, int hp, int pat, int res, int n, int tid, int lane, int wave) {
    const int job = wave >> 2, jw = wave & 3, h = 2 * hp + job, jt = tid & 255, r32 = lane & 31, hi = lane >> 5;
    const int d = (pat == 0) ? 1 : (pat == 1 ? 4 : 16);
    const GAS bf16_t* PROJ = (const GAS bf16_t*)PROJ_; GAS bf16_t* DSAO = (GAS bf16_t*)DSAO_; GAS float* LSE = (GAS float*)LSE_;
    LAS bf16_t* Ks = (LAS bf16_t*)(lds + job * 36864); LAS bf16_t* Vt = (LAS bf16_t*)(lds + job * 36864 + 9216);
    __syncthreads();
    const int qi = jw * 32 + r32;
    const size_t trow = (size_t)b * SEQ + (size_t)(n * 128 + qi) * d + res;
    bf16x8 qf[4];
    { const GAS bf16_t* qp = PROJ + trow * LDP + COL_DQ + h * 64 + hi * 8;
#pragma unroll
      for (int ds = 0; ds < 4; ++ds) qf[ds] = *(const GAS bf16x8*)(qp + ds * 16); }
    AttnSt st; attn_init(st);
    const int kt0 = (n == 0) ? 2 : 0, lch = jt & 7, lrow = jt >> 3, rp = jt >> 4, c4 = jt & 15;
    const GAS bf16_t* kbase = PROJ + ((size_t)b * SEQ + res) * LDP + COL_DK + h * 64 + lch * 8;
    const GAS bf16_t* vbase = PROJ + ((size_t)b * SEQ + res) * LDP + COL_DV + h * 64 + c4 * 4;
    const long rstep = (long)d * LDP;
    const long mk0 = (long)(n - 1) * 128 + lrow, mv0 = (long)(n - 1) * 128 + 2 * rp;
    u32x4 kreg0, kreg1; u32x2 va0, vb0, va1, vb1;
#define DSA_LOAD(kt_) do { const long o0 = (mk0 + 64 * (kt_)) * rstep, o1 = o0 + 32 * rstep, p0 = (mv0 + 64 * (kt_)) * rstep, p1 = p0 + 32 * rstep; \
        kreg0 = *(const GAS u32x4*)(kbase + o0); kreg1 = *(const GAS u32x4*)(kbase + o1); \
        va0 = *(const GAS u32x2*)(vbase + p0); vb0 = *(const GAS u32x2*)(vbase + p0 + rstep); va1 = *(const GAS u32x2*)(vbase + p1); vb1 = *(const GAS u32x2*)(vbase + p1 + rstep); } while (0)
#define DSA_STAGE(K_, V_) do { stage_k(K_, lrow, lch, kreg0); stage_k(K_, lrow + 32, lch, kreg1); stage_v2(V_, rp, c4, va0, vb0); stage_v2(V_, rp + 16, c4, va1, vb1); } while (0)
    DSA_LOAD(kt0);
    DSA_STAGE(Ks + (kt0 & 1) * 9216, Vt + (kt0 & 1) * 9216);
    DSA_LOAD(kt0 + 1);
    __syncthreads();
    const int q0 = jw * 32;
    for (int kt = kt0; kt < 4; ++kt) {
        LAS bf16_t* Kc = Ks + (kt & 1) * 9216; LAS bf16_t* Vc = Vt + (kt & 1) * 9216;
        if (kt + 1 < 4) DSA_STAGE(Ks + ((kt + 1) & 1) * 9216, Vt + ((kt + 1) & 1) * 9216);
        if (kt + 2 < 4) DSA_LOAD(kt + 2);
        const int k0 = 64 * kt;
        if (k0 + 63 >= q0 && k0 <= q0 + 31 + 128) {
            const bool allv = (k0 >= q0 + 31) && (k0 + 63 <= q0 + 128);
            attn_tile<false>(st, qf, Kc, Vc, r32, hi, 0.f, (const LAS float*)lds, qi, qi + 128, k0, !allv);
        }
        __syncthreads();
    }
#undef DSA_LOAD
#undef DSA_STAGE
    const float l = st.l + __shfl_xor(st.l, 32);
    attn_store(st, 1.0f / l, (bf16_t*)(DSAO + ((size_t)pat * M + trow) * 384 + h * 64), hi);
    if (hi == 0) LSE[((size_t)pat * M + trow) * 8 + h] = st.m * QK_C + __log2f(l);
}

__device__ __forceinline__ void merge_row(const bf16_t* SSMO, const bf16_t* DSAO, const float* LSE, const bf16_t* FOXO, const float* gm, bf16_t* OUT, size_t m, int lane) {
    float v[16];
    if (lane < 16) {
#pragma unroll
        for (int i = 0; i < 16; ++i) v[i] = 0.f;
    } else if (lane < 40) {
        const int c0 = 16 * lane - 256, h = c0 >> 6;
        const GAS float* LSEg = (const GAS float*)LSE; const float l0 = LSEg[(0 * (size_t)M + m) * 8 + h], l1 = LSEg[(1 * (size_t)M + m) * 8 + h], l2 = LSEg[(2 * (size_t)M + m) * 8 + h];
        const float mx = fmaxf(l0, fmaxf(l1, l2));
        float w0 = __builtin_amdgcn_exp2f(l0 - mx), w1 = __builtin_amdgcn_exp2f(l1 - mx), w2 = __builtin_amdgcn_exp2f(l2 - mx);
        const float inv = 1.0f / (w0 + w1 + w2); w0 *= inv; w1 *= inv; w2 *= inv;
#pragma unroll
        for (int i = 0; i < 16; ++i) v[i] = 0.f;
#pragma unroll
        for (int p = 0; p < 3; ++p) { const float w = (p == 0) ? w0 : (p == 1 ? w1 : w2); const GAS bf16_t* src = (const GAS bf16_t*)DSAO + ((size_t)p * M + m) * 384 + c0;
            const u32x4 a = *(const GAS u32x4*)src, c = *(const GAS u32x4*)(src + 8);
#pragma unroll
            for (int i = 0; i < 4; ++i) { v[2 * i] += w * bflo(a[i]); v[2 * i + 1] += w * bfhi(a[i]); v[8 + 2 * i] += w * bflo(c[i]); v[8 + 2 * i + 1] += w * bfhi(c[i]); } }
    } else {
        const int c0 = 16 * lane - 640;
        const u32x4 a = *(const GAS u32x4*)((const GAS bf16_t*)FOXO + m * 384 + c0), c = *(const GAS u32x4*)((const GAS bf16_t*)FOXO + m * 384 + c0 + 8);
#pragma unroll
        for (int i = 0; i < 4; ++i) { v[2 * i] = bflo(a[i]); v[2 * i + 1] = bfhi(a[i]); v[8 + 2 * i] = bflo(c[i]); v[8 + 2 * i + 1] = bfhi(c[i]); }
    }
    float ss = 0.f;
#pragma unroll
    for (int i = 0; i < 16; ++i) ss += v[i] * v[i];
    const int seg = (lane < 16) ? 0 : (lane < 40 ? 1 : 2);
    const float s0 = wave_sum(seg == 0 ? ss : 0.f), s1 = wave_sum(seg == 1 ? ss : 0.f), s2 = wave_sum(seg == 2 ? ss : 0.f);
    const float rs = (seg == 0) ? 1.0f / sqrtf(s0 * (1.0f / 256.0f) + EPS) : (seg == 1) ? 1.0f / sqrtf(s1 * (1.0f / 384.0f) + EPS) : 1.0f / sqrtf(s2 * (1.0f / 384.0f) + EPS);
    u32x4 o0, o1;
#pragma unroll
    for (int i = 0; i < 4; ++i) { const f32x4 g = *(const GAS f32x4*)((const GAS float*)gm + 16 * lane + 4 * i);
        const unsigned lo = cvtpk(v[4 * i] * rs * g[0], v[4 * i + 1] * rs * g[1]), hh = cvtpk(v[4 * i + 2] * rs * g[2], v[4 * i + 3] * rs * g[3]);
        if (i < 2) { o0[2 * i] = lo; o0[2 * i + 1] = hh; } else { o1[2 * (i - 2)] = lo; o1[2 * (i - 2) + 1] = hh; } }
    if (lane >= 16) { *(GAS u32x4*)((GAS bf16_t*)OUT + m * 1024 + 16 * lane) = o0; *(GAS u32x4*)((GAS bf16_t*)OUT + m * 1024 + 16 * lane + 8) = o1; }
}
template <int PH> __device__ __forceinline__ void run_phase(const Params& P, const int l, LAS unsigned char* lds, const int wave0, const int umax = 1 << 30) {
    constexpr size_t WS_PRM = 58 * MiB; constexpr int PRM_L = 8192, PR_GPOST = 0, PR_GPREF = 1024, PR_GPOSTF = 2048, PR_GMIX = 3072, PR_GPRE = 4096, PR_BGLU = 5120, PR_SD = 5376, PR_BF = 5632;
#define WSBASE() unsigned char* ws = P.ws; asm volatile("" : "+s"(ws)); float* const Pout = P.out; const float* const Px = P.in[I_X]; (void)Pout; (void)Px; int wave_s = wave0; asm volatile("" : "+s"(wave_s)); int lane_v; asm volatile("v_mbcnt_lo_u32_b32 %0, -1, 0\n\tv_mbcnt_hi_u32_b32 %0, -1, %0" : "=v"(lane_v)); const int tid = wave_s * 64 + lane_v; int bid = blockIdx.x; asm volatile("" : "+s"(bid)); int G = gridDim.x; asm volatile("" : "+s"(G)); const int lane = lane_v, wave = wave_s, gw = bid * 8 + wave, NGW = G * 8; (void)lane; (void)gw; (void)NGW
    if constexpr (PH == 0) {
    {
        WSBASE();
        bf16_t* WinT = (bf16_t*)(ws + WS_WIN); bf16_t* WoutT = (bf16_t*)(ws + WS_WOUT); bf16_t* WguT = (bf16_t*)(ws + WS_WGU); bf16_t* WdnT = (bf16_t*)(ws + WS_WDN); bf16_t* WgluT = (bf16_t*)(ws + WS_WGLU);
        float* ABAR = (float*)(ws + WS_ABAR); bf16_t* BB = (bf16_t*)(ws + WS_BB); bf16_t* CC = (bf16_t*)(ws + WS_CC); float* PRM = (float*)(ws + WS_PRM);
        LAS float* scr = (LAS float*)(lds + wave * 16384);
        constexpr int I_IN = 16 * 88, I_OUT = 16 * 32, I_GU = 16 * 176, I_DN = 44 * 32, I_GL = 4 * 8, I_ALL = I_IN + I_OUT + I_GU + I_DN + I_GL;
        for (int it = gw; it < 2 * I_ALL; it += NGW) {
            const int l = it / I_ALL; int r = it % I_ALL;
            if (r < I_IN) { const int kb = r / 88, nb = r % 88; tr_item(P.in[I_WIN] + (size_t)l * 1024 * NIN, 1024, NIN, WinT + (size_t)l * NINP * 1024, 64 * kb, 32 * nb, 32 * nb, scr, lane); continue; } r -= I_IN;
            if (r < I_OUT) { const int kb = r / 32, nb = r % 32; tr_item(P.in[I_WOUT] + (size_t)l * 1024 * 1024, 1024, 1024, WoutT + (size_t)l * 1024 * 1024, 64 * kb, 32 * nb, 32 * nb, scr, lane); continue; } r -= I_OUT;
            if (r < I_GU) { const int kb = r / 176, nb = r % 176, c0 = 32 * nb, half = (c0 >= DFF) ? 1 : 0, cc = c0 - half * DFF, dr = 256 * (cc / 128) + 128 * half + (cc % 128);
                tr_item(P.in[I_WGU] + (size_t)l * 1024 * NGU, 1024, NGU, WguT + (size_t)l * NGU * 1024, 64 * kb, c0, dr, scr, lane); continue; } r -= I_GU;
            if (r < I_DN) { const int kb = r / 32, nb = r % 32; tr_item(P.in[I_WDN] + (size_t)l * DFF * 1024, DFF, 1024, WdnT + (size_t)l * 1024 * DFF, 64 * kb, 32 * nb, 32 * nb, scr, lane); continue; } r -= I_DN;
            { const int kb = r / 8, nb = r % 8; tr_item(P.in[I_WGLU] + (size_t)l * 256 * 256, 256, 256, WgluT + (size_t)l * 256 * 256, 64 * kb, 32 * nb, 32 * nb, scr, lane); }
        }
        for (int e = bid * 512 + tid; e < 2 * 16 * 64; e += G * 512) {
            const int lg = e >> 6, p = e & 63;
            const float dt = expf(P.in[I_LDT][lg]), ar = P.in[I_ARE][e], ai = P.in[I_AIM][e];
            const float decay = expf(ar * dt); float sn, cs; sincos_rr(ai * dt, sn, cs);
            const float are = decay * cs, aim = decay * sn, mag2 = ar * ar + ai * ai;
            const float cre = ((are - 1.0f) * ar + aim * ai) / mag2, cim = (aim * ar - (are - 1.0f) * ai) / mag2;
            ABAR[2 * e] = are; ABAR[2 * e + 1] = aim;
            for (int c = 0; c < 16; ++c) { const float br = P.in[I_BRE][(size_t)e * 16 + c], bi = P.in[I_BIM][(size_t)e * 16 + c];
                BB[((size_t)lg * 128 + p) * 16 + c] = (bf16_t)(cvtpk(cre * br - cim * bi, 0.f) & 0xffffu);
                BB[((size_t)lg * 128 + 64 + p) * 16 + c] = (bf16_t)(cvtpk(cre * bi + cim * br, 0.f) & 0xffffu);
                *(unsigned*)(CC + ((size_t)lg * 16 + c) * 128 + 2 * p) = cvtpk(P.in[I_CRE][((size_t)lg * 16 + c) * 64 + p], -P.in[I_CIM][((size_t)lg * 16 + c) * 64 + p]); }
        }
        for (int e = bid * 512 + tid; e < 2 * 1024; e += G * 512) { const int l = e >> 10, c = e & 1023; float* pr = PRM + l * PRM_L;
            pr[PR_GPOST + c] = P.in[I_GPOST][e]; pr[PR_GPREF + c] = P.in[I_GPREF][e]; pr[PR_GPOSTF + c] = P.in[I_GPOSTF][e]; pr[PR_GMIX + c] = P.in[I_GMIX][e]; pr[PR_GPRE + c] = P.in[I_GPRE][e];
            if (c < 256) { pr[PR_BGLU + c] = P.in[I_BGLU][l * 256 + c]; pr[PR_SD + c] = P.in[I_SD][l * 256 + c]; }
            if (c < 8) pr[PR_BF + c] = (c < 6) ? P.in[I_BF][l * 6 + c] : 0.f; }
        row_phase<false, 0, 2>(Px, nullptr, (float*)(ws + 60 * MiB), (const bf16_t*)(ws + WS_BUFB), nullptr, nullptr, P.in[I_GPRE], (bf16_t*)(ws + WS_BUFA), gw, NGW, lane);
    }
    }
    if constexpr (PH == 1) {
        { WSBASE(); pg8::Gemm g{(bf16_t*)(ws + WS_BUFA), (bf16_t*)(ws + WS_WIN) + (size_t)l * NINP * 1024, M, NINP, 1024}; pg8::StaticOrder S; S.init(M, NINP, G, bid);
          pg8::EpiProj E{(bf16_t*)(ws + WS_PROJ), (float*)(ws + WS_FL), (const float*)(ws + WS_PRM) + l * PRM_L + PR_BF};
          pg8::gemm_phase<pg8::EpiProj, pg8::StaticOrder, true, true>(lds, g, S, E, wave); }
    }
    if constexpr (PH == 2) {
        {
            WSBASE();
            const bf16_t* PROJ = (const bf16_t*)(ws + WS_PROJ); float* FL = (float*)(ws + WS_FL);
            constexpr int NU_SSM = 64, NU_FOX = NB * 6 * 8, NU_DSA = NB * 3 * 48;
            unsigned* qctr = (unsigned*)(ws + WS_CTL) + 64 * l; LAS int* uq = (LAS int*)(lds + LDS_BYTES - 64);
#ifdef STATIC_Q
            (void)qctr; (void)uq;
            for (int u = bid; u < NU_SSM + NU_FOX + NU_DSA; u += G) {
#else
            for (;;) {
                __syncthreads();
                if (tid == 0) *uq = (int)__hip_atomic_fetch_add(qctr, 1u, __ATOMIC_RELAXED, __HIP_MEMORY_SCOPE_AGENT);
                __syncthreads();
                const int u = __builtin_amdgcn_readfirstlane(*uq);
                if (u >= NU_SSM + NU_FOX + NU_DSA || u >= umax) break;
#endif
                if (u < NU_SSM) { const int wu = u * 8 + wave;
                    ssm_wave(PROJ, (const float*)(ws + WS_ABAR) + (size_t)l * 16 * 64 * 2, (const bf16_t*)(ws + WS_BB) + (size_t)l * 16 * 128 * 16, (const bf16_t*)(ws + WS_CC) + (size_t)l * 16 * 16 * 128,
                             (const float*)(ws + WS_PRM) + l * PRM_L + PR_SD, (bf16_t*)(ws + WS_G), lds + wave * SSM_WAVE_LDS, wu >> 4, wu & 15, lane);
                } else if (u < NU_SSM + NU_FOX) { const int v = u - NU_SSM, qb = 7 - v / 192, bh = v % 192;
                    fox_unit(PROJ, FL, (bf16_t*)(ws + WS_FOXO), lds, bh / 6, bh % 6, qb, tid, lane, wave);
                } else { const int v = u - NU_SSM - NU_FOX, b = v / 144, rem = v % 144, hp = rem / 48, j = rem % 48, pat = j >> 4, jj = j & 15;
                    const int res = (pat == 0) ? 0 : (pat == 1 ? (jj & 3) : jj), n = (pat == 0) ? jj : (pat == 1 ? (jj >> 2) : 0);
                    dsa_unit(PROJ, (bf16_t*)(ws + WS_DSAO), (float*)(ws + WS_LSE), lds, b, hp, pat, res, n, tid, lane, wave);
                }
            }
        }
    }
    if constexpr (PH == 3) {
        { WSBASE(); int kglu = 256; asm volatile("" : "+s"(kglu)); pg8::Gemm g{(bf16_t*)(ws + WS_G), (bf16_t*)(ws + WS_WGLU) + (size_t)l * 256 * 256, M, 256, kglu}; pg8::StaticOrder S; S.init(M, 256, G, bid);
          pg8::EpiGLUNorm E{(bf16_t*)(ws + WS_G), (bf16_t*)(ws + WS_PROJ), (const float*)(ws + WS_PRM) + l * PRM_L + PR_BGLU, (const float*)(ws + WS_PRM) + l * PRM_L + PR_GMIX};
          pg8::gemm_phase<pg8::EpiGLUNorm, pg8::StaticOrder, false, true>(lds, g, S, E, wave);
          bf16_t* d_ = (bf16_t*)(ws + WS_DSAO); float* e_ = (float*)(ws + WS_LSE); bf16_t* f_ = (bf16_t*)(ws + WS_FOXO); const float* g_ = (const float*)(ws + WS_PRM) + l * PRM_L + PR_GMIX; bf16_t* o_ = (bf16_t*)(ws + WS_PROJ);
          for (int m = gw; m < M; m += 2 * NGW) { merge_row(nullptr, d_, e_, f_, g_, o_, (size_t)m, lane); if (m + NGW < M) merge_row(nullptr, d_, e_, f_, g_, o_, (size_t)(m + NGW), lane); } }
    }
    if constexpr (PH == 4) {
    }
    if constexpr (PH == 5) {
        { WSBASE(); pg8::Gemm g{(bf16_t*)(ws + WS_PROJ), (bf16_t*)(ws + WS_WOUT) + (size_t)l * 1024 * 1024, M, 1024, 1024}; pg8::StaticOrder S; S.init(M, 1024, G, bid);
          pg8::EpiBf16<0> E{(bf16_t*)(ws + WS_BUFB), 1024, nullptr, 0, 0, 1.f};
          pg8::gemm_phase<pg8::EpiBf16<0>, pg8::StaticOrder, true, true>(lds, g, S, E, wave); }
    }
    if constexpr (PH == 6) {
        { WSBASE(); const float* xin = (l == 0) ? Px : Pout; const float* pr = (const float*)(ws + WS_PRM) + l * PRM_L;
          (void)xin; float* rn = (float*)(ws + 60 * MiB);
          row_phase<true, 2, 2>((const bf16_t*)(ws + WS_BUFA), pr + PR_GPRE, rn, (const bf16_t*)(ws + WS_BUFB), pr + PR_GPOST, nullptr, pr + PR_GPREF, (bf16_t*)(ws + WS_BUFA), gw, NGW, lane); }
    }
    if constexpr (PH == 7) {
        { WSBASE(); pg8::Gemm g{(bf16_t*)(ws + WS_BUFA), (bf16_t*)(ws + WS_WGU) + (size_t)l * NGU * 1024, M, NGU, 1024}; pg8::StaticOrder S; S.init(M, NGU, G, bid);
          pg8::EpiSwiGLU E{(bf16_t*)(ws + WS_PROJ)};
          pg8::gemm_phase<pg8::EpiSwiGLU, pg8::StaticOrder, true, true>(lds, g, S, E, wave); }
    }
    if constexpr (PH == 8) {
        { WSBASE(); pg8::Gemm g{(bf16_t*)(ws + WS_PROJ), (bf16_t*)(ws + WS_WDN) + (size_t)l * 1024 * DFF, M, 1024, DFF}; pg8::StaticOrder S; S.init(M, 1024, G, bid);
          pg8::EpiBf16<0> E{(bf16_t*)(ws + WS_BUFB), 1024, nullptr, 0, 0, 1.f};
          pg8::gemm_phase<pg8::EpiBf16<0>, pg8::StaticOrder, true, true>(lds, g, S, E, wave); }
    }
    if constexpr (PH == 9) {
        { WSBASE(); const float* pr = (const float*)(ws + WS_PRM);
          float* rn = (float*)(ws + 60 * MiB); const bf16_t* xnb = (const bf16_t*)(ws + WS_BUFA);
          if (l == 0) row_phase<true, 2, 2>(xnb, pr + l * PRM_L + PR_GPREF, rn, (const bf16_t*)(ws + WS_BUFB), pr + l * PRM_L + PR_GPOSTF, nullptr, pr + PRM_L + PR_GPRE, (bf16_t*)(ws + WS_BUFA), gw, NGW, lane);
          else row_phase<true, 2, 0>(xnb, pr + l * PRM_L + PR_GPREF, rn, (const bf16_t*)(ws + WS_BUFB), pr + l * PRM_L + PR_GPOSTF, Pout, pr + PRM_L + PR_GPRE, nullptr, gw, NGW, lane); }
    }
#undef WSBASE
}

template <int PH> __global__ void __launch_bounds__(512, 2) phase_k(Params P, int l) {
    extern __shared__ __attribute__((aligned(16))) unsigned char lds_raw[];
    const int wave0 = __builtin_amdgcn_readfirstlane(threadIdx.x >> 6);
    run_phase<PH>(P, l, (LAS unsigned char*)lds_raw, wave0);
}
#ifdef MEGA
__global__ void __launch_bounds__(512, 2) mega(Params P) {
    extern __shared__ __attribute__((aligned(16))) unsigned char lds_raw[];
    LAS unsigned char* lds = (LAS unsigned char*)lds_raw;
    const int wave0 = __builtin_amdgcn_readfirstlane(threadIdx.x >> 6);
    volatile LAS unsigned* bst = (volatile LAS unsigned*)(lds + LDS_BYTES - 32);
    if (threadIdx.x < 2) bst[threadIdx.x] = 0u;
    __syncthreads();
    unsigned* barw; { GAS unsigned char* wsg_ = (GAS unsigned char*)P.ws; barw = (unsigned*)(unsigned char*)(wsg_ + WS_CTL) + 4096; }
    XcdBarrier xb = xcd_barrier_post(barw, bst, (int)threadIdx.x);
#define GRIDBAR() do { int lane_b; asm volatile("v_mbcnt_lo_u32_b32 %0, -1, 0\n\tv_mbcnt_hi_u32_b32 %0, -1, %0" : "=v"(lane_b)); xcd_barrier(xb, wave0 * 64 + lane_b); } while (0)
    cg::this_grid().sync();
    run_phase<0>(P, 0, lds, wave0);
    GRIDBAR();
    const int tidz = (int)(blockIdx.x * 512 + threadIdx.x); (void)tidz;
#pragma unroll 1
    for (int l = 0; l < 2; ++l) {
        run_phase<1>(P, l, lds, wave0); GRIDBAR();
        run_phase<2>(P, l, lds, wave0); GRIDBAR();
#if defined(DUP_PH) && DUP_PH == 2
        if (tidz == 0) { unsigned* qc = (unsigned*)(P.ws + WS_CTL) + 64 * l; __hip_atomic_store(qc, (unsigned)DUP_UMIN, __ATOMIC_RELAXED, __HIP_MEMORY_SCOPE_AGENT); }
        GRIDBAR(); run_phase<2>(P, l, lds, wave0, DUP_UMAX); GRIDBAR();
#endif
        run_phase<3>(P, l, lds, wave0); GRIDBAR();
        run_phase<5>(P, l, lds, wave0); GRIDBAR();
        run_phase<6>(P, l, lds, wave0); GRIDBAR();
        run_phase<7>(P, l, lds, wave0); GRIDBAR();
        run_phase<8>(P, l, lds, wave0); GRIDBAR();
        run_phase<9>(P, l, lds, wave0);
        if (l == 0) GRIDBAR();
    }
#undef GRIDBAR
}
#endif


__global__ void dbg_copy(const bf16_t* src, float* out, int ld, int ncol, int planes = 1) {
    const size_t m = blockIdx.x;
    for (int c = threadIdx.x; c < 1024; c += blockDim.x) { float a = 0.f; for (int pl = 0; pl < planes; ++pl) for (int k = c; k < ncol; k += 1024) a += bf2f(src[((size_t)pl * M + m) * ld + k]); out[m * 1024 + c] = a; }
}
__global__ void dbg_prm(const unsigned char* ws, float* out) {
    const int i = blockIdx.x * blockDim.x + threadIdx.x;
    if (i < 4096) out[i] = ((const float*)(ws + WS_ABAR))[i];
    else if (i < 4096 + 65536) out[i] = bf2f(((const bf16_t*)(ws + WS_BB))[i - 4096]);
    else if (i < 4096 + 131072) out[i] = bf2f(((const bf16_t*)(ws + WS_CC))[i - 4096 - 65536]);
    else if (i < 4096 + 131072 + 16384) out[i] = ((const float*)(ws + 58 * MiB))[i - 4096 - 131072];
}
template <int PH> static void launch_phase(const Params& p, int l, int grid, hipStream_t stream) {
    static bool attr = false;
    if (!attr) { (void)hipFuncSetAttribute((const void*)phase_k<PH>, hipFuncAttributeMaxDynamicSharedMemorySize, LDS_BYTES); attr = true; }
    hipLaunchKernelGGL(phase_k<PH>, dim3(grid), dim3(512), LDS_BYTES, stream, p, l);
}
extern "C" void kernel_launch(void* const* d_in, const int* in_sizes, int n_in, void* d_out, int out_size, void* d_ws, size_t ws_size, hipStream_t stream) {
    static int grid = 0;
    if (grid == 0) {
        if (n_in != 21 || in_sizes[0] != M * DM || out_size != M * DM || ws_size < WS_END) { fprintf(stderr, "kernel_launch: unexpected shapes: n_in %d in0 %d out %d ws %zu\n", n_in, n_in > 0 ? in_sizes[0] : -1, out_size, ws_size); grid = -1; return; }
        int dev = 0, cus = 0, per_cu = 1;
        (void)hipGetDevice(&dev); (void)hipDeviceGetAttribute(&cus, hipDeviceAttributeMultiprocessorCount, dev);
#ifdef MEGA
        if (hipFuncSetAttribute((const void*)mega, hipFuncAttributeMaxDynamicSharedMemorySize, LDS_BYTES) != hipSuccess) { fprintf(stderr, "kernel_launch: hipFuncSetAttribute failed\n"); grid = -1; return; }
        if (hipOccupancyMaxActiveBlocksPerMultiprocessor(&per_cu, (const void*)mega, 512, LDS_BYTES) != hipSuccess || per_cu < 1) { fprintf(stderr, "kernel_launch: occupancy query says %d\n", per_cu); per_cu = 1; }
        (void)hipGetLastError();
#endif
        grid = cus * per_cu;
    }
    if (grid < 0) return;
    if (hipMemsetAsync((char*)d_ws + WS_CTL, 0, 65536, stream) != hipSuccess) { fprintf(stderr, "kernel_launch: memset failed\n"); return; }
    Params p{};
    for (int i = 0; i < 21; ++i) p.in[i] = (const float*)d_in[i];
    p.out = (float*)d_out; p.ws = (unsigned char*)d_ws;
#ifdef MEGA
    void* args[] = {&p};
    hipError_t e = hipLaunchCooperativeKernel((const void*)mega, dim3(grid), dim3(512), args, LDS_BYTES, stream);
    if (e != hipSuccess) fprintf(stderr, "kernel_launch: cooperative launch failed: %s (grid %d)\n", hipGetErrorString(e), grid);
#else
    launch_phase<0>(p, 0, grid, stream);
#if defined(DBG_STOP) && DBG_STOP == 100
    hipLaunchKernelGGL(dbg_prm, dim3(640), dim3(256), 0, stream, (const unsigned char*)d_ws, (float*)d_out); return;
#endif
    for (int l = 0; l < 2; ++l) {
#if defined(DBG_STOP) && DBG_STOP == 1
        launch_phase<1>(p, l, grid, stream); hipLaunchKernelGGL(dbg_copy, dim3(M), dim3(256), 0, stream, (const bf16_t*)((unsigned char*)d_ws + WS_PROJ), (float*)d_out, LDP, LDP); return;
#endif
#if defined(DBG_STOP) && DBG_STOP == 21
        launch_phase<1>(p, l, grid, stream); launch_phase<2>(p, l, grid, stream); hipLaunchKernelGGL(dbg_copy, dim3(M), dim3(256), 0, stream, (const bf16_t*)((unsigned char*)d_ws + WS_FOXO), (float*)d_out, 384, 384, 1); return;
#endif
#if defined(DBG_STOP) && DBG_STOP == 22
        launch_phase<1>(p, l, grid, stream); launch_phase<2>(p, l, grid, stream); hipLaunchKernelGGL(dbg_copy, dim3(M), dim3(256), 0, stream, (const bf16_t*)((unsigned char*)d_ws + WS_DSAO), (float*)d_out, 384, 384, 3); return;
#endif
#if defined(DBG_STOP) && DBG_STOP == 23
        launch_phase<1>(p, l, grid, stream); launch_phase<2>(p, l, grid, stream); hipLaunchKernelGGL(dbg_copy, dim3(M), dim3(256), 0, stream, (const bf16_t*)((unsigned char*)d_ws + WS_G), (float*)d_out, 256, 256, 1); return;
#endif
#if defined(DBG_STOP) && DBG_STOP == 4
        launch_phase<1>(p, l, grid, stream); launch_phase<2>(p, l, grid, stream); launch_phase<3>(p, l, grid, stream); launch_phase<4>(p, l, grid, stream);
        hipLaunchKernelGGL(dbg_copy, dim3(M), dim3(256), 0, stream, (const bf16_t*)((unsigned char*)d_ws + WS_BUFA), (float*)d_out, 1024, 1024); return;
#endif
        launch_phase<1>(p, l, grid, stream); launch_phase<2>(p, l, grid, stream); launch_phase<3>(p, l, grid, stream); launch_phase<4>(p, l, grid, stream); launch_phase<5>(p, l, grid, stream);
        launch_phase<6>(p, l, grid, stream); launch_phase<7>(p, l, grid, stream); launch_phase<8>(p, l, grid, stream); launch_phase<9>(p, l, grid, stream);
    }
#endif
}
```

```cpp
#define MEGA 1
#include <hip/hip_runtime.h>
#include <hip/hip_cooperative_groups.h>
#include <cstdio>
#include <cstdint>
namespace cg = cooperative_groups;
namespace pg8 {
#define PG8_LAS __attribute__((address_space(3)))
typedef unsigned short bf16_t;
typedef short bf16x8 __attribute__((ext_vector_type(8)));
typedef float f32x4 __attribute__((ext_vector_type(4)));
typedef unsigned u32x4 __attribute__((ext_vector_type(4)));
constexpr int BM = 256, BK = 64, HALF = 128, HTB = HALF * BK * 2  , STAGE_BYTES = 8 * HTB, NXCD = 8, WGM = 8;

__host__ __device__ __forceinline__ int lds_byte(int r, int c) { const int st = (r >> 4) * 2 + (c >> 5), rr = r & 15, cc = c & 31, ob = rr * 64 + cc * 2; return st * 1024 + (ob ^ (((ob >> 9) & 1) << 5)); }
__host__ __device__ __forceinline__ void stage_rc(int b, int& R, int& C) { const int st = b / 1024, sb = b % 1024, swz = sb ^ (((sb >> 9) & 1) << 5); R = (st >> 1) * 16 + swz / 64; C = (st & 1) * 32 + (swz % 64) / 2; }
__host__ __device__ __forceinline__ int perm32(int rho) { const int n = rho >> 4, i = rho & 15; return 8 * (i >> 2) + 4 * n + (i & 3); }

struct Unit { int pm, pn; };
struct Gemm { const bf16_t* A; const bf16_t* Bt; int M, N, K; };

struct StaticOrder {
    int nM, nN, nwg, G, c;
    __host__ __device__ void init(int M, int N, int G_, int c_) { nM = M / BM; nN = N / BM; nwg = nM * nN; G = G_; c = c_; }
    __host__ __device__ bool next(int i, Unit& u) const {
        const long L = (long)i * G + c; if (L >= nwg) return false;
        int wgid = (int)L; { const int q = nwg / NXCD, r = nwg % NXCD, xcd = wgid % NXCD, off = wgid / NXCD; wgid = (xcd < r ? xcd * (q + 1) : r * (q + 1) + (xcd - r) * q) + off; }
        const int nig = WGM * nN, gid = wgid / nig, fm = gid * WGM, gsz = (nM - fm) < WGM ? (nM - fm) : WGM;
        u.pm = fm + ((wgid % nig) % gsz); u.pn = (wgid % nig) / gsz; return true;
    }
    __device__ __forceinline__ void a_ready(const Unit&) const {}
    __device__ __forceinline__ void done(const Unit&) const {}
};

__device__ __forceinline__ unsigned cvt_pk_bf16(float lo, float hi) { unsigned r; asm volatile("v_cvt_pk_bf16_f32 %0, %1, %2" : "=v"(r) : "v"(lo), "v"(hi)); return r; }
typedef float f32x2 __attribute__((ext_vector_type(2)));
__device__ __forceinline__ f32x2 gelu_pk(f32x2 v) {
    const f32x2 av = __builtin_elementwise_abs(v), d = av * 0.2316418882f + 1.0f;
    f32x2 t; t.x = __builtin_amdgcn_rcpf(d.x); t.y = __builtin_amdgcn_rcpf(d.y);
    f32x2 q = t * 0.5307027145f + (-0.7265760135f); q = q * t + 0.7107068705f; q = q * t + (-0.142248368f); q = q * t + 0.127414796f; q = q * t;
    const f32x2 s = (v * v) * (-0.72134752044f);
    f32x2 e; e.x = __builtin_amdgcn_exp2f(s.x); e.y = __builtin_amdgcn_exp2f(s.y);
    const f32x2 m = v * (q * e), r = v - m;
    f32x2 o; o.x = v.x < 0.f ? m.x : r.x; o.y = v.y < 0.f ? m.y : r.y; return o;
}

template <int ACT  > struct EpiBf16 {
    static constexpr bool PERM = true, AFTER_DRAIN = false; static_assert(ACT == 0 || ACT == 1, "EpiBf16: ACT is 0 (none) or 1 (gelu_pk)");
    bf16_t* O; int ldc; const float* bias; int split_cols; size_t split_stride; float scale0;
    __device__ __forceinline__ void operator()(const f32x4 (&acc)[2][2][4][2], const Unit& u, int wr, int wc, int fr, int fq) const {
        const int row0 = u.pm * BM + wr * 64 + fr; int colt = u.pn * BM; bf16_t* base = O;
        float sc = 1.f; if (split_cols) { const int t = colt / split_cols; base += (size_t)t * split_stride; colt -= t * split_cols; if (t == 0) sc = scale0; }
        const int col0 = colt + wc * 32 + 8 * fq, bcol0 = u.pn * BM + wc * 32 + 8 * fq;
        f32x4 bv[2][2];
#pragma unroll
        for (int bj = 0; bj < 2; ++bj)
#pragma unroll
            for (int n = 0; n < 2; ++n) bv[bj][n] = bias ? *(const f32x4*)(bias + bcol0 + bj * HALF + 4 * n) : (f32x4){0.f, 0.f, 0.f, 0.f};
#pragma unroll
        for (int ai = 0; ai < 2; ++ai)
#pragma unroll
            for (int m = 0; m < 4; ++m) { bf16_t* rowp = base + (size_t)(row0 + ai * HALF + m * 16) * ldc + col0;
#pragma unroll
                for (int bj = 0; bj < 2; ++bj) { f32x4 v0 = acc[ai][bj][m][0] + bv[bj][0], v1 = acc[ai][bj][m][1] + bv[bj][1];
                    if (ACT == 1) { f32x2 a = gelu_pk((f32x2){v0[0], v0[1]}), b = gelu_pk((f32x2){v0[2], v0[3]}), c = gelu_pk((f32x2){v1[0], v1[1]}), d = gelu_pk((f32x2){v1[2], v1[3]});
                        v0 = (f32x4){a.x, a.y, b.x, b.y}; v1 = (f32x4){c.x, c.y, d.x, d.y}; }
                    v0 = v0 * sc; v1 = v1 * sc; u32x4 w; w.x = cvt_pk_bf16(v0[0], v0[1]); w.y = cvt_pk_bf16(v0[2], v0[3]); w.z = cvt_pk_bf16(v1[0], v1[1]); w.w = cvt_pk_bf16(v1[2], v1[3]);
                    *(u32x4*)(rowp + bj * HALF) = w; } }
    }
};
template <class Epi, class Sched, bool ALIGN_EPI = false, bool SP2 = false>
__device__ __forceinline__ void gemm_phase(PG8_LAS unsigned char* lds, const Gemm g, const Sched& S, const Epi& E, const int wave_in) {
    int lane_l; asm volatile("v_mbcnt_lo_u32_b32 %0, -1, 0\n\tv_mbcnt_hi_u32_b32 %0, -1, %0" : "=v"(lane_l));
    const int wid = wave_in, lane = lane_l, tid = wid * 64 + lane, wr = wid >> 2, wc = wid & 3, fr = lane & 15, fq = lane >> 4;
    const int K = g.K, nt = K / BK;
    unsigned voffA[2], voffB[2];
#pragma unroll
    for (int i = 0; i < 2; ++i) { int R, C; stage_rc(tid * 16 + i * 8192, R, C); const int Rb = Epi::PERM ? ((R & ~31) + perm32(R & 31)) : R;
        voffA[i] = (unsigned)(R * K + C) * 2u; voffB[i] = (unsigned)(Rb * K + C) * 2u; }
    const size_t kstep = (size_t)(BK * 2);
    const size_t hstep = (size_t)HALF * K * 2;
    const size_t tstep = 2 * hstep;
    const unsigned ldsw = (unsigned)wid * 1024u;
    const int aoff = lds_byte(wr * 64 + fr, fq * 8), boff = lds_byte(wc * 32 + fr, fq * 8);
#define PG8_SA(b, h) (((b) * 2 + (h)) * HTB)
#define PG8_SB(b, h) ((4 + (b) * 2 + (h)) * HTB)
#define PG8_STAGE(bufoff, gbase, voff) do { _Pragma("unroll") for (int _i = 0; _i < 2; ++_i) \
        __builtin_amdgcn_global_load_lds((const unsigned*)((const char*)(gbase) + (voff)[_i]), (PG8_LAS unsigned*)(lds + (bufoff) + ldsw + _i * 8192), 16, 0, 0); } while (0)
#define PG8_LDA(dst, b, h) do { _Pragma("unroll") for (int m = 0; m < 4; ++m) _Pragma("unroll") for (int k = 0; k < 2; ++k) dst[m][k] = *(const PG8_LAS bf16x8*)(lds + PG8_SA(b, h) + aoff + m * 2048 + k * 1024); } while (0)
#define PG8_LDB(dst, b, h) do { _Pragma("unroll") for (int n = 0; n < 2; ++n) _Pragma("unroll") for (int k = 0; k < 2; ++k) dst[n][k] = *(const PG8_LAS bf16x8*)(lds + PG8_SB(b, h) + boff + n * 2048 + k * 1024); } while (0)
#define PG8_MMA(ai, bj, At, Bt) do { __builtin_amdgcn_s_setprio(1); _Pragma("unroll") for (int m = 0; m < 4; ++m) _Pragma("unroll") for (int n = 0; n < 2; ++n) _Pragma("unroll") for (int k = 0; k < 2; ++k) \
        acc[ai][bj][m][n] = __builtin_amdgcn_mfma_f32_16x16x32_bf16(Bt[n][k], At[m][k], acc[ai][bj][m][n], 0, 0, 0); __builtin_amdgcn_s_setprio(0); } while (0)
#define PG8_WAIT_V(n) asm volatile("s_waitcnt vmcnt(" #n ")" ::: "memory")
#define PG8_WAIT_L(n) asm volatile("s_waitcnt lgkmcnt(" #n ")" ::: "memory")
#define PG8_BAR __builtin_amdgcn_s_barrier()
#define PG8_SCHED __builtin_amdgcn_sched_barrier(0)
    Unit cur, nxt; int ui = 0;
    if (!S.next(0, cur)) return;
    f32x4 acc[2][2][4][2];
#pragma unroll
    for (int a = 0; a < 2; ++a)
#pragma unroll
        for (int b = 0; b < 2; ++b)
#pragma unroll
            for (int m = 0; m < 4; ++m)
#pragma unroll
                for (int n = 0; n < 2; ++n) acc[a][b][m][n] = (f32x4){0.f, 0.f, 0.f, 0.f};
    bf16x8 At[4][2], B0[2][2], B1[2][2];
    const char* cA = (const char*)g.A + (size_t)cur.pm * tstep; const char* cB = (const char*)g.Bt + (size_t)cur.pn * tstep;
    S.a_ready(cur);
    if constexpr (SP2) {
        PG8_STAGE(PG8_SB(0, 0), cB, voffB); PG8_STAGE(PG8_SB(0, 1), cB + hstep, voffB); PG8_STAGE(PG8_SA(0, 0), cA, voffA); PG8_STAGE(PG8_SA(0, 1), cA + hstep, voffA);
        if (wr == 1) PG8_BAR;
        PG8_WAIT_V(2); PG8_BAR;
        PG8_STAGE(PG8_SB(1, 0), cB + kstep, voffB); PG8_STAGE(PG8_SA(1, 0), cA + kstep, voffA); PG8_STAGE(PG8_SB(1, 1), cB + hstep + kstep, voffB);
        PG8_WAIT_V(6); PG8_BAR;
    } else {
        PG8_STAGE(PG8_SB(0, 0), cB, voffB); PG8_STAGE(PG8_SA(0, 0), cA, voffA); PG8_STAGE(PG8_SB(0, 1), cB + hstep, voffB); PG8_STAGE(PG8_SA(0, 1), cA + hstep, voffA);
        if (wr == 1) PG8_BAR;
        PG8_WAIT_V(4); PG8_BAR;
        PG8_STAGE(PG8_SB(1, 0), cB + kstep, voffB); PG8_STAGE(PG8_SA(1, 0), cA + kstep, voffA); PG8_STAGE(PG8_SB(1, 1), cB + hstep + kstep, voffB);
        PG8_WAIT_V(6); PG8_BAR;
    }
    for (;;) {
        const bool has_next = S.next(ui + 1, nxt);
        const char* nA = has_next ? (const char*)g.A + (size_t)nxt.pm * tstep : cA; const char* nB = has_next ? (const char*)g.Bt + (size_t)nxt.pn * tstep : cB;
        for (int t = 0; t < nt; t += 2) {
            const bool last = (t == nt - 2);
            const char* a1 = cA + (size_t)(t + 1) * kstep;
            const char* a2 = last ? nA : cA + (size_t)(t + 2) * kstep; const char* b2 = last ? nB : cB + (size_t)(t + 2) * kstep;
            const char* a3 = a2 + kstep; const char* b3 = b2 + kstep;
            if (last && has_next) S.a_ready(nxt);
            if constexpr (SP2) {
            PG8_LDB(B0, 0, 0); PG8_LDB(B1, 0, 1); PG8_SCHED; PG8_LDA(At, 0, 0); PG8_STAGE(PG8_SA(1, 1), a1 + hstep, voffA);
            PG8_WAIT_V(8); PG8_WAIT_L(0); PG8_BAR; PG8_MMA(0, 0, At, B0); PG8_MMA(0, 1, At, B1); PG8_BAR; PG8_SCHED;
            PG8_LDA(At, 0, 1); PG8_STAGE(PG8_SB(0, 0), b2, voffB); PG8_STAGE(PG8_SB(0, 1), b2 + hstep, voffB); PG8_STAGE(PG8_SA(0, 0), a2, voffA);
            PG8_WAIT_V(8); PG8_WAIT_L(0); PG8_BAR; PG8_MMA(1, 0, At, B0); PG8_MMA(1, 1, At, B1); PG8_BAR; PG8_SCHED;
            PG8_LDB(B0, 1, 0); PG8_LDB(B1, 1, 1); PG8_SCHED; PG8_LDA(At, 1, 0); PG8_STAGE(PG8_SA(0, 1), a2 + hstep, voffA);
            PG8_WAIT_V(8); PG8_WAIT_L(0); PG8_BAR; PG8_MMA(0, 0, At, B0); PG8_MMA(0, 1, At, B1); PG8_BAR; PG8_SCHED;
            PG8_LDA(At, 1, 1); PG8_STAGE(PG8_SB(1, 0), b3, voffB); PG8_STAGE(PG8_SB(1, 1), b3 + hstep, voffB); PG8_STAGE(PG8_SA(1, 0), a3, voffA);
            PG8_WAIT_V(8); PG8_WAIT_L(0); PG8_BAR; PG8_MMA(1, 0, At, B0); PG8_MMA(1, 1, At, B1); PG8_BAR; PG8_SCHED;
            } else {
            PG8_LDB(B0, 0, 0); PG8_SCHED; PG8_LDA(At, 0, 0); PG8_STAGE(PG8_SA(1, 1), a1 + hstep, voffA);
            PG8_WAIT_L(8); PG8_BAR; PG8_WAIT_L(0); PG8_MMA(0, 0, At, B0); PG8_BAR; PG8_SCHED;
            PG8_LDB(B1, 0, 1); PG8_STAGE(PG8_SB(0, 0), b2, voffB);
            PG8_BAR; PG8_WAIT_L(0); PG8_MMA(0, 1, At, B1); PG8_BAR;
            PG8_LDA(At, 0, 1); PG8_STAGE(PG8_SA(0, 0), a2, voffA);
            PG8_BAR; PG8_WAIT_L(0); PG8_MMA(1, 0, At, B0); PG8_BAR; PG8_SCHED;
            PG8_STAGE(PG8_SB(0, 1), b2 + hstep, voffB);
            PG8_WAIT_V(6); PG8_BAR; PG8_MMA(1, 1, At, B1); PG8_BAR;
            PG8_LDB(B0, 1, 0); PG8_SCHED; PG8_LDA(At, 1, 0); PG8_STAGE(PG8_SA(0, 1), a2 + hstep, voffA);
            PG8_WAIT_L(8); PG8_BAR; PG8_WAIT_L(0); PG8_MMA(0, 0, At, B0); PG8_BAR; PG8_SCHED;
            PG8_LDB(B1, 1, 1); PG8_STAGE(PG8_SB(1, 0), b3, voffB);
            PG8_BAR; PG8_WAIT_L(0); PG8_MMA(0, 1, At, B1); PG8_BAR;
            PG8_LDA(At, 1, 1); PG8_STAGE(PG8_SA(1, 0), a3, voffA);
            PG8_BAR; PG8_WAIT_L(0); PG8_MMA(1, 0, At, B0); PG8_BAR; PG8_SCHED;
            PG8_STAGE(PG8_SB(1, 1), b3 + hstep, voffB);
            PG8_WAIT_V(6); PG8_BAR; PG8_MMA(1, 1, At, B1); PG8_BAR;
            }
        }
        if constexpr (ALIGN_EPI) { if (wr == 0) PG8_BAR; }
        if constexpr (!Epi::AFTER_DRAIN) { E(acc, cur, wr, wc, fr, fq); S.done(cur); }
        if (!has_next) break;
#pragma unroll
        for (int a = 0; a < 2; ++a)
#pragma unroll
            for (int b = 0; b < 2; ++b)
#pragma unroll
                for (int m = 0; m < 4; ++m)
#pragma unroll
                    for (int n = 0; n < 2; ++n) acc[a][b][m][n] = (f32x4){0.f, 0.f, 0.f, 0.f};
        cur = nxt; cA = nA; cB = nB; ++ui;
        if constexpr (ALIGN_EPI) { if (wr == 1) PG8_BAR; }
    }
    PG8_WAIT_V(0);
    if constexpr (!ALIGN_EPI) { if (wr == 0) PG8_BAR; }
    PG8_BAR;
    if constexpr (Epi::AFTER_DRAIN) { E.fused(acc, cur, wr, wc, fr, fq, lds, wid, lane); S.done(cur); }
#undef PG8_SA
#undef PG8_SB
#undef PG8_STAGE
#undef PG8_LDA
#undef PG8_LDB
#undef PG8_MMA
#undef PG8_WAIT_V
#undef PG8_WAIT_L
#undef PG8_BAR
#undef PG8_SCHED
}
}
#define LAS __attribute__((address_space(3)))
#define GAS __attribute__((address_space(1)))
typedef unsigned short bf16_t;
typedef short bf16x8 __attribute__((ext_vector_type(8)));
typedef float f32x4 __attribute__((ext_vector_type(4)));
typedef float f32x16 __attribute__((ext_vector_type(16)));
typedef unsigned u32x4 __attribute__((ext_vector_type(4)));
typedef unsigned u32x2 __attribute__((ext_vector_type(2)));
constexpr int NB = 32, SEQ = 2048, DM = 1024, M = NB * SEQ;
constexpr int NIN = 2566, NINP = 2816, DFF = 2816, NGU = 5632, LDP = 2816;
constexpr int COL_DQ = 256, COL_DK = 640, COL_DV = 1024, COL_FQ = 1408, COL_FK = 1792, COL_FV = 2176;
constexpr float EPS = 1e-6f, LOG2E = 1.4426950408889634f, QK_C = 0.125f * 1.4426950408889634f;
constexpr size_t MiB = (size_t)1 << 20;
constexpr size_t WS_WIN = 0, WS_WOUT = 11 * MiB, WS_WGU = 15 * MiB, WS_WDN = 37 * MiB, WS_WGLU = 48 * MiB;
constexpr size_t WS_ABAR = 49 * MiB, WS_BB = 49 * MiB + 65536, WS_CC = 49 * MiB + 262144, WS_FL = 50 * MiB, WS_LSE = 52 * MiB;
constexpr size_t WS_BUFA = 64 * MiB, WS_BUFB = 192 * MiB, WS_PROJ = 320 * MiB, WS_DSAO = 672 * MiB, WS_FOXO = 816 * MiB, WS_G = 864 * MiB, WS_SSMO = 896 * MiB, WS_END = 928 * MiB;
constexpr int LDS_BYTES = 147456;
constexpr size_t WS_CTL = 59 * MiB;

struct Params { const float* in[21]; float* out; unsigned char* ws; };
enum { I_X = 0, I_GPRE, I_WIN, I_BF, I_LDT, I_ARE, I_AIM, I_BRE, I_BIM, I_CRE, I_CIM, I_SD, I_WGLU, I_BGLU, I_GMIX, I_WOUT, I_GPOST, I_GPREF, I_WGU, I_WDN, I_GPOSTF };

__device__ __forceinline__ unsigned cvtpk(float lo, float hi) { typedef float f2 __attribute__((ext_vector_type(2))); typedef __bf16 b2 __attribute__((ext_vector_type(2))); f2 v = {lo, hi}; b2 b = __builtin_convertvector(v, b2); return __builtin_bit_cast(unsigned, b); }
__device__ __forceinline__ float bf2f(unsigned v) { return __uint_as_float(v << 16); }
__device__ __forceinline__ float bflo(unsigned w) { return __uint_as_float(w << 16); }
__device__ __forceinline__ float bfhi(unsigned w) { return __uint_as_float(w & 0xffff0000u); }
__device__ __forceinline__ float wave_sum(float v) {
#pragma unroll
    for (int o = 1; o < 64; o <<= 1) v += __shfl_xor(v, o);
    return v;
}
__device__ __forceinline__ float sigmoidf_(float x) { return __builtin_amdgcn_rcpf(1.0f + __expf(-x)); }
__device__ __forceinline__ float gelu_tanh(float y) { const float u = 0.7978845608028654f * (y + 0.044715f * y * y * y); return y * __builtin_amdgcn_rcpf(1.0f + __expf(-2.0f * u)); }
__device__ __forceinline__ float logsig(float z) { return fminf(z, 0.f) - __logf(1.0f + __expf(-fabsf(z))); }
#define LDS_WAIT() asm volatile("s_waitcnt lgkmcnt(0)" ::: "memory")

namespace pg8 {
struct EpiProj {
    static constexpr bool PERM = true, AFTER_DRAIN = false;
    bf16_t* O; float* FL; const float* bf;
    __device__ __forceinline__ void operator()(const f32x4 (&acc)[2][2][4][2], const Unit& u, int wr, int wc, int fr, int fq) const {
        const int row0 = u.pm * BM + wr * 64 + fr, col0 = u.pn * BM + wc * 32 + 8 * fq;
#pragma unroll
        for (int ai = 0; ai < 2; ++ai)
#pragma unroll
            for (int m = 0; m < 4; ++m) { bf16_t* rowp = O + (size_t)(row0 + ai * HALF + m * 16) * LDP + col0;
#pragma unroll
                for (int bj = 0; bj < 2; ++bj) { const f32x4 v0 = acc[ai][bj][m][0], v1 = acc[ai][bj][m][1];
                    u32x4 w; w.x = cvtpk(v0[0], v0[1]); w.y = cvtpk(v0[2], v0[3]); w.z = cvtpk(v1[0], v1[1]); w.w = cvtpk(v1[2], v1[3]);
                    *(u32x4*)(rowp + bj * HALF) = w; } }
        if (u.pn == 10 && wc == 0 && fq == 0) {
            float b6[6];
#pragma unroll
            for (int j = 0; j < 6; ++j) b6[j] = bf[j];
#pragma unroll
            for (int ai = 0; ai < 2; ++ai)
#pragma unroll
                for (int m = 0; m < 4; ++m) { float* fp = FL + (size_t)(row0 + ai * HALF + m * 16) * 8; const f32x4 v0 = acc[ai][0][m][0], v1 = acc[ai][0][m][1];
                    f32x4 o0, o1; o0[0] = logsig(v0[0] + b6[0]); o0[1] = logsig(v0[1] + b6[1]); o0[2] = logsig(v0[2] + b6[2]); o0[3] = logsig(v0[3] + b6[3]);
                    o1[0] = logsig(v1[0] + b6[4]); o1[1] = logsig(v1[1] + b6[5]); o1[2] = 0.f; o1[3] = 0.f;
                    *(f32x4*)fp = o0; *(f32x4*)(fp + 4) = o1; }
        }
    }
};
struct EpiSwiGLU {
    static constexpr bool PERM = true, AFTER_DRAIN = false;
    bf16_t* H;
    __device__ __forceinline__ void operator()(const f32x4 (&acc)[2][2][4][2], const Unit& u, int wr, int wc, int fr, int fq) const {
        const int row0 = u.pm * BM + wr * 64 + fr, col0 = u.pn * HALF + wc * 32 + 8 * fq;
#pragma unroll
        for (int ai = 0; ai < 2; ++ai)
#pragma unroll
            for (int m = 0; m < 4; ++m) { bf16_t* rowp = H + (size_t)(row0 + ai * HALF + m * 16) * DFF + col0;
                float h[8];
#pragma unroll
                for (int n = 0; n < 2; ++n)
#pragma unroll
                    for (int i = 0; i < 4; ++i) { const float g = acc[ai][0][m][n][i], up = acc[ai][1][m][n][i]; h[n * 4 + i] = g * sigmoidf_(g) * up; }
                u32x4 w; w.x = cvtpk(h[0], h[1]); w.y = cvtpk(h[2], h[3]); w.z = cvtpk(h[4], h[5]); w.w = cvtpk(h[6], h[7]);
                *(u32x4*)rowp = w; }
    }
};
struct EpiGLU {
    static constexpr bool PERM = true, AFTER_DRAIN = false;
    const bf16_t* G; bf16_t* O; const float* bg;
    __device__ __forceinline__ void operator()(const f32x4 (&acc)[2][2][4][2], const Unit& u, int wr, int wc, int fr, int fq) const {
        const int row0 = u.pm * BM + wr * 64 + fr, col0 = wc * 32 + 8 * fq;
#pragma unroll
        for (int bj = 0; bj < 2; ++bj) {
#pragma unroll
            for (int ai = 0; ai < 2; ++ai)
#pragma unroll
                for (int m = 0; m < 4; ++m) { const size_t off = (size_t)(row0 + ai * HALF + m * 16) * 256 + col0 + bj * HALF;
                    const f32x4 b0 = *(const f32x4*)(bg + col0 + bj * HALF), b1 = *(const f32x4*)(bg + col0 + bj * HALF + 4);
                    const u32x4 gw = *(const u32x4*)(G + off); const f32x4 v0 = acc[ai][bj][m][0] + b0, v1 = acc[ai][bj][m][1] + b1;
                    u32x4 w; w.x = cvtpk(bflo(gw.x) * sigmoidf_(v0[0]), bfhi(gw.x) * sigmoidf_(v0[1])); w.y = cvtpk(bflo(gw.y) * sigmoidf_(v0[2]), bfhi(gw.y) * sigmoidf_(v0[3]));
                    w.z = cvtpk(bflo(gw.z) * sigmoidf_(v1[0]), bfhi(gw.z) * sigmoidf_(v1[1])); w.w = cvtpk(bflo(gw.w) * sigmoidf_(v1[2]), bfhi(gw.w) * sigmoidf_(v1[3]));
                    *(u32x4*)(O + off) = w; asm volatile("" ::: "memory"); } }
    }
};
struct EpiGLUNorm {
    static constexpr bool PERM = true, AFTER_DRAIN = true;
    const bf16_t* G; bf16_t* MIX; const float* bg; const float* gm;
    __device__ __forceinline__ void fused(f32x4 (&acc)[2][2][4][2], const Unit& u, int wr, int wc, int fr, int fq, PG8_LAS unsigned char* lds, int wid, int lane) const {
        PG8_LAS float* Pss = (PG8_LAS float*)lds;
        const int row0 = u.pm * BM + wr * 64 + fr, col0 = wc * 32 + 8 * fq;
#pragma unroll
        for (int bj = 0; bj < 2; ++bj) { const f32x4 b0 = *(const f32x4*)(bg + col0 + bj * HALF), b1 = *(const f32x4*)(bg + col0 + bj * HALF + 4);
#pragma unroll
            for (int ai = 0; ai < 2; ++ai)
#pragma unroll
                for (int m = 0; m < 4; ++m) { const size_t off = (size_t)(row0 + ai * HALF + m * 16) * 256 + col0 + bj * HALF;
                    const u32x4 gw = *(const u32x4*)(G + off); const f32x4 v0 = acc[ai][bj][m][0] + b0, v1 = acc[ai][bj][m][1] + b1;
                    acc[ai][bj][m][0] = (f32x4){bflo(gw.x) * sigmoidf_(v0[0]), bfhi(gw.x) * sigmoidf_(v0[1]), bflo(gw.y) * sigmoidf_(v0[2]), bfhi(gw.y) * sigmoidf_(v0[3])};
                    acc[ai][bj][m][1] = (f32x4){bflo(gw.z) * sigmoidf_(v1[0]), bfhi(gw.z) * sigmoidf_(v1[1]), bflo(gw.w) * sigmoidf_(v1[2]), bfhi(gw.w) * sigmoidf_(v1[3])};
                    asm volatile("" ::: "memory"); } }
#pragma unroll
        for (int ai = 0; ai < 2; ++ai)
#pragma unroll
            for (int m = 0; m < 4; ++m) { float ss = 0.f;
#pragma unroll
                for (int bj = 0; bj < 2; ++bj)
#pragma unroll
                    for (int n = 0; n < 2; ++n) { const f32x4 x = acc[ai][bj][m][n]; ss += (x[0] * x[0] + x[1] * x[1]) + (x[2] * x[2] + x[3] * x[3]); }
                ss += __shfl_xor(ss, 16); ss += __shfl_xor(ss, 32);
                if (fq == 0) Pss[(ai * HALF + wr * 64 + m * 16 + fr) * 4 + wc] = ss; }
        asm volatile("s_waitcnt lgkmcnt(0)" ::: "memory"); __builtin_amdgcn_s_barrier(); asm volatile("" ::: "memory");
#pragma unroll
        for (int ai = 0; ai < 2; ++ai)
#pragma unroll
            for (int m = 0; m < 4; ++m) { const f32x4 q = *(const PG8_LAS f32x4*)(Pss + (ai * HALF + wr * 64 + m * 16 + fr) * 4);
                const float rs = 1.0f / sqrtf(((q[0] + q[1]) + (q[2] + q[3])) * (1.0f / 256.0f) + 1e-6f);
#pragma unroll
                for (int bj = 0; bj < 2; ++bj) { const f32x4 g0 = *(const f32x4*)(gm + col0 + bj * HALF), g1 = *(const f32x4*)(gm + col0 + bj * HALF + 4);
                    const f32x4 o0 = acc[ai][bj][m][0] * rs * g0, o1 = acc[ai][bj][m][1] * rs * g1;
                    u32x4 w; w.x = cvtpk(o0[0], o0[1]); w.y = cvtpk(o0[2], o0[3]); w.z = cvtpk(o1[0], o1[1]); w.w = cvtpk(o1[2], o1[3]);
                    *(u32x4*)(MIX + (size_t)(row0 + ai * HALF + m * 16) * 1024 + col0 + bj * HALF) = w; } }
        asm volatile("s_waitcnt lgkmcnt(0)" ::: "memory"); __builtin_amdgcn_s_barrier(); asm volatile("" ::: "memory");
    }
};
}
#define XB_TMO      128
#define XB_XCNT(j)  (256  + 64 * (j))
#define XB_XSUB(j)  (1280 + 64 * (j))
#define XB_XGEN(j)  (2304 + 64 * (j))
#define XB_TOP      3328
#define XB_TOPGEN   3392
#define XCD_BAR_WORDS 3456
#define XB_SPIN_CAP (1u << 18)

__device__ __forceinline__ unsigned xb_ld(unsigned* p)              { return __hip_atomic_load(p, __ATOMIC_RELAXED, __HIP_MEMORY_SCOPE_AGENT); }
__device__ __forceinline__ unsigned xb_add(unsigned* p, unsigned v) { return __hip_atomic_fetch_add(p, v, __ATOMIC_RELAXED, __HIP_MEMORY_SCOPE_AGENT); }
__device__ __forceinline__ unsigned xb_xcc_id() { return (unsigned)__builtin_amdgcn_s_getreg((3 << 11) | 20) & 0xFu; }
#define XB_SPIN(cond, bar) do { unsigned _sp = 0; while (cond) { __builtin_amdgcn_s_sleep(1); \
    if ((++_sp & 255u) == 0u) { if (xb_ld(&(bar)[XB_TMO])) break; if (_sp > XB_SPIN_CAP) { atomicAdd(&(bar)[XB_TMO], 1u); break; } } } } while (0)

struct XcdBarrier {
    unsigned* bar; unsigned x;
    volatile LAS unsigned* st;
};

__device__ __forceinline__ XcdBarrier xcd_barrier_post(unsigned* bar, volatile LAS unsigned* st, const int tid) {
    XcdBarrier b; b.bar = bar; b.x = xb_xcc_id(); b.st = st;
    if (tid == 0) (void)xb_add(&bar[XB_XCNT(b.x)], 1u);
    return b;
}
__device__ __forceinline__ void xcd_barrier_complete(unsigned* bar, unsigned x, unsigned& nloc, unsigned& nx) {
    const unsigned G = gridDim.x * gridDim.y * gridDim.z;
    unsigned sum, cnt, mine, sp = 0u;
    for (;;) {
        sum = 0u; cnt = 0u; mine = 0u;
#pragma unroll
        for (unsigned j = 0; j < 16; ++j) { const unsigned c = xb_ld(&bar[XB_XCNT(j)]); sum += c; cnt += (c > 0u) ? 1u : 0u; mine = (j == x) ? c : mine; }
        if (sum == G) break;
        __builtin_amdgcn_s_sleep(1);
        if ((++sp & 255u) == 0u) { if (xb_ld(&bar[XB_TMO])) break; if (sp > XB_SPIN_CAP) { atomicAdd(&bar[XB_TMO], 1u); break; } }
    }
    nloc = mine > 0u ? mine : 1u; nx = cnt > 0u ? cnt : 1u;
}

__device__ __forceinline__ void xcd_barrier(const XcdBarrier& b, const int tid) {
    asm volatile("s_waitcnt vmcnt(0)" ::: "memory");
    __syncthreads();
    if (tid == 0) {
        unsigned* bar = b.bar;
        __builtin_amdgcn_s_waitcnt(0);
        unsigned nloc = b.st[0], nx = b.st[1];
        if (nloc == 0u) { xcd_barrier_complete(bar, b.x, nloc, nx); b.st[0] = nloc; b.st[1] = nx; }
        const unsigned old = xb_add(&bar[XB_XSUB(b.x)], 1u);
        const unsigned gen = old / nloc;
        if (old + 1u == (gen + 1u) * nloc) {
            __builtin_amdgcn_fence(__ATOMIC_RELEASE, "agent");
            asm volatile("s_waitcnt vmcnt(0)" ::: "memory");
            const unsigned og = xb_add(&bar[XB_TOP], 1u);
            const unsigned tg = og / nx;
            if (og + 1u == (tg + 1u) * nx) xb_add(&bar[XB_TOPGEN], 1u);
            else XB_SPIN(xb_ld(&bar[XB_TOPGEN]) == tg, bar);
            __builtin_amdgcn_fence(__ATOMIC_ACQUIRE, "agent");
            xb_add(&bar[XB_XGEN(b.x)], 1u);
            asm volatile("s_waitcnt vmcnt(0)" ::: "memory");
        } else {
            XB_SPIN(xb_ld(&bar[XB_XGEN(b.x)]) == gen, bar);
            __builtin_amdgcn_fence(__ATOMIC_ACQUIRE, "agent");
            asm volatile("s_waitcnt vmcnt(0)" ::: "memory");
        }
    }
    __syncthreads();
}
__device__ __forceinline__ void tr_item(const float* W, int K, int N, bf16_t* WT, int k0, int n0, int drow0, LAS float* scr, int lane) {
    const int n = n0 + (lane & 31);
#pragma unroll 8
    for (int i = 0; i < 32; ++i) { const int kk = 2 * i + (lane >> 5); scr[kk * 33 + (lane & 31)] = (n < N) ? W[(size_t)(k0 + kk) * N + n] : 0.f; }
    LDS_WAIT(); __builtin_amdgcn_wave_barrier();
    const int c = lane & 7;
#pragma unroll
    for (int j = 0; j < 4; ++j) { const int nn = (lane >> 3) + 8 * j; const LAS float* s = scr + (8 * c) * 33 + nn;
        u32x4 o; o.x = cvtpk(s[0 * 33], s[1 * 33]); o.y = cvtpk(s[2 * 33], s[3 * 33]); o.z = cvtpk(s[4 * 33], s[5 * 33]); o.w = cvtpk(s[6 * 33], s[7 * 33]);
        *(u32x4*)(WT + (size_t)(drow0 + nn) * K + k0 + 8 * c) = o; }
    LDS_WAIT(); __builtin_amdgcn_wave_barrier();
}
__device__ __forceinline__ void sincos_rr(float x, float& s, float& c) {
    const float q = rintf(x * 0.6366197723675814f);
    float r = fmaf(-q, 1.57079637050628662109375f, x); r = fmaf(-q, -4.37113900018624283e-8f, r);
    const float r2 = r * r;
    const float sp = r + r * r2 * (-1.6666654611e-1f + r2 * (8.3321608736e-3f + r2 * (-1.9515295891e-4f)));
    const float cp = 1.0f - 0.5f * r2 + r2 * r2 * (4.166664568298827e-2f + r2 * (-1.388731625493765e-3f + r2 * 2.443315711809948e-5f));
    const int n = ((int)q) & 3;
    s = (n == 0) ? sp : (n == 1) ? cp : (n == 2) ? -sp : -cp;
    c = (n == 0) ? cp : (n == 1) ? -sp : (n == 2) ? -cp : sp;
}
struct RowIn { f32x4 x[4]; u32x2 xb[4]; u32x2 y[4]; float rinv; };
template <bool HAS_Y, int XIN> __device__ __forceinline__ void row_load(RowIn& r, const void* xin, const float* rn, size_t m, const bf16_t* y, int lane) {
#pragma unroll
    for (int j = 0; j < 4; ++j) {
        if (XIN != 0) r.xb[j] = *(const GAS u32x2*)((const GAS bf16_t*)xin + m * 1024 + 4 * lane + 256 * j); else r.x[j] = *(const GAS f32x4*)((const GAS float*)xin + m * 1024 + 4 * lane + 256 * j);
        if (HAS_Y) r.y[j] = *(const GAS u32x2*)((const GAS bf16_t*)y + m * 1024 + 4 * lane + 256 * j); }
    if (XIN == 2) r.rinv = ((const GAS float*)rn)[m];
}
template <bool HAS_Y, int XIN, int XOUT> __device__ __forceinline__ void row_compute(const RowIn& r, const f32x4 (&gi)[4], const f32x4 (&gp)[4], void* xout, float* rn, size_t m, const f32x4 (&gq)[4], bf16_t* xn, int lane) {
    f32x4 xv[4];
#pragma unroll
    for (int j = 0; j < 4; ++j) { if (XIN != 0) { const u32x2 w = r.xb[j]; xv[j] = (f32x4){bflo(w.x), bfhi(w.x), bflo(w.y), bfhi(w.y)}; if (XIN == 2) xv[j] = xv[j] * r.rinv * gi[j]; } else xv[j] = r.x[j]; }
    if (HAS_Y) {
        f32x4 yv[4]; float ss = 0.f;
#pragma unroll
        for (int j = 0; j < 4; ++j) { const u32x2 w = r.y[j]; yv[j] = (f32x4){bflo(w.x), bfhi(w.x), bflo(w.y), bfhi(w.y)};
            ss += (yv[j][0] * yv[j][0] + yv[j][1] * yv[j][1]) + (yv[j][2] * yv[j][2] + yv[j][3] * yv[j][3]); }
        const float ry = 1.0f / sqrtf(wave_sum(ss) * (1.0f / 1024.0f) + EPS);
#pragma unroll
        for (int j = 0; j < 4; ++j) { xv[j] = xv[j] + yv[j] * ry * gp[j];
            if (XOUT == 1) { u32x2 w; w.x = cvtpk(xv[j][0], xv[j][1]); w.y = cvtpk(xv[j][2], xv[j][3]); *(GAS u32x2*)((GAS bf16_t*)xout + m * 1024 + 4 * lane + 256 * j) = w; }
            if (XOUT == 0) *(GAS f32x4*)((GAS float*)xout + m * 1024 + 4 * lane + 256 * j) = xv[j]; }
    }
    if (xn) {
        float ss = 0.f;
#pragma unroll
        for (int j = 0; j < 4; ++j) ss += (xv[j][0] * xv[j][0] + xv[j][1] * xv[j][1]) + (xv[j][2] * xv[j][2] + xv[j][3] * xv[j][3]);
        const float ms = wave_sum(ss) * (1.0f / 1024.0f) + EPS, rx = 1.0f / sqrtf(ms);
        if (XOUT == 2 && lane == 0) ((GAS float*)rn)[m] = sqrtf(ms);
#pragma unroll
        for (int j = 0; j < 4; ++j) { const f32x4 o = xv[j] * rx * gq[j];
            u32x2 w; w.x = cvtpk(o[0], o[1]); w.y = cvtpk(o[2], o[3]); *(GAS u32x2*)((GAS bf16_t*)xn + m * 1024 + 4 * lane + 256 * j) = w; }
    }
}
template <bool HAS_Y, int XIN, int XOUT> __device__ __forceinline__ void row_phase(const void* xin, const float* gin, float* rn, const bf16_t* y, const float* gpost, void* xout, const float* gpre, bf16_t* xn, int gw, int NGW, int lane) {
    f32x4 gp[4], gq[4], gi[4];
#pragma unroll
    for (int j = 0; j < 4; ++j) { gp[j] = HAS_Y ? *(const GAS f32x4*)((const GAS float*)gpost + 4 * lane + 256 * j) : (f32x4){0.f, 0.f, 0.f, 0.f}; gq[j] = xn ? *(const GAS f32x4*)((const GAS float*)gpre + 4 * lane + 256 * j) : (f32x4){0.f, 0.f, 0.f, 0.f};
        if (XIN == 2) { const f32x4 g = *(const GAS f32x4*)((const GAS float*)gin + 4 * lane + 256 * j); gi[j] = (f32x4){1.0f / g[0], 1.0f / g[1], 1.0f / g[2], 1.0f / g[3]}; } else gi[j] = (f32x4){1.f, 1.f, 1.f, 1.f}; }
    RowIn cur, nxt, nx2;
    int m = gw;
    if (m < M) row_load<HAS_Y, XIN>(cur, xin, rn, (size_t)m, y, lane);
    if (m + NGW < M) row_load<HAS_Y, XIN>(nxt, xin, rn, (size_t)(m + NGW), y, lane);
    for (; m < M; m += NGW) {
        const int m2 = m + 2 * NGW;
        if (m2 < M) row_load<HAS_Y, XIN>(nx2, xin, rn, (size_t)m2, y, lane);
        row_compute<HAS_Y, XIN, XOUT>(cur, gi, gp, xout, rn, (size_t)m, gq, xn, lane);
        cur = nxt; nxt = nx2;
    }
}

constexpr int XP = 132, HP = 136, SSM_WAVE_LDS = 16 * XP * 4 + 16 * HP * 2;
__device__ __forceinline__ void ssm_wave(const bf16_t* PROJ_, const float* ABAR, const bf16_t* BB, const bf16_t* CC, const float* dsk, bf16_t* G_, LAS unsigned char* wl, int b, int g, int lane) {
    LAS float* XT = (LAS float*)wl; LAS bf16_t* HT = (LAS bf16_t*)(wl + 16 * XP * 4);
    const GAS bf16_t* PROJg = (const GAS bf16_t*)PROJ_; GAS bf16_t* Gg = (GAS bf16_t*)G_;
#define PROJ PROJg
#define G Gg
    const int c16 = lane & 15, q4 = lane >> 4;
    const float ar = ABAR[(g * 64 + lane) * 2], ai = ABAR[(g * 64 + lane) * 2 + 1];
    bf16x8 bfr[8], cfr[4]; const bf16x8 zero8 = {0, 0, 0, 0, 0, 0, 0, 0};
#pragma unroll
    for (int j = 0; j < 8; ++j) bfr[j] = (q4 < 2) ? *(const bf16x8*)(BB + ((size_t)g * 128 + 16 * j + c16) * 16 + 8 * q4) : zero8;
#pragma unroll
    for (int ks = 0; ks < 4; ++ks) cfr[ks] = *(const bf16x8*)(CC + ((size_t)g * 16 + c16) * 128 + 32 * ks + 8 * q4);
    const float dk = dsk[g * 16 + c16];
    float hr = 0.f, hi = 0.f;
    const size_t m0 = (size_t)b * SEQ;
    const GAS bf16_t* up = PROJ + (m0 + c16) * LDP + g * 16 + 8 * (q4 & 1);
    bf16x8 anext = *(const GAS bf16x8*)up;
    const GAS bf16_t* usk = PROJ + (m0 + 4 * q4) * LDP + g * 16 + c16;
    unsigned short un0 = usk[0], un1 = usk[LDP], un2 = usk[2 * LDP], un3 = usk[3 * LDP];
    for (int tile = 0; tile < SEQ / 16; ++tile) {
        const bf16x8 acur = (q4 < 2) ? anext : zero8;
        if (tile + 1 < SEQ / 16) anext = *(const GAS bf16x8*)(up + (size_t)(tile + 1) * 16 * LDP);
        const float uc[4] = {bf2f(un0), bf2f(un1), bf2f(un2), bf2f(un3)};
        if (tile + 1 < SEQ / 16) { const GAS bf16_t* q = usk + (size_t)(tile + 1) * 16 * LDP; un0 = q[0]; un1 = q[LDP]; un2 = q[2 * LDP]; un3 = q[3 * LDP]; }
f32x4 xa[8];
#pragma unroll
        for (int j = 0; j < 8; ++j) xa[j] = __builtin_amdgcn_mfma_f32_16x16x32_bf16(acur, bfr[j], (f32x4){0.f, 0.f, 0.f, 0.f}, 0, 0, 0);
        asm volatile("s_nop 15\n\ts_nop 15" : "+v"(xa[0]), "+v"(xa[1]), "+v"(xa[2]), "+v"(xa[3]), "+v"(xa[4]), "+v"(xa[5]), "+v"(xa[6]), "+v"(xa[7]));
#pragma unroll
        for (int j = 0; j < 8; ++j)
#pragma unroll
            for (int i = 0; i < 4; ++i) XT[(4 * q4 + i) * XP + 16 * j + c16] = xa[j][i];
        LDS_WAIT(); __builtin_amdgcn_wave_barrier();
#pragma unroll
        for (int t = 0; t < 16; ++t) { const float xr = XT[t * XP + lane], xi = XT[t * XP + 64 + lane];
            const float nr = fmaf(ar, hr, fmaf(-ai, hi, xr)), ni = fmaf(ar, hi, fmaf(ai, hr, xi)); hr = nr; hi = ni;
            *(LAS unsigned*)(HT + t * HP + 2 * lane) = cvtpk(hr, hi); }
        LDS_WAIT(); __builtin_amdgcn_wave_barrier();
        f32x4 ya = {0.f, 0.f, 0.f, 0.f};
#pragma unroll
        for (int ks = 0; ks < 4; ++ks) { const bf16x8 a = *(const LAS bf16x8*)(HT + c16 * HP + 32 * ks + 8 * q4); ya = __builtin_amdgcn_mfma_f32_16x16x32_bf16(a, cfr[ks], ya, 0, 0, 0); }
        asm volatile("s_nop 15\n\ts_nop 15" : "+v"(ya));
#pragma unroll
        for (int i = 0; i < 4; ++i) { const size_t mrow = m0 + tile * 16 + 4 * q4 + i; const float u = uc[i];
            const float yv = ya[i] + dk * u; G[mrow * 256 + g * 16 + c16] = (bf16_t)(cvtpk(gelu_tanh(yv), 0.f) & 0xffffu); }
        LDS_WAIT(); __builtin_amdgcn_wave_barrier();
    }
}

#undef PROJ
#undef G
constexpr int KP = 72;
struct AttnSt { f32x16 o0, o1; float m, l; };
__device__ __forceinline__ bf16x8 pack8(const f32x16& p, int s) { u32x4 w; w.x = cvtpk(p[8 * s + 0], p[8 * s + 1]); w.y = cvtpk(p[8 * s + 2], p[8 * s + 3]); w.z = cvtpk(p[8 * s + 4], p[8 * s + 5]); w.w = cvtpk(p[8 * s + 6], p[8 * s + 7]); return __builtin_bit_cast(bf16x8, w); }
typedef float f32x2_ __attribute__((ext_vector_type(2)));
template <bool BIAS>
__device__ __forceinline__ void attn_tile(AttnSt& st, const bf16x8 (&qf)[4], const LAS bf16_t* Ks, const LAS bf16_t* Vt, int r32, int hi,
                                          float cq, const LAS float* ck, int klo, int khi, int kbase, bool need_mask) {
    f32x16 p0, p1;
#pragma unroll
    for (int r = 0; r < 16; ++r) { p0[r] = 0.f; p1[r] = 0.f; }
#pragma unroll
    for (int ds = 0; ds < 4; ++ds) { const bf16x8 a0 = *(const LAS bf16x8*)(Ks + r32 * KP + ds * 16 + hi * 8), a1 = *(const LAS bf16x8*)(Ks + (32 + r32) * KP + ds * 16 + hi * 8);
        p0 = __builtin_amdgcn_mfma_f32_32x32x16_bf16(a0, qf[ds], p0, 0, 0, 0); p1 = __builtin_amdgcn_mfma_f32_32x32x16_bf16(a1, qf[ds], p1, 0, 0, 0); }
    if (BIAS) {
#pragma unroll
        for (int g = 0; g < 4; ++g) {
            const f32x4 c0 = *(const LAS f32x4*)(ck + 8 * g + 4 * hi), c1 = *(const LAS f32x4*)(ck + 32 + 8 * g + 4 * hi);
#pragma unroll
            for (int i = 0; i < 4; i += 2) { const int r = 4 * g + i;
                const f32x2_ a2 = (f32x2_){p0[r], p0[r + 1]} * QK_C + (f32x2_){c0[i], c0[i + 1]}, b2 = (f32x2_){p1[r], p1[r + 1]} * QK_C + (f32x2_){c1[i], c1[i + 1]};
                p0[r] = a2.x; p0[r + 1] = a2.y; p1[r] = b2.x; p1[r + 1] = b2.y; }
        }
    }
    if (need_mask) {
        const unsigned nml = (unsigned)(kbase + 4 * hi - klo), range = (unsigned)(khi - klo);
#pragma unroll
        for (int r = 0; r < 16; ++r) { const unsigned c = (unsigned)((r & 3) + 8 * (r >> 2));
            if (nml + c > range) p0[r] = -INFINITY;
            if (nml + (c + 32u) > range) p1[r] = -INFINITY; }
    }
#define MX3(a, b, c) __builtin_fmaxf(__builtin_fmaxf((a), (b)), (c))
    float rm;
    { float ma = MX3(p0[0], p0[1], p1[0]), mb = MX3(p0[2], p0[3], p1[1]); ma = MX3(ma, p1[2], p1[3]);
#pragma unroll
      for (int r = 4; r < 16; r += 4) { ma = MX3(ma, p0[r], p0[r + 1]); mb = MX3(mb, p0[r + 2], p0[r + 3]); ma = MX3(ma, p1[r], p1[r + 1]); mb = MX3(mb, p1[r + 2], p1[r + 3]); }
      rm = __builtin_fmaxf(ma, mb); }
#undef MX3
    rm = fmaxf(rm, __shfl_xor(rm, 32));
    const float mnew = fmaxf(st.m, rm);
    const float SC = BIAS ? 1.0f : QK_C;
    const float alpha = __builtin_amdgcn_exp2f((st.m - mnew) * SC), nm = -mnew * SC;
    st.m = mnew;
    f32x2_ sum2 = {0.f, 0.f};
#pragma unroll
    for (int r = 0; r < 16; r += 2) {
        const f32x2_ a2 = BIAS ? (f32x2_){p0[r], p0[r + 1]} + nm : (f32x2_){p0[r], p0[r + 1]} * QK_C + nm, b2 = BIAS ? (f32x2_){p1[r], p1[r + 1]} + nm : (f32x2_){p1[r], p1[r + 1]} * QK_C + nm;
        p0[r] = __builtin_amdgcn_exp2f(a2.x); p0[r + 1] = __builtin_amdgcn_exp2f(a2.y); p1[r] = __builtin_amdgcn_exp2f(b2.x); p1[r + 1] = __builtin_amdgcn_exp2f(b2.y);
        sum2 += (f32x2_){p0[r], p0[r + 1]} + (f32x2_){p1[r], p1[r + 1]}; }
    st.l = st.l * alpha + (sum2.x + sum2.y);
#pragma unroll
    for (int r = 0; r < 16; ++r) { st.o0[r] *= alpha; st.o1[r] *= alpha; }
    const int sw0 = ((r32 >> 3) & 7) << 3, sw1 = (((32 + r32) >> 3) & 7) << 3;
#pragma unroll
    for (int T = 0; T < 2; ++T)
#pragma unroll
        for (int s = 0; s < 2; ++s) { const bf16x8 pf = pack8(T == 0 ? p0 : p1, s); const int kvb = 32 * T + 16 * s + 4 * hi;
            { const u32x2 lo = *(const LAS u32x2*)(Vt + r32 * KP + (kvb ^ sw0)), hh = *(const LAS u32x2*)(Vt + r32 * KP + ((kvb + 8) ^ sw0));
              const u32x4 v = {lo.x, lo.y, hh.x, hh.y}; st.o0 = __builtin_amdgcn_mfma_f32_32x32x16_bf16(__builtin_bit_cast(bf16x8, v), pf, st.o0, 0, 0, 0); }
            { const u32x2 lo = *(const LAS u32x2*)(Vt + (32 + r32) * KP + (kvb ^ sw1)), hh = *(const LAS u32x2*)(Vt + (32 + r32) * KP + ((kvb + 8) ^ sw1));
              const u32x4 v = {lo.x, lo.y, hh.x, hh.y}; st.o1 = __builtin_amdgcn_mfma_f32_32x32x16_bf16(__builtin_bit_cast(bf16x8, v), pf, st.o1, 0, 0, 0); }
        }
}
__device__ __forceinline__ void attn_init(AttnSt& st) {
#pragma unroll
    for (int r = 0; r < 16; ++r) { st.o0[r] = 0.f; st.o1[r] = 0.f; }
    st.m = -1e30f; st.l = 0.f;
}
__device__ __forceinline__ void attn_store(const AttnSt& st, float inv, bf16_t* orow, int hi) {
#pragma unroll
    for (int g = 0; g < 4; ++g) {
        u32x2 w0, w1; w0.x = cvtpk(st.o0[4 * g] * inv, st.o0[4 * g + 1] * inv); w0.y = cvtpk(st.o0[4 * g + 2] * inv, st.o0[4 * g + 3] * inv);
        w1.x = cvtpk(st.o1[4 * g] * inv, st.o1[4 * g + 1] * inv); w1.y = cvtpk(st.o1[4 * g + 2] * inv, st.o1[4 * g + 3] * inv);
        *(u32x2*)(orow + 8 * g + 4 * hi) = w0; *(u32x2*)(orow + 32 + 8 * g + 4 * hi) = w1; }
}
__device__ __forceinline__ void stage_k(LAS bf16_t* Ks, int lrow, int lch, const u32x4& kreg) { *(LAS u32x4*)(Ks + lrow * KP + lch * 8) = kreg; }
__device__ __forceinline__ void stage_v2(LAS bf16_t* Vt, int rp, int c4, const u32x2& va, const u32x2& vb) {
    const int sw = ((c4 >> 1) & 7) << 3;
#pragma unroll
    for (int j = 0; j < 4; ++j) { const unsigned a = va[j >> 1], c = vb[j >> 1];
        const unsigned w = (j & 1) ? ((a >> 16) | (c & 0xffff0000u)) : ((a & 0xffffu) | (c << 16));
        *(LAS unsigned*)(Vt + (4 * c4 + j) * KP + ((2 * rp) ^ sw)) = w; }
}

__device__ __forceinline__ void fox_unit(const bf16_t* PROJ_, const float* FL_, bf16_t* FOXO_, LAS unsigned char* lds, int b, int h, int qb, int tid, int lane, int wave) {
    const GAS bf16_t* PROJ = (const GAS bf16_t*)PROJ_; const GAS float* FL = (const GAS float*)FL_; GAS bf16_t* FOXO = (GAS bf16_t*)FOXO_;
    LAS bf16_t* Ks = (LAS bf16_t*)lds; LAS bf16_t* Vt = (LAS bf16_t*)(lds + 9216); LAS float* cum = (LAS float*)(lds + 36864); LAS float* wtot = (LAS float*)(lds + 36864 + 8192);
    const int r32 = lane & 31, hi = lane >> 5;
    const int q1 = (qb + 1) * 256;
    __syncthreads();
    {
        float v[4]; const int s0 = 4 * tid;
#pragma unroll
        for (int i = 0; i < 4; ++i) v[i] = (s0 + i < q1) ? FL[((size_t)b * SEQ + s0 + i) * 8 + h] * LOG2E : 0.f;
        v[1] += v[0]; v[2] += v[1]; v[3] += v[2];
        const float tot = v[3]; float inc = tot;
#pragma unroll
        for (int off = 1; off < 64; off <<= 1) { const float t = __shfl_up(inc, off); if (lane >= off) inc += t; }
        if (lane == 63) wtot[wave] = inc;
        __syncthreads();
        float base = 0.f;
        for (int w = 0; w < wave; ++w) base += wtot[w];
        const float ex = base + inc - tot;
#pragma unroll
        for (int i = 0; i < 4; ++i) cum[s0 + i] = -(ex + v[i]);
    }
    __syncthreads();
    const int qrow0 = qb * 256 + wave * 32, qpos = qrow0 + r32;
    bf16x8 qf[4];
    { const GAS bf16_t* qp = PROJ + ((size_t)b * SEQ + qpos) * LDP + COL_FQ + h * 64 + hi * 8;
#pragma unroll
      for (int ds = 0; ds < 4; ++ds) qf[ds] = *(const GAS bf16x8*)(qp + ds * 16); }
    const float cq = 0.f;
    AttnSt st; attn_init(st);
    const int NT = q1 / 64, lrow = tid >> 3, lch = tid & 7, rp = tid >> 4, c4 = tid & 15;
    const GAS bf16_t* kg = PROJ + ((size_t)b * SEQ + lrow) * LDP + COL_FK + h * 64 + lch * 8;
    const GAS bf16_t* vg = PROJ + ((size_t)b * SEQ + 2 * rp) * LDP + COL_FV + h * 64 + c4 * 4;
    u32x4 kreg = *(const GAS u32x4*)kg; u32x2 va = *(const GAS u32x2*)vg, vb = *(const GAS u32x2*)(vg + LDP);
    stage_k(Ks, lrow, lch, kreg); stage_v2(Vt, rp, c4, va, vb);
    if (NT > 1) { kreg = *(const GAS u32x4*)(kg + (size_t)64 * LDP); va = *(const GAS u32x2*)(vg + (size_t)64 * LDP); vb = *(const GAS u32x2*)(vg + (size_t)65 * LDP); }
    __syncthreads();
    for (int kt = 0; kt < NT; ++kt) {
        LAS bf16_t* Kc = Ks + (kt & 1) * 9216; LAS bf16_t* Vc = Vt + (kt & 1) * 9216; LAS bf16_t* Kn = Ks + ((kt + 1) & 1) * 9216; LAS bf16_t* Vn = Vt + ((kt + 1) & 1) * 9216;
        if (kt + 1 < NT) { stage_k(Kn, lrow, lch, kreg); stage_v2(Vn, rp, c4, va, vb); }
        if (kt + 2 < NT) { kreg = *(const GAS u32x4*)(kg + (size_t)(kt + 2) * 64 * LDP); va = *(const GAS u32x2*)(vg + (size_t)(kt + 2) * 64 * LDP); vb = *(const GAS u32x2*)(vg + ((size_t)(kt + 2) * 64 + 1) * LDP); }
        if (kt * 64 <= qrow0 + 31) attn_tile<true>(st, qf, Kc, Vc, r32, hi, cq, cum + kt * 64, 0, qpos, kt * 64, kt * 64 + 63 > qrow0);
        __syncthreads();
    }
    const float l = st.l + __shfl_xor(st.l, 32);
    attn_store(st, 1.0f / l, (bf16_t*)(FOXO + ((size_t)b * SEQ + qpos) * 384 + h * 64), hi);
}

__device__ __forceinline__ void dsa_unit(const bf16_t* PROJ_, bf16_t* DSAO_, float* LSE_, LAS unsigned char* lds, int b, int hp, int pat, int res, int n, int tid, int lane, int wave) {
    const int job = wave >> 2, jw = wave & 3, h = 2 * hp + job, jt = tid & 255, r32 = lane & 31, hi = lane >> 5;
    const int d = (pat == 0) ? 1 : (pat == 1 ? 4 : 16);
    const GAS bf16_t* PROJ = (const GAS bf16_t*)PROJ_; GAS bf16_t* DSAO = (GAS bf16_t*)DSAO_; GAS float* LSE = (GAS float*)LSE_;
    LAS bf16_t* Ks = (LAS bf16_t*)(lds + job * 36864); LAS bf16_t* Vt = (LAS bf16_t*)(lds + job * 36864 + 9216);
    __syncthreads();
    const int qi = jw * 32 + r32;
    const size_t trow = (size_t)b * SEQ + (size_t)(n * 128 + qi) * d + res;
    bf16x8 qf[4];
    { const GAS bf16_t* qp = PROJ + trow * LDP + COL_DQ + h * 64 + hi * 8;
#pragma unroll
      for (int ds = 0; ds < 4; ++ds) qf[ds] = *(const GAS bf16x8*)(qp + ds * 16); }
    AttnSt st; attn_init(st);
    const int kt0 = (n == 0) ? 2 : 0, lch = jt & 7, lrow = jt >> 3, rp = jt >> 4, c4 = jt & 15;
    const GAS bf16_t* kbase = PROJ + ((size_t)b * SEQ + res) * LDP + COL_DK + h * 64 + lch * 8;
    const GAS bf16_t* vbase = PROJ + ((size_t)b * SEQ + res) * LDP + COL_DV + h * 64 + c4 * 4;
    const long rstep = (long)d * LDP;
    const long mk0 = (long)(n - 1) * 128 + lrow, mv0 = (long)(n - 1) * 128 + 2 * rp;
    u32x4 kreg0, kreg1; u32x2 va0, vb0, va1, vb1;
#define DSA_LOAD(kt_) do { const long o0 = (mk0 + 64 * (kt_)) * rstep, o1 = o0 + 32 * rstep, p0 = (mv0 + 64 * (kt_)) * rstep, p1 = p0 + 32 * rstep; \
        kreg0 = *(const GAS u32x4*)(kbase + o0); kreg1 = *(const GAS u32x4*)(kbase + o1); \
        va0 = *(const GAS u32x2*)(vbase + p0); vb0 = *(const GAS u32x2*)(vbase + p0 + rstep); va1 = *(const GAS u32x2*)(vbase + p1); vb1 = *(const GAS u32x2*)(vbase + p1 + rstep); } while (0)
#define DSA_STAGE(K_, V_) do { stage_k(K_, lrow, lch, kreg0); stage_k(K_, lrow + 32, lch, kreg1); stage_v2(V_, rp, c4, va0, vb0); stage_v2(V_, rp + 16, c4, va1, vb1); } while (0)
    DSA_LOAD(kt0);
    DSA_STAGE(Ks + (kt0 & 1) * 9216, Vt + (kt0 & 1) * 9216);
    DSA_LOAD(kt0 + 1);
    __syncthreads();
    const int q0 = jw * 32;
    for (int kt = kt0; kt < 4; ++kt) {
        LAS bf16_t* Kc = Ks + (kt & 1) * 9216; LAS bf16_t* Vc = Vt + (kt & 1) * 9216;
        if (kt + 1 < 4) DSA_STAGE(Ks + ((kt + 1) & 1) * 9216, Vt + ((kt + 1) & 1) * 9216);
        if (kt + 2 < 4) DSA_LOAD(kt + 2);
        const int k0 = 64 * kt;
        if (k0 + 63 >= q0 && k0 <= q0 + 31 + 128) {
            const bool allv = (k0 >= q0 + 31) && (k0 + 63 <= q0 + 128);
            attn_tile<false>(st, qf, Kc, Vc, r32, hi, 0.f, (const LAS float*)lds, qi, qi + 128, k0, !allv);
        }
        __syncthreads();
    }
#undef DSA_LOAD
#undef DSA_STAGE
    const float l = st.l + __shfl_xor(st.l, 32);
    attn_store(st, 1.0f / l, (bf16_t*)(DSAO + ((size_t)pat * M + trow) * 384 + h * 64), hi);
    if (hi == 0) LSE[((size_t)pat * M + trow) * 8 + h] = st.m * QK_C + __log2f(l);
}

__device__ __forceinline__ void merge_row(const bf16_t* SSMO, const bf16_t* DSAO, const float* LSE, const bf16_t* FOXO, const float* gm, bf16_t* OUT, size_t m, int lane) {
    float v[16];
    if (lane < 16) {
#pragma unroll
        for (int i = 0; i < 16; ++i) v[i] = 0.f;
    } else if (lane < 40) {
        const int c0 = 16 * lane - 256, h = c0 >> 6;
        const GAS float* LSEg = (const GAS float*)LSE; const float l0 = LSEg[(0 * (size_t)M + m) * 8 + h], l1 = LSEg[(1 * (size_t)M + m) * 8 + h], l2 = LSEg[(2 * (size_t)M + m) * 8 + h];
        const float mx = fmaxf(l0, fmaxf(l1, l2));
        float w0 = __builtin_amdgcn_exp2f(l0 - mx), w1 = __builtin_amdgcn_exp2f(l1 - mx), w2 = __builtin_amdgcn_exp2f(l2 - mx);
        const float inv = 1.0f / (w0 + w1 + w2); w0 *= inv; w1 *= inv; w2 *= inv;
#pragma unroll
        for (int i = 0; i < 16; ++i) v[i] = 0.f;
#pragma unroll
        for (int p = 0; p < 3; ++p) { const float w = (p == 0) ? w0 : (p == 1 ? w1 : w2); const GAS bf16_t* src = (const GAS bf16_t*)DSAO + ((size_t)p * M + m) * 384 + c0;
            const u32x4 a = *(const GAS u32x4*)src, c = *(const GAS u32x4*)(src + 8);
#pragma unroll
            for (int i = 0; i < 4; ++i) { v[2 * i] += w * bflo(a[i]); v[2 * i + 1] += w * bfhi(a[i]); v[8 + 2 * i] += w * bflo(c[i]); v[8 + 2 * i + 1] += w * bfhi(c[i]); } }
    } else {
        const int c0 = 16 * lane - 640;
        const u32x4 a = *(const GAS u32x4*)((const GAS bf16_t*)FOXO + m * 384 + c0), c = *(const GAS u32x4*)((const GAS bf16_t*)FOXO + m * 384 + c0 + 8);
#pragma unroll
        for (int i = 0; i < 4; ++i) { v[2 * i] = bflo(a[i]); v[2 * i + 1] = bfhi(a[i]); v[8 + 2 * i] = bflo(c[i]); v[8 + 2 * i + 1] = bfhi(c[i]); }
    }
    float ss = 0.f;
#pragma unroll
    for (int i = 0; i < 16; ++i) ss += v[i] * v[i];
    const int seg = (lane < 16) ? 0 : (lane < 40 ? 1 : 2);
    const float s0 = wave_sum(seg == 0 ? ss : 0.f), s1 = wave_sum(seg == 1 ? ss : 0.f), s2 = wave_sum(seg == 2 ? ss : 0.f);
    const float rs = (seg == 0) ? 1.0f / sqrtf(s0 * (1.0f / 256.0f) + EPS) : (seg == 1) ? 1.0f / sqrtf(s1 * (1.0f / 384.0f) + EPS) : 1.0f / sqrtf(s2 * (1.0f / 384.0f) + EPS);
    u32x4 o0, o1;
#pragma unroll
    for (int i = 0; i < 4; ++i) { const f32x4 g = *(const GAS f32x4*)((const GAS float*)gm + 16 * lane + 4 * i);
        const unsigned lo = cvtpk(v[4 * i] * rs * g[0], v[4 * i + 1] * rs * g[1]), hh = cvtpk(v[4 * i + 2] * rs * g[2], v[4 * i + 3] * rs * g[3]);
        if (i < 2) { o0[2 * i] = lo; o0[2 * i + 1] = hh; } else { o1[2 * (i - 2)] = lo; o1[2 * (i - 2) + 1] = hh; } }
    if (lane >= 16) { *(GAS u32x4*)((GAS bf16_t*)OUT + m * 1024 + 16 * lane) = o0; *(GAS u32x4*)((GAS bf16_t*)OUT + m * 1024 + 16 * lane + 8) = o1; }
}
template <int PH> __device__ __forceinline__ void run_phase(const Params& P, const int l, LAS unsigned char* lds, const int wave0, const int umax = 1 << 30) {
    constexpr size_t WS_PRM = 58 * MiB; constexpr int PRM_L = 8192, PR_GPOST = 0, PR_GPREF = 1024, PR_GPOSTF = 2048, PR_GMIX = 3072, PR_GPRE = 4096, PR_BGLU = 5120, PR_SD = 5376, PR_BF = 5632;
#define WSBASE() unsigned char* ws = P.ws; asm volatile("" : "+s"(ws)); float* const Pout = P.out; const float* const Px = P.in[I_X]; (void)Pout; (void)Px; int wave_s = wave0; asm volatile("" : "+s"(wave_s)); int lane_v; asm volatile("v_mbcnt_lo_u32_b32 %0, -1, 0\n\tv_mbcnt_hi_u32_b32 %0, -1, %0" : "=v"(lane_v)); const int tid = wave_s * 64 + lane_v; int bid = blockIdx.x; asm volatile("" : "+s"(bid)); int G = gridDim.x; asm volatile("" : "+s"(G)); const int lane = lane_v, wave = wave_s, gw = bid * 8 + wave, NGW = G * 8; (void)lane; (void)gw; (void)NGW
    if constexpr (PH == 0) {
    {
        WSBASE();
        bf16_t* WinT = (bf16_t*)(ws + WS_WIN); bf16_t* WoutT = (bf16_t*)(ws + WS_WOUT); bf16_t* WguT = (bf16_t*)(ws + WS_WGU); bf16_t* WdnT = (bf16_t*)(ws + WS_WDN); bf16_t* WgluT = (bf16_t*)(ws + WS_WGLU);
        float* ABAR = (float*)(ws + WS_ABAR); bf16_t* BB = (bf16_t*)(ws + WS_BB); bf16_t* CC = (bf16_t*)(ws + WS_CC); float* PRM = (float*)(ws + WS_PRM);
        LAS float* scr = (LAS float*)(lds + wave * 16384);
        constexpr int I_IN = 16 * 88, I_OUT = 16 * 32, I_GU = 16 * 176, I_DN = 44 * 32, I_GL = 4 * 8, I_ALL = I_IN + I_OUT + I_GU + I_DN + I_GL;
        for (int it = gw; it < 2 * I_ALL; it += NGW) {
            const int l = it / I_ALL; int r = it % I_ALL;
            if (r < I_IN) { const int kb = r / 88, nb = r % 88; tr_item(P.in[I_WIN] + (size_t)l * 1024 * NIN, 1024, NIN, WinT + (size_t)l * NINP * 1024, 64 * kb, 32 * nb, 32 * nb, scr, lane); continue; } r -= I_IN;
            if (r < I_OUT) { const int kb = r / 32, nb = r % 32; tr_item(P.in[I_WOUT] + (size_t)l * 1024 * 1024, 1024, 1024, WoutT + (size_t)l * 1024 * 1024, 64 * kb, 32 * nb, 32 * nb, scr, lane); continue; } r -= I_OUT;
            if (r < I_GU) { const int kb = r / 176, nb = r % 176, c0 = 32 * nb, half = (c0 >= DFF) ? 1 : 0, cc = c0 - half * DFF, dr = 256 * (cc / 128) + 128 * half + (cc % 128);
                tr_item(P.in[I_WGU] + (size_t)l * 1024 * NGU, 1024, NGU, WguT + (size_t)l * NGU * 1024, 64 * kb, c0, dr, scr, lane); continue; } r -= I_GU;
            if (r < I_DN) { const int kb = r / 32, nb = r % 32; tr_item(P.in[I_WDN] + (size_t)l * DFF * 1024, DFF, 1024, WdnT + (size_t)l * 1024 * DFF, 64 * kb, 32 * nb, 32 * nb, scr, lane); continue; } r -= I_DN;
            { const int kb = r / 8, nb = r % 8; tr_item(P.in[I_WGLU] + (size_t)l * 256 * 256, 256, 256, WgluT + (size_t)l * 256 * 256, 64 * kb, 32 * nb, 32 * nb, scr, lane); }
        }
        for (int e = bid * 512 + tid; e < 2 * 16 * 64; e += G * 512) {
            const int lg = e >> 6, p = e & 63;
            const float dt = expf(P.in[I_LDT][lg]), ar = P.in[I_ARE][e], ai = P.in[I_AIM][e];
            const float decay = expf(ar * dt); float sn, cs; sincos_rr(ai * dt, sn, cs);
            const float are = decay * cs, aim = decay * sn, mag2 = ar * ar + ai * ai;
            const float cre = ((are - 1.0f) * ar + aim * ai) / mag2, cim = (aim * ar - (are - 1.0f) * ai) / mag2;
            ABAR[2 * e] = are; ABAR[2 * e + 1] = aim;
            for (int c = 0; c < 16; ++c) { const float br = P.in[I_BRE][(size_t)e * 16 + c], bi = P.in[I_BIM][(size_t)e * 16 + c];
                BB[((size_t)lg * 128 + p) * 16 + c] = (bf16_t)(cvtpk(cre * br - cim * bi, 0.f) & 0xffffu);
                BB[((size_t)lg * 128 + 64 + p) * 16 + c] = (bf16_t)(cvtpk(cre * bi + cim * br, 0.f) & 0xffffu);
                *(unsigned*)(CC + ((size_t)lg * 16 + c) * 128 + 2 * p) = cvtpk(P.in[I_CRE][((size_t)lg * 16 + c) * 64 + p], -P.in[I_CIM][((size_t)lg * 16 + c) * 64 + p]); }
        }
        for (int e = bid * 512 + tid; e < 2 * 1024; e += G * 512) { const int l = e >> 10, c = e & 1023; float* pr = PRM + l * PRM_L;
            pr[PR_GPOST + c] = P.in[I_GPOST][e]; pr[PR_GPREF + c] = P.in[I_GPREF][e]; pr[PR_GPOSTF + c] = P.in[I_GPOSTF][e]; pr[PR_GMIX + c] = P.in[I_GMIX][e]; pr[PR_GPRE + c] = P.in[I_GPRE][e];
            if (c < 256) { pr[PR_BGLU + c] = P.in[I_BGLU][l * 256 + c]; pr[PR_SD + c] = P.in[I_SD][l * 256 + c]; }
            if (c < 8) pr[PR_BF + c] = (c < 6) ? P.in[I_BF][l * 6 + c] : 0.f; }
        row_phase<false, 0, 2>(Px, nullptr, (float*)(ws + 60 * MiB), (const bf16_t*)(ws + WS_BUFB), nullptr, nullptr, P.in[I_GPRE], (bf16_t*)(ws + WS_BUFA), gw, NGW, lane);
    }
    }
    if constexpr (PH == 1) {
        { WSBASE(); pg8::Gemm g{(bf16_t*)(ws + WS_BUFA), (bf16_t*)(ws + WS_WIN) + (size_t)l * NINP * 1024, M, NINP, 1024}; pg8::StaticOrder S; S.init(M, NINP, G, bid);
          pg8::EpiProj E{(bf16_t*)(ws + WS_PROJ), (float*)(ws + WS_FL), (const float*)(ws + WS_PRM) + l * PRM_L + PR_BF};
          pg8::gemm_phase<pg8::EpiProj, pg8::StaticOrder, true, true>(lds, g, S, E, wave); }
    }
    if constexpr (PH == 2) {
        {
            WSBASE();
            const bf16_t* PROJ = (const bf16_t*)(ws + WS_PROJ); float* FL = (float*)(ws + WS_FL);
            constexpr int NU_SSM = 64, NU_FOX = NB * 6 * 8, NU_DSA = NB * 3 * 48;
            unsigned* qctr = (unsigned*)(ws + WS_CTL) + 64 * l; LAS int* uq = (LAS int*)(lds + LDS_BYTES - 64);
#ifdef STATIC_Q
            (void)qctr; (void)uq;
            for (int u = bid; u < NU_SSM + NU_FOX + NU_DSA; u += G) {
#else
            for (;;) {
                __syncthreads();
                if (tid == 0) *uq = (int)__hip_atomic_fetch_add(qctr, 1u, __ATOMIC_RELAXED, __HIP_MEMORY_SCOPE_AGENT);
                __syncthreads();
                const int u = __builtin_amdgcn_readfirstlane(*uq);
                if (u >= NU_SSM + NU_FOX + NU_DSA || u >= umax) break;
#endif
                if (u < NU_SSM) { const int wu = u * 8 + wave;
                    ssm_wave(PROJ, (const float*)(ws + WS_ABAR) + (size_t)l * 16 * 64 * 2, (const bf16_t*)(ws + WS_BB) + (size_t)l * 16 * 128 * 16, (const bf16_t*)(ws + WS_CC) + (size_t)l * 16 * 16 * 128,
                             (const float*)(ws + WS_PRM) + l * PRM_L + PR_SD, (bf16_t*)(ws + WS_G), lds + wave * SSM_WAVE_LDS, wu >> 4, wu & 15, lane);
                } else if (u < NU_SSM + NU_FOX) { const int v = u - NU_SSM, qb = 7 - v / 192, bh = v % 192;
                    fox_unit(PROJ, FL, (bf16_t*)(ws + WS_FOXO), lds, bh / 6, bh % 6, qb, tid, lane, wave);
                } else { const int v = u - NU_SSM - NU_FOX, b = v / 144, rem = v % 144, hp = rem / 48, j = rem % 48, pat = j >> 4, jj = j & 15;
                    const int res = (pat == 0) ? 0 : (pat == 1 ? (jj & 3) : jj), n = (pat == 0) ? jj : (pat == 1 ? (jj >> 2) : 0);
                    dsa_unit(PROJ, (bf16_t*)(ws + WS_DSAO), (float*)(ws + WS_LSE), lds, b, hp, pat, res, n, tid, lane, wave);
                }
            }
        }
    }
    if constexpr (PH == 3) {
        { WSBASE(); int kglu = 256; asm volatile("" : "+s"(kglu)); pg8::Gemm g{(bf16_t*)(ws + WS_G), (bf16_t*)(ws + WS_WGLU) + (size_t)l * 256 * 256, M, 256, kglu}; pg8::StaticOrder S; S.init(M, 256, G, bid);
          pg8::EpiGLUNorm E{(bf16_t*)(ws + WS_G), (bf16_t*)(ws + WS_PROJ), (const float*)(ws + WS_PRM) + l * PRM_L + PR_BGLU, (const float*)(ws + WS_PRM) + l * PRM_L + PR_GMIX};
          pg8::gemm_phase<pg8::EpiGLUNorm, pg8::StaticOrder, false, true>(lds, g, S, E, wave);
          bf16_t* d_ = (bf16_t*)(ws + WS_DSAO); float* e_ = (float*)(ws + WS_LSE); bf16_t* f_ = (bf16_t*)(ws + WS_FOXO); const float* g_ = (const float*)(ws + WS_PRM) + l * PRM_L + PR_GMIX; bf16_t* o_ = (bf16_t*)(ws + WS_PROJ);
          for (int m = gw; m < M; m += 2 * NGW) { merge_row(nullptr, d_, e_, f_, g_, o_, (size_t)m, lane); if (m + NGW < M) merge_row(nullptr, d_, e_, f_, g_, o_, (size_t)(m + NGW), lane); } }
    }
    if constexpr (PH == 4) {
    }
    if constexpr (PH == 5) {
        { WSBASE(); const bool second = (umax == 1);
          int kk = second ? DFF : 1024; asm volatile("" : "+s"(kk));
          const bf16_t* bt = second ? (const bf16_t*)(ws + WS_WDN) + (size_t)l * 1024 * DFF : (const bf16_t*)(ws + WS_WOUT) + (size_t)l * 1024 * 1024;
          pg8::Gemm g{(bf16_t*)(ws + WS_PROJ), bt, M, 1024, kk}; pg8::StaticOrder S; S.init(M, 1024, G, bid);
          pg8::EpiBf16<0> E{(bf16_t*)(ws + WS_BUFB), 1024, nullptr, 0, 0, 1.f};
          pg8::gemm_phase<pg8::EpiBf16<0>, pg8::StaticOrder, true, true>(lds, g, S, E, wave); }
    }
    if constexpr (PH == 6) {
        { WSBASE(); const float* xin = (l == 0) ? Px : Pout; const float* pr = (const float*)(ws + WS_PRM) + l * PRM_L;
          (void)xin; float* rn = (float*)(ws + 60 * MiB);
          row_phase<true, 2, 2>((const bf16_t*)(ws + WS_BUFA), pr + PR_GPRE, rn, (const bf16_t*)(ws + WS_BUFB), pr + PR_GPOST, nullptr, pr + PR_GPREF, (bf16_t*)(ws + WS_BUFA), gw, NGW, lane); }
    }
    if constexpr (PH == 7) {
        { WSBASE(); pg8::Gemm g{(bf16_t*)(ws + WS_BUFA), (bf16_t*)(ws + WS_WGU) + (size_t)l * NGU * 1024, M, NGU, 1024}; pg8::StaticOrder S; S.init(M, NGU, G, bid);
          pg8::EpiSwiGLU E{(bf16_t*)(ws + WS_PROJ)};
          pg8::gemm_phase<pg8::EpiSwiGLU, pg8::StaticOrder, true, true>(lds, g, S, E, wave); }
    }
    if constexpr (PH == 8) {
        { WSBASE(); pg8::Gemm g{(bf16_t*)(ws + WS_PROJ), (bf16_t*)(ws + WS_WDN) + (size_t)l * 1024 * DFF, M, 1024, DFF}; pg8::StaticOrder S; S.init(M, 1024, G, bid);
          pg8::EpiBf16<0> E{(bf16_t*)(ws + WS_BUFB), 1024, nullptr, 0, 0, 1.f};
          pg8::gemm_phase<pg8::EpiBf16<0>, pg8::StaticOrder, true, true>(lds, g, S, E, wave); }
    }
    if constexpr (PH == 9) {
        { WSBASE(); const float* pr = (const float*)(ws + WS_PRM);
          float* rn = (float*)(ws + 60 * MiB); const bf16_t* xnb = (const bf16_t*)(ws + WS_BUFA);
          if (l == 0) row_phase<true, 2, 2>(xnb, pr + l * PRM_L + PR_GPREF, rn, (const bf16_t*)(ws + WS_BUFB), pr + l * PRM_L + PR_GPOSTF, nullptr, pr + PRM_L + PR_GPRE, (bf16_t*)(ws + WS_BUFA), gw, NGW, lane);
          else row_phase<true, 2, 0>(xnb, pr + l * PRM_L + PR_GPREF, rn, (const bf16_t*)(ws + WS_BUFB), pr + l * PRM_L + PR_GPOSTF, Pout, pr + PRM_L + PR_GPRE, nullptr, gw, NGW, lane); }
    }
#undef WSBASE
}

template <int PH> __global__ void __launch_bounds__(512, 2) phase_k(Params P, int l) {
    extern __shared__ __attribute__((aligned(16))) unsigned char lds_raw[];
    const int wave0 = __builtin_amdgcn_readfirstlane(threadIdx.x >> 6);
    run_phase<PH>(P, l, (LAS unsigned char*)lds_raw, wave0);
}
#ifdef MEGA
__global__ void __launch_bounds__(512, 2) mega(Params P) {
    extern __shared__ __attribute__((aligned(16))) unsigned char lds_raw[];
    LAS unsigned char* lds = (LAS unsigned char*)lds_raw;
    const int wave0 = __builtin_amdgcn_readfirstlane(threadIdx.x >> 6);
    volatile LAS unsigned* bst = (volatile LAS unsigned*)(lds + LDS_BYTES - 32);
    if (threadIdx.x < 2) bst[threadIdx.x] = 0u;
    __syncthreads();
    unsigned* barw; { GAS unsigned char* wsg_ = (GAS unsigned char*)P.ws; barw = (unsigned*)(unsigned char*)(wsg_ + WS_CTL) + 4096; }
    XcdBarrier xb = xcd_barrier_post(barw, bst, (int)threadIdx.x);
#define GRIDBAR() do { int lane_b; asm volatile("v_mbcnt_lo_u32_b32 %0, -1, 0\n\tv_mbcnt_hi_u32_b32 %0, -1, %0" : "=v"(lane_b)); xcd_barrier(xb, wave0 * 64 + lane_b); } while (0)
    cg::this_grid().sync();
    run_phase<0>(P, 0, lds, wave0);
    GRIDBAR();
    const int tidz = (int)(blockIdx.x * 512 + threadIdx.x); (void)tidz;
#pragma unroll 1
    for (int hl = 0; hl < 4; ++hl) {
        const int l = hl >> 1, second = hl & 1;
        if (!second) {
            run_phase<1>(P, l, lds, wave0); GRIDBAR();
            run_phase<2>(P, l, lds, wave0); GRIDBAR();
            run_phase<3>(P, l, lds, wave0); GRIDBAR();
        } else {
            run_phase<7>(P, l, lds, wave0); GRIDBAR();
        }
        run_phase<5>(P, l, lds, wave0, second); GRIDBAR();
        if (!second) { run_phase<6>(P, l, lds, wave0); GRIDBAR(); }
        else { run_phase<9>(P, l, lds, wave0); if (hl != 3) GRIDBAR(); }
    }
#undef GRIDBAR
}
#endif


__global__ void dbg_copy(const bf16_t* src, float* out, int ld, int ncol, int planes = 1) {
    const size_t m = blockIdx.x;
    for (int c = threadIdx.x; c < 1024; c += blockDim.x) { float a = 0.f; for (int pl = 0; pl < planes; ++pl) for (int k = c; k < ncol; k += 1024) a += bf2f(src[((size_t)pl * M + m) * ld + k]); out[m * 1024 + c] = a; }
}
__global__ void dbg_prm(const unsigned char* ws, float* out) {
    const int i = blockIdx.x * blockDim.x + threadIdx.x;
    if (i < 4096) out[i] = ((const float*)(ws + WS_ABAR))[i];
    else if (i < 4096 + 65536) out[i] = bf2f(((const bf16_t*)(ws + WS_BB))[i - 4096]);
    else if (i < 4096 + 131072) out[i] = bf2f(((const bf16_t*)(ws + WS_CC))[i - 4096 - 65536]);
    else if (i < 4096 + 131072 + 16384) out[i] = ((const float*)(ws + 58 * MiB))[i - 4096 - 131072];
}
template <int PH> static void launch_phase(const Params& p, int l, int grid, hipStream_t stream) {
    static bool attr = false;
    if (!attr) { (void)hipFuncSetAttribute((const void*)phase_k<PH>, hipFuncAttributeMaxDynamicSharedMemorySize, LDS_BYTES); attr = true; }
    hipLaunchKernelGGL(phase_k<PH>, dim3(grid), dim3(512), LDS_BYTES, stream, p, l);
}
extern "C" void kernel_launch(void* const* d_in, const int* in_sizes, int n_in, void* d_out, int out_size, void* d_ws, size_t ws_size, hipStream_t stream) {
    static int grid = 0;
    if (grid == 0) {
        if (n_in != 21 || in_sizes[0] != M * DM || out_size != M * DM || ws_size < WS_END) { fprintf(stderr, "kernel_launch: unexpected shapes: n_in %d in0 %d out %d ws %zu\n", n_in, n_in > 0 ? in_sizes[0] : -1, out_size, ws_size); grid = -1; return; }
        int dev = 0, cus = 0, per_cu = 1;
        (void)hipGetDevice(&dev); (void)hipDeviceGetAttribute(&cus, hipDeviceAttributeMultiprocessorCount, dev);
#ifdef MEGA
        if (hipFuncSetAttribute((const void*)mega, hipFuncAttributeMaxDynamicSharedMemorySize, LDS_BYTES) != hipSuccess) { fprintf(stderr, "kernel_launch: hipFuncSetAttribute failed\n"); grid = -1; return; }
        if (hipOccupancyMaxActiveBlocksPerMultiprocessor(&per_cu, (const void*)mega, 512, LDS_BYTES) != hipSuccess || per_cu < 1) { fprintf(stderr, "kernel_launch: occupancy query says %d\n", per_cu); per_cu = 1; }
        (void)hipGetLastError();
#endif
        grid = cus * per_cu;
    }
    if (grid < 0) return;
    if (hipMemsetAsync((char*)d_ws + WS_CTL, 0, 65536, stream) != hipSuccess) { fprintf(stderr, "kernel_launch: memset failed\n"); return; }
    Params p{};
    for (int i = 0; i < 21; ++i) p.in[i] = (const float*)d_in[i];
    p.out = (float*)d_out; p.ws = (unsigned char*)d_ws;
#ifdef MEGA
    void* args[] = {&p};
    hipError_t e = hipLaunchCooperativeKernel((const void*)mega, dim3(grid), dim3(512), args, LDS_BYTES, stream);
    if (e != hipSuccess) fprintf(stderr, "kernel_launch: cooperative launch failed: %s (grid %d)\n", hipGetErrorString(e), grid);
#else
    launch_phase<0>(p, 0, grid, stream);
#if defined(DBG_STOP) && DBG_STOP == 100
    hipLaunchKernelGGL(dbg_prm, dim3(640), dim3(256), 0, stream, (const unsigned char*)d_ws, (float*)d_out); return;
#endif
    for (int l = 0; l < 2; ++l) {
#if defined(DBG_STOP) && DBG_STOP == 1
        launch_phase<1>(p, l, grid, stream); hipLaunchKernelGGL(dbg_copy, dim3(M), dim3(256), 0, stream, (const bf16_t*)((unsigned char*)d_ws + WS_PROJ), (float*)d_out, LDP, LDP); return;
#endif
#if defined(DBG_STOP) && DBG_STOP == 21
        launch_phase<1>(p, l, grid, stream); launch_phase<2>(p, l, grid, stream); hipLaunchKernelGGL(dbg_copy, dim3(M), dim3(256), 0, stream, (const bf16_t*)((unsigned char*)d_ws + WS_FOXO), (float*)d_out, 384, 384, 1); return;
#endif
#if defined(DBG_STOP) && DBG_STOP == 22
        launch_phase<1>(p, l, grid, stream); launch_phase<2>(p, l, grid, stream); hipLaunchKernelGGL(dbg_copy, dim3(M), dim3(256), 0, stream, (const bf16_t*)((unsigned char*)d_ws + WS_DSAO), (float*)d_out, 384, 384, 3); return;
#endif
#if defined(DBG_STOP) && DBG_STOP == 23
        launch_phase<1>(p, l, grid, stream); launch_phase<2>(p, l, grid, stream); hipLaunchKernelGGL(dbg_copy, dim3(M), dim3(256), 0, stream, (const bf16_t*)((unsigned char*)d_ws + WS_G), (float*)d_out, 256, 256, 1); return;
#endif
#if defined(DBG_STOP) && DBG_STOP == 4
        launch_phase<1>(p, l, grid, stream); launch_phase<2>(p, l, grid, stream); launch_phase<3>(p, l, grid, stream); launch_phase<4>(p, l, grid, stream);
        hipLaunchKernelGGL(dbg_copy, dim3(M), dim3(256), 0, stream, (const bf16_t*)((unsigned char*)d_ws + WS_BUFA), (float*)d_out, 1024, 1024); return;
#endif
        launch_phase<1>(p, l, grid, stream); launch_phase<2>(p, l, grid, stream); launch_phase<3>(p, l, grid, stream); launch_phase<4>(p, l, grid, stream); launch_phase<5>(p, l, grid, stream);
        launch_phase<6>(p, l, grid, stream); launch_phase<7>(p, l, grid, stream); launch_phase<8>(p, l, grid, stream); launch_phase<9>(p, l, grid, stream);
    }
#endif
}
```

```cpp
#define MEGA 1
#include <hip/hip_runtime.h>
#include <hip/hip_cooperative_groups.h>
#include <cstdio>
#include <cstdint>
namespace cg = cooperative_groups;
namespace pg8 {
#define PG8_LAS __attribute__((address_space(3)))
typedef unsigned short bf16_t;
typedef short bf16x8 __attribute__((ext_vector_type(8)));
typedef float f32x4 __attribute__((ext_vector_type(4)));
typedef unsigned u32x4 __attribute__((ext_vector_type(4)));
constexpr int BM = 256, BK = 64, HALF = 128, HTB = HALF * BK * 2  , STAGE_BYTES = 8 * HTB, NXCD = 8, WGM = 8;

__host__ __device__ __forceinline__ int lds_byte(int r, int c) { const int st = (r >> 4) * 2 + (c >> 5), rr = r & 15, cc = c & 31, ob = rr * 64 + cc * 2; return st * 1024 + (ob ^ (((ob >> 9) & 1) << 5)); }
__host__ __device__ __forceinline__ void stage_rc(int b, int& R, int& C) { const int st = b / 1024, sb = b % 1024, swz = sb ^ (((sb >> 9) & 1) << 5); R = (st >> 1) * 16 + swz / 64; C = (st & 1) * 32 + (swz % 64) / 2; }
__host__ __device__ __forceinline__ int perm32(int rho) { const int n = rho >> 4, i = rho & 15; return 8 * (i >> 2) + 4 * n + (i & 3); }

struct Unit { int pm, pn; };
struct Gemm { const bf16_t* A; const bf16_t* Bt; int M, N, K; };

struct StaticOrder {
    int nM, nN, nwg, G, c;
    __host__ __device__ void init(int M, int N, int G_, int c_) { nM = M / BM; nN = N / BM; nwg = nM * nN; G = G_; c = c_; }
    __host__ __device__ bool next(int i, Unit& u) const {
        const long L = (long)i * G + c; if (L >= nwg) return false;
        int wgid = (int)L; { const int q = nwg / NXCD, r = nwg % NXCD, xcd = wgid % NXCD, off = wgid / NXCD; wgid = (xcd < r ? xcd * (q + 1) : r * (q + 1) + (xcd - r) * q) + off; }
        const int nig = WGM * nN, gid = wgid / nig, fm = gid * WGM, gsz = (nM - fm) < WGM ? (nM - fm) : WGM;
        u.pm = fm + ((wgid % nig) % gsz); u.pn = (wgid % nig) / gsz; return true;
    }
    __device__ __forceinline__ void a_ready(const Unit&) const {}
    __device__ __forceinline__ void done(const Unit&) const {}
};

__device__ __forceinline__ unsigned cvt_pk_bf16(float lo, float hi) { unsigned r; asm volatile("v_cvt_pk_bf16_f32 %0, %1, %2" : "=v"(r) : "v"(lo), "v"(hi)); return r; }
typedef float f32x2 __attribute__((ext_vector_type(2)));
__device__ __forceinline__ f32x2 gelu_pk(f32x2 v) {
    const f32x2 av = __builtin_elementwise_abs(v), d = av * 0.2316418882f + 1.0f;
    f32x2 t; t.x = __builtin_amdgcn_rcpf(d.x); t.y = __builtin_amdgcn_rcpf(d.y);
    f32x2 q = t * 0.5307027145f + (-0.7265760135f); q = q * t + 0.7107068705f; q = q * t + (-0.142248368f); q = q * t + 0.127414796f; q = q * t;
    const f32x2 s = (v * v) * (-0.72134752044f);
    f32x2 e; e.x = __builtin_amdgcn_exp2f(s.x); e.y = __builtin_amdgcn_exp2f(s.y);
    const f32x2 m = v * (q * e), r = v - m;
    f32x2 o; o.x = v.x < 0.f ? m.x : r.x; o.y = v.y < 0.f ? m.y : r.y; return o;
}

template <int ACT  > struct EpiBf16 {
    static constexpr bool PERM = true, AFTER_DRAIN = false; static_assert(ACT == 0 || ACT == 1, "EpiBf16: ACT is 0 (none) or 1 (gelu_pk)");
    bf16_t* O; int ldc; const float* bias; int split_cols; size_t split_stride; float scale0;
    __device__ __forceinline__ void operator()(const f32x4 (&acc)[2][2][4][2], const Unit& u, int wr, int wc, int fr, int fq) const {
        const int row0 = u.pm * BM + wr * 64 + fr; int colt = u.pn * BM; bf16_t* base = O;
        float sc = 1.f; if (split_cols) { const int t = colt / split_cols; base += (size_t)t * split_stride; colt -= t * split_cols; if (t == 0) sc = scale0; }
        const int col0 = colt + wc * 32 + 8 * fq, bcol0 = u.pn * BM + wc * 32 + 8 * fq;
        f32x4 bv[2][2];
#pragma unroll
        for (int bj = 0; bj < 2; ++bj)
#pragma unroll
            for (int n = 0; n < 2; ++n) bv[bj][n] = bias ? *(const f32x4*)(bias + bcol0 + bj * HALF + 4 * n) : (f32x4){0.f, 0.f, 0.f, 0.f};
#pragma unroll
        for (int ai = 0; ai < 2; ++ai)
#pragma unroll
            for (int m = 0; m < 4; ++m) { bf16_t* rowp = base + (size_t)(row0 + ai * HALF + m * 16) * ldc + col0;
#pragma unroll
                for (int bj = 0; bj < 2; ++bj) { f32x4 v0 = acc[ai][bj][m][0] + bv[bj][0], v1 = acc[ai][bj][m][1] + bv[bj][1];
                    if (ACT == 1) { f32x2 a = gelu_pk((f32x2){v0[0], v0[1]}), b = gelu_pk((f32x2){v0[2], v0[3]}), c = gelu_pk((f32x2){v1[0], v1[1]}), d = gelu_pk((f32x2){v1[2], v1[3]});
                        v0 = (f32x4){a.x, a.y, b.x, b.y}; v1 = (f32x4){c.x, c.y, d.x, d.y}; }
                    v0 = v0 * sc; v1 = v1 * sc; u32x4 w; w.x = cvt_pk_bf16(v0[0], v0[1]); w.y = cvt_pk_bf16(v0[2], v0[3]); w.z = cvt_pk_bf16(v1[0], v1[1]); w.w = cvt_pk_bf16(v1[2], v1[3]);
                    *(u32x4*)(rowp + bj * HALF) = w; } }
    }
};
template <class Epi, class Sched, bool ALIGN_EPI = false, bool SP2 = false>
__device__ __forceinline__ void gemm_phase(PG8_LAS unsigned char* lds, const Gemm g, const Sched& S, const Epi& E, const int wave_in) {
    int lane_l; asm volatile("v_mbcnt_lo_u32_b32 %0, -1, 0\n\tv_mbcnt_hi_u32_b32 %0, -1, %0" : "=v"(lane_l));
    const int wid = wave_in, lane = lane_l, tid = wid * 64 + lane, wr = wid >> 2, wc = wid & 3, fr = lane & 15, fq = lane >> 4;
    const int K = g.K, nt = K / BK;
    unsigned voffA[2], voffB[2];
#pragma unroll
    for (int i = 0; i < 2; ++i) { int R, C; stage_rc(tid * 16 + i * 8192, R, C); const int Rb = Epi::PERM ? ((R & ~31) + perm32(R & 31)) : R;
        voffA[i] = (unsigned)(R * K + C) * 2u; voffB[i] = (unsigned)(Rb * K + C) * 2u; }
    const size_t kstep = (size_t)(BK * 2);
    const size_t hstep = (size_t)HALF * K * 2;
    const size_t tstep = 2 * hstep;
    const unsigned ldsw = (unsigned)wid * 1024u;
    const int aoff = lds_byte(wr * 64 + fr, fq * 8), boff = lds_byte(wc * 32 + fr, fq * 8);
#define PG8_SA(b, h) (((b) * 2 + (h)) * HTB)
#define PG8_SB(b, h) ((4 + (b) * 2 + (h)) * HTB)
#define PG8_STAGE(bufoff, gbase, voff) do { _Pragma("unroll") for (int _i = 0; _i < 2; ++_i) \
        __builtin_amdgcn_global_load_lds((const unsigned*)((const char*)(gbase) + (voff)[_i]), (PG8_LAS unsigned*)(lds + (bufoff) + ldsw + _i * 8192), 16, 0, 0); } while (0)
#define PG8_LDA(dst, b, h) do { _Pragma("unroll") for (int m = 0; m < 4; ++m) _Pragma("unroll") for (int k = 0; k < 2; ++k) dst[m][k] = *(const PG8_LAS bf16x8*)(lds + PG8_SA(b, h) + aoff + m * 2048 + k * 1024); } while (0)
#define PG8_LDB(dst, b, h) do { _Pragma("unroll") for (int n = 0; n < 2; ++n) _Pragma("unroll") for (int k = 0; k < 2; ++k) dst[n][k] = *(const PG8_LAS bf16x8*)(lds + PG8_SB(b, h) + boff + n * 2048 + k * 1024); } while (0)
#define PG8_MMA(ai, bj, At, Bt) do { __builtin_amdgcn_s_setprio(1); _Pragma("unroll") for (int m = 0; m < 4; ++m) _Pragma("unroll") for (int n = 0; n < 2; ++n) _Pragma("unroll") for (int k = 0; k < 2; ++k) \
        acc[ai][bj][m][n] = __builtin_amdgcn_mfma_f32_16x16x32_bf16(Bt[n][k], At[m][k], acc[ai][bj][m][n], 0, 0, 0); __builtin_amdgcn_s_setprio(0); } while (0)
#define PG8_WAIT_V(n) asm volatile("s_waitcnt vmcnt(" #n ")" ::: "memory")
#define PG8_WAIT_L(n) asm volatile("s_waitcnt lgkmcnt(" #n ")" ::: "memory")
#define PG8_BAR __builtin_amdgcn_s_barrier()
#define PG8_SCHED __builtin_amdgcn_sched_barrier(0)
    Unit cur, nxt; int ui = 0;
    if (!S.next(0, cur)) return;
    f32x4 acc[2][2][4][2];
#pragma unroll
    for (int a = 0; a < 2; ++a)
#pragma unroll
        for (int b = 0; b < 2; ++b)
#pragma unroll
            for (int m = 0; m < 4; ++m)
#pragma unroll
                for (int n = 0; n < 2; ++n) acc[a][b][m][n] = (f32x4){0.f, 0.f, 0.f, 0.f};
    bf16x8 At[4][2], B0[2][2], B1[2][2];
    const char* cA = (const char*)g.A + (size_t)cur.pm * tstep; const char* cB = (const char*)g.Bt + (size_t)cur.pn * tstep;
    S.a_ready(cur);
    if constexpr (SP2) {
        PG8_STAGE(PG8_SB(0, 0), cB, voffB); PG8_STAGE(PG8_SB(0, 1), cB + hstep, voffB); PG8_STAGE(PG8_SA(0, 0), cA, voffA); PG8_STAGE(PG8_SA(0, 1), cA + hstep, voffA);
        if (wr == 1) PG8_BAR;
        PG8_WAIT_V(2); PG8_BAR;
        PG8_STAGE(PG8_SB(1, 0), cB + kstep, voffB); PG8_STAGE(PG8_SA(1, 0), cA + kstep, voffA); PG8_STAGE(PG8_SB(1, 1), cB + hstep + kstep, voffB);
        PG8_WAIT_V(6); PG8_BAR;
    } else {
        PG8_STAGE(PG8_SB(0, 0), cB, voffB); PG8_STAGE(PG8_SA(0, 0), cA, voffA); PG8_STAGE(PG8_SB(0, 1), cB + hstep, voffB); PG8_STAGE(PG8_SA(0, 1), cA + hstep, voffA);
        if (wr == 1) PG8_BAR;
        PG8_WAIT_V(4); PG8_BAR;
        PG8_STAGE(PG8_SB(1, 0), cB + kstep, voffB); PG8_STAGE(PG8_SA(1, 0), cA + kstep, voffA); PG8_STAGE(PG8_SB(1, 1), cB + hstep + kstep, voffB);
        PG8_WAIT_V(6); PG8_BAR;
    }
    for (;;) {
        const bool has_next = S.next(ui + 1, nxt);
        const char* nA = has_next ? (const char*)g.A + (size_t)nxt.pm * tstep : cA; const char* nB = has_next ? (const char*)g.Bt + (size_t)nxt.pn * tstep : cB;
        for (int t = 0; t < nt; t += 2) {
            const bool last = (t == nt - 2);
            const char* a1 = cA + (size_t)(t + 1) * kstep;
            const char* a2 = last ? nA : cA + (size_t)(t + 2) * kstep; const char* b2 = last ? nB : cB + (size_t)(t + 2) * kstep;
            const char* a3 = a2 + kstep; const char* b3 = b2 + kstep;
            if (last && has_next) S.a_ready(nxt);
            if constexpr (SP2) {
            PG8_LDB(B0, 0, 0); PG8_LDB(B1, 0, 1); PG8_SCHED; PG8_LDA(At, 0, 0); PG8_STAGE(PG8_SA(1, 1), a1 + hstep, voffA);
            PG8_WAIT_V(8); PG8_WAIT_L(0); PG8_BAR; PG8_MMA(0, 0, At, B0); PG8_MMA(0, 1, At, B1); PG8_BAR; PG8_SCHED;
            PG8_LDA(At, 0, 1); PG8_STAGE(PG8_SB(0, 0), b2, voffB); PG8_STAGE(PG8_SB(0, 1), b2 + hstep, voffB); PG8_STAGE(PG8_SA(0, 0), a2, voffA);
            PG8_WAIT_V(8); PG8_WAIT_L(0); PG8_BAR; PG8_MMA(1, 0, At, B0); PG8_MMA(1, 1, At, B1); PG8_BAR; PG8_SCHED;
            PG8_LDB(B0, 1, 0); PG8_LDB(B1, 1, 1); PG8_SCHED; PG8_LDA(At, 1, 0); PG8_STAGE(PG8_SA(0, 1), a2 + hstep, voffA);
            PG8_WAIT_V(8); PG8_WAIT_L(0); PG8_BAR; PG8_MMA(0, 0, At, B0); PG8_MMA(0, 1, At, B1); PG8_BAR; PG8_SCHED;
            PG8_LDA(At, 1, 1); PG8_STAGE(PG8_SB(1, 0), b3, voffB); PG8_STAGE(PG8_SB(1, 1), b3 + hstep, voffB); PG8_STAGE(PG8_SA(1, 0), a3, voffA);
            PG8_WAIT_V(8); PG8_WAIT_L(0); PG8_BAR; PG8_MMA(1, 0, At, B0); PG8_MMA(1, 1, At, B1); PG8_BAR; PG8_SCHED;
            } else {
            PG8_LDB(B0, 0, 0); PG8_SCHED; PG8_LDA(At, 0, 0); PG8_STAGE(PG8_SA(1, 1), a1 + hstep, voffA);
            PG8_WAIT_L(8); PG8_BAR; PG8_WAIT_L(0); PG8_MMA(0, 0, At, B0); PG8_BAR; PG8_SCHED;
            PG8_LDB(B1, 0, 1); PG8_STAGE(PG8_SB(0, 0), b2, voffB);
            PG8_BAR; PG8_WAIT_L(0); PG8_MMA(0, 1, At, B1); PG8_BAR;
            PG8_LDA(At, 0, 1); PG8_STAGE(PG8_SA(0, 0), a2, voffA);
            PG8_BAR; PG8_WAIT_L(0); PG8_MMA(1, 0, At, B0); PG8_BAR; PG8_SCHED;
            PG8_STAGE(PG8_SB(0, 1), b2 + hstep, voffB);
            PG8_WAIT_V(6); PG8_BAR; PG8_MMA(1, 1, At, B1); PG8_BAR;
            PG8_LDB(B0, 1, 0); PG8_SCHED; PG8_LDA(At, 1, 0); PG8_STAGE(PG8_SA(0, 1), a2 + hstep, voffA);
            PG8_WAIT_L(8); PG8_BAR; PG8_WAIT_L(0); PG8_MMA(0, 0, At, B0); PG8_BAR; PG8_SCHED;
            PG8_LDB(B1, 1, 1); PG8_STAGE(PG8_SB(1, 0), b3, voffB);
            PG8_BAR; PG8_WAIT_L(0); PG8_MMA(0, 1, At, B1); PG8_BAR;
            PG8_LDA(At, 1, 1); PG8_STAGE(PG8_SA(1, 0), a3, voffA);
            PG8_BAR; PG8_WAIT_L(0); PG8_MMA(1, 0, At, B0); PG8_BAR; PG8_SCHED;
            PG8_STAGE(PG8_SB(1, 1), b3 + hstep, voffB);
            PG8_WAIT_V(6); PG8_BAR; PG8_MMA(1, 1, At, B1); PG8_BAR;
            }
        }
        if constexpr (ALIGN_EPI) { if (wr == 0) PG8_BAR; }
        if constexpr (!Epi::AFTER_DRAIN) { E(acc, cur, wr, wc, fr, fq); S.done(cur); }
        if (!has_next) break;
#pragma unroll
        for (int a = 0; a < 2; ++a)
#pragma unroll
            for (int b = 0; b < 2; ++b)
#pragma unroll
                for (int m = 0; m < 4; ++m)
#pragma unroll
                    for (int n = 0; n < 2; ++n) acc[a][b][m][n] = (f32x4){0.f, 0.f, 0.f, 0.f};
        cur = nxt; cA = nA; cB = nB; ++ui;
        if constexpr (ALIGN_EPI) { if (wr == 1) PG8_BAR; }
    }
    PG8_WAIT_V(0);
    if constexpr (!ALIGN_EPI) { if (wr == 0) PG8_BAR; }
    PG8_BAR;
    if constexpr (Epi::AFTER_DRAIN) { E.fused(acc, cur, wr, wc, fr, fq, lds, wid, lane); S.done(cur); }
#undef PG8_SA
#undef PG8_SB
#undef PG8_STAGE
#undef PG8_LDA
#undef PG8_LDB
#undef PG8_MMA
#undef PG8_WAIT_V
#undef PG8_WAIT_L
#undef PG8_BAR
#undef PG8_SCHED
}
}
#define LAS __attribute__((address_space(3)))
#define GAS __attribute__((address_space(1)))
typedef unsigned short bf16_t;
typedef short bf16x8 __attribute__((ext_vector_type(8)));
typedef float f32x4 __attribute__((ext_vector_type(4)));
typedef float f32x16 __attribute__((ext_vector_type(16)));
typedef unsigned u32x4 __attribute__((ext_vector_type(4)));
typedef unsigned u32x2 __attribute__((ext_vector_type(2)));
constexpr int NB = 32, SEQ = 2048, DM = 1024, M = NB * SEQ;
constexpr int NIN = 2566, NINP = 2816, DFF = 2816, NGU = 5632, LDP = 2816;
constexpr int COL_DQ = 256, COL_DK = 640, COL_DV = 1024, COL_FQ = 1408, COL_FK = 1792, COL_FV = 2176;
constexpr float EPS = 1e-6f, LOG2E = 1.4426950408889634f, QK_C = 0.125f * 1.4426950408889634f;
constexpr size_t MiB = (size_t)1 << 20;
constexpr size_t WS_WIN = 0, WS_WOUT = 11 * MiB, WS_WGU = 15 * MiB, WS_WDN = 37 * MiB, WS_WGLU = 48 * MiB;
constexpr size_t WS_ABAR = 49 * MiB, WS_BB = 49 * MiB + 65536, WS_CC = 49 * MiB + 262144, WS_FL = 50 * MiB, WS_LSE = 52 * MiB;
constexpr size_t WS_BUFA = 64 * MiB, WS_BUFB = 192 * MiB, WS_PROJ = 320 * MiB, WS_DSAO = 672 * MiB, WS_FOXO = 816 * MiB, WS_G = 864 * MiB, WS_SSMO = 896 * MiB, WS_END = 928 * MiB;
constexpr int LDS_BYTES = 147456;
constexpr size_t WS_CTL = 59 * MiB;

struct Params { const float* in[21]; float* out; unsigned char* ws; };
enum { I_X = 0, I_GPRE, I_WIN, I_BF, I_LDT, I_ARE, I_AIM, I_BRE, I_BIM, I_CRE, I_CIM, I_SD, I_WGLU, I_BGLU, I_GMIX, I_WOUT, I_GPOST, I_GPREF, I_WGU, I_WDN, I_GPOSTF };

__device__ __forceinline__ unsigned cvtpk(float lo, float hi) { typedef float f2 __attribute__((ext_vector_type(2))); typedef __bf16 b2 __attribute__((ext_vector_type(2))); f2 v = {lo, hi}; b2 b = __builtin_convertvector(v, b2); return __builtin_bit_cast(unsigned, b); }
__device__ __forceinline__ float bf2f(unsigned v) { return __uint_as_float(v << 16); }
__device__ __forceinline__ float bflo(unsigned w) { return __uint_as_float(w << 16); }
__device__ __forceinline__ float bfhi(unsigned w) { return __uint_as_float(w & 0xffff0000u); }
__device__ __forceinline__ float wave_sum(float v) {
#pragma unroll
    for (int o = 1; o < 64; o <<= 1) v += __shfl_xor(v, o);
    return v;
}
__device__ __forceinline__ float sigmoidf_(float x) { return __builtin_amdgcn_rcpf(1.0f + __expf(-x)); }
__device__ __forceinline__ float gelu_tanh(float y) { const float u = 0.7978845608028654f * (y + 0.044715f * y * y * y); return y * __builtin_amdgcn_rcpf(1.0f + __expf(-2.0f * u)); }
__device__ __forceinline__ float logsig(float z) { return fminf(z, 0.f) - __logf(1.0f + __expf(-fabsf(z))); }
#define LDS_WAIT() asm volatile("s_waitcnt lgkmcnt(0)" ::: "memory")

namespace pg8 {
struct EpiProj {
    static constexpr bool PERM = true, AFTER_DRAIN = false;
    bf16_t* O; float* FL; const float* bf;
    __device__ __forceinline__ void operator()(const f32x4 (&acc)[2][2][4][2], const Unit& u, int wr, int wc, int fr, int fq) const {
        const int row0 = u.pm * BM + wr * 64 + fr, col0 = u.pn * BM + wc * 32 + 8 * fq;
#pragma unroll
        for (int ai = 0; ai < 2; ++ai)
#pragma unroll
            for (int m = 0; m < 4; ++m) { bf16_t* rowp = O + (size_t)(row0 + ai * HALF + m * 16) * LDP + col0;
#pragma unroll
                for (int bj = 0; bj < 2; ++bj) { const f32x4 v0 = acc[ai][bj][m][0], v1 = acc[ai][bj][m][1];
                    u32x4 w; w.x = cvtpk(v0[0], v0[1]); w.y = cvtpk(v0[2], v0[3]); w.z = cvtpk(v1[0], v1[1]); w.w = cvtpk(v1[2], v1[3]);
                    *(u32x4*)(rowp + bj * HALF) = w; } }
        if (u.pn == 10 && wc == 0 && fq == 0) {
            float b6[6];
#pragma unroll
            for (int j = 0; j < 6; ++j) b6[j] = bf[j];
#pragma unroll
            for (int ai = 0; ai < 2; ++ai)
#pragma unroll
                for (int m = 0; m < 4; ++m) { float* fp = FL + (size_t)(row0 + ai * HALF + m * 16) * 8; const f32x4 v0 = acc[ai][0][m][0], v1 = acc[ai][0][m][1];
                    f32x4 o0, o1; o0[0] = logsig(v0[0] + b6[0]); o0[1] = logsig(v0[1] + b6[1]); o0[2] = logsig(v0[2] + b6[2]); o0[3] = logsig(v0[3] + b6[3]);
                    o1[0] = logsig(v1[0] + b6[4]); o1[1] = logsig(v1[1] + b6[5]); o1[2] = 0.f; o1[3] = 0.f;
                    *(f32x4*)fp = o0; *(f32x4*)(fp + 4) = o1; }
        }
    }
};
struct EpiSwiGLU {
    static constexpr bool PERM = true, AFTER_DRAIN = false;
    bf16_t* H;
    __device__ __forceinline__ void operator()(const f32x4 (&acc)[2][2][4][2], const Unit& u, int wr, int wc, int fr, int fq) const {
        const int row0 = u.pm * BM + wr * 64 + fr, col0 = u.pn * HALF + wc * 32 + 8 * fq;
#pragma unroll
        for (int ai = 0; ai < 2; ++ai)
#pragma unroll
            for (int m = 0; m < 4; ++m) { bf16_t* rowp = H + (size_t)(row0 + ai * HALF + m * 16) * DFF + col0;
                float h[8];
#pragma unroll
                for (int n = 0; n < 2; ++n)
#pragma unroll
                    for (int i = 0; i < 4; ++i) { const float g = acc[ai][0][m][n][i], up = acc[ai][1][m][n][i]; h[n * 4 + i] = g * sigmoidf_(g) * up; }
                u32x4 w; w.x = cvtpk(h[0], h[1]); w.y = cvtpk(h[2], h[3]); w.z = cvtpk(h[4], h[5]); w.w = cvtpk(h[6], h[7]);
                *(u32x4*)rowp = w; }
    }
};
struct EpiGLU {
    static constexpr bool PERM = true, AFTER_DRAIN = false;
    const bf16_t* G; bf16_t* O; const float* bg;
    __device__ __forceinline__ void operator()(const f32x4 (&acc)[2][2][4][2], const Unit& u, int wr, int wc, int fr, int fq) const {
        const int row0 = u.pm * BM + wr * 64 + fr, col0 = wc * 32 + 8 * fq;
#pragma unroll
        for (int bj = 0; bj < 2; ++bj) {
#pragma unroll
            for (int ai = 0; ai < 2; ++ai)
#pragma unroll
                for (int m = 0; m < 4; ++m) { const size_t off = (size_t)(row0 + ai * HALF + m * 16) * 256 + col0 + bj * HALF;
                    const f32x4 b0 = *(const f32x4*)(bg + col0 + bj * HALF), b1 = *(const f32x4*)(bg + col0 + bj * HALF + 4);
                    const u32x4 gw = *(const u32x4*)(G + off); const f32x4 v0 = acc[ai][bj][m][0] + b0, v1 = acc[ai][bj][m][1] + b1;
                    u32x4 w; w.x = cvtpk(bflo(gw.x) * sigmoidf_(v0[0]), bfhi(gw.x) * sigmoidf_(v0[1])); w.y = cvtpk(bflo(gw.y) * sigmoidf_(v0[2]), bfhi(gw.y) * sigmoidf_(v0[3]));
                    w.z = cvtpk(bflo(gw.z) * sigmoidf_(v1[0]), bfhi(gw.z) * sigmoidf_(v1[1])); w.w = cvtpk(bflo(gw.w) * sigmoidf_(v1[2]), bfhi(gw.w) * sigmoidf_(v1[3]));
                    *(u32x4*)(O + off) = w; asm volatile("" ::: "memory"); } }
    }
};
struct EpiGLUNorm {
    static constexpr bool PERM = true, AFTER_DRAIN = true;
    const bf16_t* G; bf16_t* MIX; const float* bg; const float* gm;
    __device__ __forceinline__ void fused(f32x4 (&acc)[2][2][4][2], const Unit& u, int wr, int wc, int fr, int fq, PG8_LAS unsigned char* lds, int wid, int lane) const {
        PG8_LAS float* Pss = (PG8_LAS float*)lds;
        const int row0 = u.pm * BM + wr * 64 + fr, col0 = wc * 32 + 8 * fq;
#pragma unroll
        for (int bj = 0; bj < 2; ++bj) { const f32x4 b0 = *(const f32x4*)(bg + col0 + bj * HALF), b1 = *(const f32x4*)(bg + col0 + bj * HALF + 4);
#pragma unroll
            for (int ai = 0; ai < 2; ++ai)
#pragma unroll
                for (int m = 0; m < 4; ++m) { const size_t off = (size_t)(row0 + ai * HALF + m * 16) * 256 + col0 + bj * HALF;
                    const u32x4 gw = *(const u32x4*)(G + off); const f32x4 v0 = acc[ai][bj][m][0] + b0, v1 = acc[ai][bj][m][1] + b1;
                    acc[ai][bj][m][0] = (f32x4){bflo(gw.x) * sigmoidf_(v0[0]), bfhi(gw.x) * sigmoidf_(v0[1]), bflo(gw.y) * sigmoidf_(v0[2]), bfhi(gw.y) * sigmoidf_(v0[3])};
                    acc[ai][bj][m][1] = (f32x4){bflo(gw.z) * sigmoidf_(v1[0]), bfhi(gw.z) * sigmoidf_(v1[1]), bflo(gw.w) * sigmoidf_(v1[2]), bfhi(gw.w) * sigmoidf_(v1[3])};
                    asm volatile("" ::: "memory"); } }
#pragma unroll
        for (int ai = 0; ai < 2; ++ai)
#pragma unroll
            for (int m = 0; m < 4; ++m) { float ss = 0.f;
#pragma unroll
                for (int bj = 0; bj < 2; ++bj)
#pragma unroll
                    for (int n = 0; n < 2; ++n) { const f32x4 x = acc[ai][bj][m][n]; ss += (x[0] * x[0] + x[1] * x[1]) + (x[2] * x[2] + x[3] * x[3]); }
                ss += __shfl_xor(ss, 16); ss += __shfl_xor(ss, 32);
                if (fq == 0) Pss[(ai * HALF + wr * 64 + m * 16 + fr) * 4 + wc] = ss; }
        asm volatile("s_waitcnt lgkmcnt(0)" ::: "memory"); __builtin_amdgcn_s_barrier(); asm volatile("" ::: "memory");
#pragma unroll
        for (int ai = 0; ai < 2; ++ai)
#pragma unroll
            for (int m = 0; m < 4; ++m) { const f32x4 q = *(const PG8_LAS f32x4*)(Pss + (ai * HALF + wr * 64 + m * 16 + fr) * 4);
                const float rs = 1.0f / sqrtf(((q[0] + q[1]) + (q[2] + q[3])) * (1.0f / 256.0f) + 1e-6f);
#pragma unroll
                for (int bj = 0; bj < 2; ++bj) { const f32x4 g0 = *(const f32x4*)(gm + col0 + bj * HALF), g1 = *(const f32x4*)(gm + col0 + bj * HALF + 4);
                    const f32x4 o0 = acc[ai][bj][m][0] * rs * g0, o1 = acc[ai][bj][m][1] * rs * g1;
                    u32x4 w; w.x = cvtpk(o0[0], o0[1]); w.y = cvtpk(o0[2], o0[3]); w.z = cvtpk(o1[0], o1[1]); w.w = cvtpk(o1[2], o1[3]);
                    *(u32x4*)(MIX + (size_t)(row0 + ai * HALF + m * 16) * 1024 + col0 + bj * HALF) = w; } }
        asm volatile("s_waitcnt lgkmcnt(0)" ::: "memory"); __builtin_amdgcn_s_barrier(); asm volatile("" ::: "memory");
    }
};
}
#define XB_TMO      128
#define XB_XCNT(j)  (256  + 64 * (j))
#define XB_XSUB(j)  (1280 + 64 * (j))
#define XB_XGEN(j)  (2304 + 64 * (j))
#define XB_TOP      3328
#define XB_TOPGEN   3392
#define XCD_BAR_WORDS 3456
#define XB_SPIN_CAP (1u << 18)

__device__ __forceinline__ unsigned xb_ld(unsigned* p)              { return __hip_atomic_load(p, __ATOMIC_RELAXED, __HIP_MEMORY_SCOPE_AGENT); }
__device__ __forceinline__ unsigned xb_add(unsigned* p, unsigned v) { return __hip_atomic_fetch_add(p, v, __ATOMIC_RELAXED, __HIP_MEMORY_SCOPE_AGENT); }
__device__ __forceinline__ unsigned xb_xcc_id() { return (unsigned)__builtin_amdgcn_s_getreg((3 << 11) | 20) & 0xFu; }
#define XB_SPIN(cond, bar) do { unsigned _sp = 0; while (cond) { __builtin_amdgcn_s_sleep(1); \
    if ((++_sp & 255u) == 0u) { if (xb_ld(&(bar)[XB_TMO])) break; if (_sp > XB_SPIN_CAP) { atomicAdd(&(bar)[XB_TMO], 1u); break; } } } } while (0)

struct XcdBarrier {
    unsigned* bar; unsigned x;
    volatile LAS unsigned* st;
};

__device__ __forceinline__ XcdBarrier xcd_barrier_post(unsigned* bar, volatile LAS unsigned* st, const int tid) {
    XcdBarrier b; b.bar = bar; b.x = xb_xcc_id(); b.st = st;
    if (tid == 0) (void)xb_add(&bar[XB_XCNT(b.x)], 1u);
    return b;
}
__device__ __forceinline__ void xcd_barrier_complete(unsigned* bar, unsigned x, unsigned& nloc, unsigned& nx) {
    const unsigned G = gridDim.x * gridDim.y * gridDim.z;
    unsigned sum, cnt, mine, sp = 0u;
    for (;;) {
        sum = 0u; cnt = 0u; mine = 0u;
#pragma unroll
        for (unsigned j = 0; j < 16; ++j) { const unsigned c = xb_ld(&bar[XB_XCNT(j)]); sum += c; cnt += (c > 0u) ? 1u : 0u; mine = (j == x) ? c : mine; }
        if (sum == G) break;
        __builtin_amdgcn_s_sleep(1);
        if ((++sp & 255u) == 0u) { if (xb_ld(&bar[XB_TMO])) break; if (sp > XB_SPIN_CAP) { atomicAdd(&bar[XB_TMO], 1u); break; } }
    }
    nloc = mine > 0u ? mine : 1u; nx = cnt > 0u ? cnt : 1u;
}

__device__ __forceinline__ void xcd_barrier(const XcdBarrier& b, const int tid) {
    asm volatile("s_waitcnt vmcnt(0)" ::: "memory");
    __syncthreads();
    if (tid == 0) {
        unsigned* bar = b.bar;
        __builtin_amdgcn_s_waitcnt(0);
        unsigned nloc = b.st[0], nx = b.st[1];
        if (nloc == 0u) { xcd_barrier_complete(bar, b.x, nloc, nx); b.st[0] = nloc; b.st[1] = nx; }
        const unsigned old = xb_add(&bar[XB_XSUB(b.x)], 1u);
        const unsigned gen = old / nloc;
        if (old + 1u == (gen + 1u) * nloc) {
            __builtin_amdgcn_fence(__ATOMIC_RELEASE, "agent");
            asm volatile("s_waitcnt vmcnt(0)" ::: "memory");
            const unsigned og = xb_add(&bar[XB_TOP], 1u);
            const unsigned tg = og / nx;
            if (og + 1u == (tg + 1u) * nx) xb_add(&bar[XB_TOPGEN], 1u);
            else XB_SPIN(xb_ld(&bar[XB_TOPGEN]) == tg, bar);
            __builtin_amdgcn_fence(__ATOMIC_ACQUIRE, "agent");
            xb_add(&bar[XB_XGEN(b.x)], 1u);
            asm volatile("s_waitcnt vmcnt(0)" ::: "memory");
        } else {
            XB_SPIN(xb_ld(&bar[XB_XGEN(b.x)]) == gen, bar);
            __builtin_amdgcn_fence(__ATOMIC_ACQUIRE, "agent");
            asm volatile("s_waitcnt vmcnt(0)" ::: "memory");
        }
    }
    __syncthreads();
}
__device__ __forceinline__ void tr_item(const float* W, int K, int N, bf16_t* WT, int k0, int n0, int drow0, LAS float* scr, int lane) {
    const int n = n0 + (lane & 31);
#pragma unroll 8
    for (int i = 0; i < 32; ++i) { const int kk = 2 * i + (lane >> 5); scr[kk * 33 + (lane & 31)] = (n < N) ? W[(size_t)(k0 + kk) * N + n] : 0.f; }
    LDS_WAIT(); __builtin_amdgcn_wave_barrier();
    const int c = lane & 7;
#pragma unroll
    for (int j = 0; j < 4; ++j) { const int nn = (lane >> 3) + 8 * j; const LAS float* s = scr + (8 * c) * 33 + nn;
        u32x4 o; o.x = cvtpk(s[0 * 33], s[1 * 33]); o.y = cvtpk(s[2 * 33], s[3 * 33]); o.z = cvtpk(s[4 * 33], s[5 * 33]); o.w = cvtpk(s[6 * 33], s[7 * 33]);
        *(u32x4*)(WT + (size_t)(drow0 + nn) * K + k0 + 8 * c) = o; }
    LDS_WAIT(); __builtin_amdgcn_wave_barrier();
}
__device__ __forceinline__ void sincos_rr(float x, float& s, float& c) {
    const float q = rintf(x * 0.6366197723675814f);
    float r = fmaf(-q, 1.57079637050628662109375f, x); r = fmaf(-q, -4.37113900018624283e-8f, r);
    const float r2 = r * r;
    const float sp = r + r * r2 * (-1.6666654611e-1f + r2 * (8.3321608736e-3f + r2 * (-1.9515295891e-4f)));
    const float cp = 1.0f - 0.5f * r2 + r2 * r2 * (4.166664568298827e-2f + r2 * (-1.388731625493765e-3f + r2 * 2.443315711809948e-5f));
    const int n = ((int)q) & 3;
    s = (n == 0) ? sp : (n == 1) ? cp : (n == 2) ? -sp : -cp;
    c = (n == 0) ? cp : (n == 1) ? -sp : (n == 2) ? -cp : sp;
}
struct RowIn { f32x4 x[4]; u32x2 xb[4]; u32x2 y[4]; float rinv; };
template <bool HAS_Y, int XIN> __device__ __forceinline__ void row_load(RowIn& r, const void* xin, const float* rn, size_t m, const bf16_t* y, int lane) {
#pragma unroll
    for (int j = 0; j < 4; ++j) {
        if (XIN != 0) r.xb[j] = *(const GAS u32x2*)((const GAS bf16_t*)xin + m * 1024 + 4 * lane + 256 * j); else r.x[j] = *(const GAS f32x4*)((const GAS float*)xin + m * 1024 + 4 * lane + 256 * j);
        if (HAS_Y) r.y[j] = *(const GAS u32x2*)((const GAS bf16_t*)y + m * 1024 + 4 * lane + 256 * j); }
    if (XIN == 2) r.rinv = ((const GAS float*)rn)[m];
}
template <bool HAS_Y, int XIN, int XOUT> __device__ __forceinline__ void row_compute(const RowIn& r, const f32x4 (&gi)[4], const f32x4 (&gp)[4], void* xout, float* rn, size_t m, const f32x4 (&gq)[4], bf16_t* xn, int lane) {
    f32x4 xv[4];
#pragma unroll
    for (int j = 0; j < 4; ++j) { if (XIN != 0) { const u32x2 w = r.xb[j]; xv[j] = (f32x4){bflo(w.x), bfhi(w.x), bflo(w.y), bfhi(w.y)}; if (XIN == 2) xv[j] = xv[j] * r.rinv * gi[j]; } else xv[j] = r.x[j]; }
    if (HAS_Y) {
        f32x4 yv[4]; float ss = 0.f;
#pragma unroll
        for (int j = 0; j < 4; ++j) { const u32x2 w = r.y[j]; yv[j] = (f32x4){bflo(w.x), bfhi(w.x), bflo(w.y), bfhi(w.y)};
            ss += (yv[j][0] * yv[j][0] + yv[j][1] * yv[j][1]) + (yv[j][2] * yv[j][2] + yv[j][3] * yv[j][3]); }
        const float ry = 1.0f / sqrtf(wave_sum(ss) * (1.0f / 1024.0f) + EPS);
#pragma unroll
        for (int j = 0; j < 4; ++j) { xv[j] = xv[j] + yv[j] * ry * gp[j];
            if (XOUT == 1) { u32x2 w; w.x = cvtpk(xv[j][0], xv[j][1]); w.y = cvtpk(xv[j][2], xv[j][3]); *(GAS u32x2*)((GAS bf16_t*)xout + m * 1024 + 4 * lane + 256 * j) = w; }
            if (XOUT == 0) *(GAS f32x4*)((GAS float*)xout + m * 1024 + 4 * lane + 256 * j) = xv[j]; }
    }
    if (xn) {
        float ss = 0.f;
#pragma unroll
        for (int j = 0; j < 4; ++j) ss += (xv[j][0] * xv[j][0] + xv[j][1] * xv[j][1]) + (xv[j][2] * xv[j][2] + xv[j][3] * xv[j][3]);
        const float ms = wave_sum(ss) * (1.0f / 1024.0f) + EPS, rx = 1.0f / sqrtf(ms);
        if (XOUT == 2 && lane == 0) ((GAS float*)rn)[m] = sqrtf(ms);
#pragma unroll
        for (int j = 0; j < 4; ++j) { const f32x4 o = xv[j] * rx * gq[j];
            u32x2 w; w.x = cvtpk(o[0], o[1]); w.y = cvtpk(o[2], o[3]); *(GAS u32x2*)((GAS bf16_t*)xn + m * 1024 + 4 * lane + 256 * j) = w; }
    }
}
template <bool HAS_Y, int XIN, int XOUT> __device__ __forceinline__ void row_phase(const void* xin, const float* gin, float* rn, const bf16_t* y, const float* gpost, void* xout, const float* gpre, bf16_t* xn, int gw, int NGW, int lane) {
    f32x4 gp[4], gq[4], gi[4];
#pragma unroll
    for (int j = 0; j < 4; ++j) { gp[j] = HAS_Y ? *(const GAS f32x4*)((const GAS float*)gpost + 4 * lane + 256 * j) : (f32x4){0.f, 0.f, 0.f, 0.f}; gq[j] = xn ? *(const GAS f32x4*)((const GAS float*)gpre + 4 * lane + 256 * j) : (f32x4){0.f, 0.f, 0.f, 0.f};
        if (XIN == 2) { const f32x4 g = *(const GAS f32x4*)((const GAS float*)gin + 4 * lane + 256 * j); gi[j] = (f32x4){1.0f / g[0], 1.0f / g[1], 1.0f / g[2], 1.0f / g[3]}; } else gi[j] = (f32x4){1.f, 1.f, 1.f, 1.f}; }
    RowIn cur, nxt, nx2;
    int m = gw;
    if (m < M) row_load<HAS_Y, XIN>(cur, xin, rn, (size_t)m, y, lane);
    if (m + NGW < M) row_load<HAS_Y, XIN>(nxt, xin, rn, (size_t)(m + NGW), y, lane);
    for (; m < M; m += NGW) {
        const int m2 = m + 2 * NGW;
        if (m2 < M) row_load<HAS_Y, XIN>(nx2, xin, rn, (size_t)m2, y, lane);
        row_compute<HAS_Y, XIN, XOUT>(cur, gi, gp, xout, rn, (size_t)m, gq, xn, lane);
        cur = nxt; nxt = nx2;
    }
}

constexpr int XP = 132, HP = 136, SSM_WAVE_LDS = 16 * XP * 4 + 16 * HP * 2;
__device__ __forceinline__ void ssm_wave(const bf16_t* PROJ_, const float* ABAR, const bf16_t* BB, const bf16_t* CC, const float* dsk, bf16_t* G_, LAS unsigned char* wl, int b, int g, int lane) {
    LAS float* XT = (LAS float*)wl; LAS bf16_t* HT = (LAS bf16_t*)(wl + 16 * XP * 4);
    const GAS bf16_t* PROJg = (const GAS bf16_t*)PROJ_; GAS bf16_t* Gg = (GAS bf16_t*)G_;
#define PROJ PROJg
#define G Gg
    const int c16 = lane & 15, q4 = lane >> 4;
    const float ar = ABAR[(g * 64 + lane) * 2], ai = ABAR[(g * 64 + lane) * 2 + 1];
    bf16x8 bfr[8], cfr[4]; const bf16x8 zero8 = {0, 0, 0, 0, 0, 0, 0, 0};
#pragma unroll
    for (int j = 0; j < 8; ++j) bfr[j] = (q4 < 2) ? *(const bf16x8*)(BB + ((size_t)g * 128 + 16 * j + c16) * 16 + 8 * q4) : zero8;
#pragma unroll
    for (int ks = 0; ks < 4; ++ks) cfr[ks] = *(const bf16x8*)(CC + ((size_t)g * 16 + c16) * 128 + 32 * ks + 8 * q4);
    const float dk = dsk[g * 16 + c16];
    float hr = 0.f, hi = 0.f;
    const size_t m0 = (size_t)b * SEQ;
    const GAS bf16_t* up = PROJ + (m0 + c16) * LDP + g * 16 + 8 * (q4 & 1);
    bf16x8 anext = *(const GAS bf16x8*)up;
    const GAS bf16_t* usk = PROJ + (m0 + 4 * q4) * LDP + g * 16 + c16;
    unsigned short un0 = usk[0], un1 = usk[LDP], un2 = usk[2 * LDP], un3 = usk[3 * LDP];
    for (int tile = 0; tile < SEQ / 16; ++tile) {
        const bf16x8 acur = (q4 < 2) ? anext : zero8;
        if (tile + 1 < SEQ / 16) anext = *(const GAS bf16x8*)(up + (size_t)(tile + 1) * 16 * LDP);
        const float uc[4] = {bf2f(un0), bf2f(un1), bf2f(un2), bf2f(un3)};
        if (tile + 1 < SEQ / 16) { const GAS bf16_t* q = usk + (size_t)(tile + 1) * 16 * LDP; un0 = q[0]; un1 = q[LDP]; un2 = q[2 * LDP]; un3 = q[3 * LDP]; }
f32x4 xa[8];
#pragma unroll
        for (int j = 0; j < 8; ++j) xa[j] = __builtin_amdgcn_mfma_f32_16x16x32_bf16(acur, bfr[j], (f32x4){0.f, 0.f, 0.f, 0.f}, 0, 0, 0);
        asm volatile("s_nop 15\n\ts_nop 15" : "+v"(xa[0]), "+v"(xa[1]), "+v"(xa[2]), "+v"(xa[3]), "+v"(xa[4]), "+v"(xa[5]), "+v"(xa[6]), "+v"(xa[7]));
#pragma unroll
        for (int j = 0; j < 8; ++j)
#pragma unroll
            for (int i = 0; i < 4; ++i) XT[(4 * q4 + i) * XP + 16 * j + c16] = xa[j][i];
        LDS_WAIT(); __builtin_amdgcn_wave_barrier();
#pragma unroll
        for (int t = 0; t < 16; ++t) { const float xr = XT[t * XP + lane], xi = XT[t * XP + 64 + lane];
            const float nr = fmaf(ar, hr, fmaf(-ai, hi, xr)), ni = fmaf(ar, hi, fmaf(ai, hr, xi)); hr = nr; hi = ni;
            *(LAS unsigned*)(HT + t * HP + 2 * lane) = cvtpk(hr, hi); }
        LDS_WAIT(); __builtin_amdgcn_wave_barrier();
        f32x4 ya = {0.f, 0.f, 0.f, 0.f};
#pragma unroll
        for (int ks = 0; ks < 4; ++ks) { const bf16x8 a = *(const LAS bf16x8*)(HT + c16 * HP + 32 * ks + 8 * q4); ya = __builtin_amdgcn_mfma_f32_16x16x32_bf16(a, cfr[ks], ya, 0, 0, 0); }
        asm volatile("s_nop 15\n\ts_nop 15" : "+v"(ya));
#pragma unroll
        for (int i = 0; i < 4; ++i) { const size_t mrow = m0 + tile * 16 + 4 * q4 + i; const float u = uc[i];
            const float yv = ya[i] + dk * u; G[mrow * 256 + g * 16 + c16] = (bf16_t)(cvtpk(gelu_tanh(yv), 0.f) & 0xffffu); }
        LDS_WAIT(); __builtin_amdgcn_wave_barrier();
    }
}

#undef PROJ
#undef G
constexpr int KP = 72;
struct AttnSt { f32x16 o0, o1; float m, l; };
__device__ __forceinline__ bf16x8 pack8(const f32x16& p, int s) { u32x4 w; w.x = cvtpk(p[8 * s + 0], p[8 * s + 1]); w.y = cvtpk(p[8 * s + 2], p[8 * s + 3]); w.z = cvtpk(p[8 * s + 4], p[8 * s + 5]); w.w = cvtpk(p[8 * s + 6], p[8 * s + 7]); return __builtin_bit_cast(bf16x8, w); }
typedef float f32x2_ __attribute__((ext_vector_type(2)));
template <bool BIAS>
__device__ __forceinline__ void attn_tile(AttnSt& st, const bf16x8 (&qf)[4], const LAS bf16_t* Ks, const LAS bf16_t* Vt, int r32, int hi,
                                          float cq, const LAS float* ck, int klo, int khi, int kbase, bool need_mask) {
    f32x16 p0, p1;
#pragma unroll
    for (int r = 0; r < 16; ++r) { p0[r] = 0.f; p1[r] = 0.f; }
#pragma unroll
    for (int ds = 0; ds < 4; ++ds) { const bf16x8 a0 = *(const LAS bf16x8*)(Ks + r32 * KP + ds * 16 + hi * 8), a1 = *(const LAS bf16x8*)(Ks + (32 + r32) * KP + ds * 16 + hi * 8);
        p0 = __builtin_amdgcn_mfma_f32_32x32x16_bf16(a0, qf[ds], p0, 0, 0, 0); p1 = __builtin_amdgcn_mfma_f32_32x32x16_bf16(a1, qf[ds], p1, 0, 0, 0); }
    if (BIAS) {
#pragma unroll
        for (int g = 0; g < 4; ++g) {
            const f32x4 c0 = *(const LAS f32x4*)(ck + 8 * g + 4 * hi), c1 = *(const LAS f32x4*)(ck + 32 + 8 * g + 4 * hi);
#pragma unroll
            for (int i = 0; i < 4; i += 2) { const int r = 4 * g + i;
                const f32x2_ a2 = (f32x2_){p0[r], p0[r + 1]} * QK_C + (f32x2_){c0[i], c0[i + 1]}, b2 = (f32x2_){p1[r], p1[r + 1]} * QK_C + (f32x2_){c1[i], c1[i + 1]};
                p0[r] = a2.x; p0[r + 1] = a2.y; p1[r] = b2.x; p1[r + 1] = b2.y; }
        }
    }
    if (need_mask) {
        const unsigned nml = (unsigned)(kbase + 4 * hi - klo), range = (unsigned)(khi - klo);
#pragma unroll
        for (int r = 0; r < 16; ++r) { const unsigned c = (unsigned)((r & 3) + 8 * (r >> 2));
            if (nml + c > range) p0[r] = -INFINITY;
            if (nml + (c + 32u) > range) p1[r] = -INFINITY; }
    }
#define MX3(a, b, c) __builtin_fmaxf(__builtin_fmaxf((a), (b)), (c))
    float rm;
    { float ma = MX3(p0[0], p0[1], p1[0]), mb = MX3(p0[2], p0[3], p1[1]); ma = MX3(ma, p1[2], p1[3]);
#pragma unroll
      for (int r = 4; r < 16; r += 4) { ma = MX3(ma, p0[r], p0[r + 1]); mb = MX3(mb, p0[r + 2], p0[r + 3]); ma = MX3(ma, p1[r], p1[r + 1]); mb = MX3(mb, p1[r + 2], p1[r + 3]); }
      rm = __builtin_fmaxf(ma, mb); }
#undef MX3
    rm = fmaxf(rm, __shfl_xor(rm, 32));
    const float mnew = fmaxf(st.m, rm);
    const float SC = BIAS ? 1.0f : QK_C;
    const float alpha = __builtin_amdgcn_exp2f((st.m - mnew) * SC), nm = -mnew * SC;
    st.m = mnew;
    f32x2_ sum2 = {0.f, 0.f};
#pragma unroll
    for (int r = 0; r < 16; r += 2) {
        const f32x2_ a2 = BIAS ? (f32x2_){p0[r], p0[r + 1]} + nm : (f32x2_){p0[r], p0[r + 1]} * QK_C + nm, b2 = BIAS ? (f32x2_){p1[r], p1[r + 1]} + nm : (f32x2_){p1[r], p1[r + 1]} * QK_C + nm;
        p0[r] = __builtin_amdgcn_exp2f(a2.x); p0[r + 1] = __builtin_amdgcn_exp2f(a2.y); p1[r] = __builtin_amdgcn_exp2f(b2.x); p1[r + 1] = __builtin_amdgcn_exp2f(b2.y);
        sum2 += (f32x2_){p0[r], p0[r + 1]} + (f32x2_){p1[r], p1[r + 1]}; }
    st.l = st.l * alpha + (sum2.x + sum2.y);
#pragma unroll
    for (int r = 0; r < 16; ++r) { st.o0[r] *= alpha; st.o1[r] *= alpha; }
    const int sw0 = ((r32 >> 3) & 7) << 3, sw1 = (((32 + r32) >> 3) & 7) << 3;
#pragma unroll
    for (int T = 0; T < 2; ++T)
#pragma unroll
        for (int s = 0; s < 2; ++s) { const bf16x8 pf = pack8(T == 0 ? p0 : p1, s); const int kvb = 32 * T + 16 * s + 4 * hi;
            { const u32x2 lo = *(const LAS u32x2*)(Vt + r32 * KP + (kvb ^ sw0)), hh = *(const LAS u32x2*)(Vt + r32 * KP + ((kvb + 8) ^ sw0));
              const u32x4 v = {lo.x, lo.y, hh.x, hh.y}; st.o0 = __builtin_amdgcn_mfma_f32_32x32x16_bf16(__builtin_bit_cast(bf16x8, v), pf, st.o0, 0, 0, 0); }
            { const u32x2 lo = *(const LAS u32x2*)(Vt + (32 + r32) * KP + (kvb ^ sw1)), hh = *(const LAS u32x2*)(Vt + (32 + r32) * KP + ((kvb + 8) ^ sw1));
              const u32x4 v = {lo.x, lo.y, hh.x, hh.y}; st.o1 = __builtin_amdgcn_mfma_f32_32x32x16_bf16(__builtin_bit_cast(bf16x8, v), pf, st.o1, 0, 0, 0); }
        }
}
__device__ __forceinline__ void attn_init(AttnSt& st) {
#pragma unroll
    for (int r = 0; r < 16; ++r) { st.o0[r] = 0.f; st.o1[r] = 0.f; }
    st.m = -1e30f; st.l = 0.f;
}
__device__ __forceinline__ void attn_store(const AttnSt& st, float inv, bf16_t* orow, int hi) {
#pragma unroll
    for (int g = 0; g < 4; ++g) {
        u32x2 w0, w1; w0.x = cvtpk(st.o0[4 * g] * inv, st.o0[4 * g + 1] * inv); w0.y = cvtpk(st.o0[4 * g + 2] * inv, st.o0[4 * g + 3] * inv);
        w1.x = cvtpk(st.o1[4 * g] * inv, st.o1[4 * g + 1] * inv); w1.y = cvtpk(st.o1[4 * g + 2] * inv, st.o1[4 * g + 3] * inv);
        *(u32x2*)(orow + 8 * g + 4 * hi) = w0; *(u32x2*)(orow + 32 + 8 * g + 4 * hi) = w1; }
}
__device__ __forceinline__ void stage_k(LAS bf16_t* Ks, int lrow, int lch, const u32x4& kreg) { *(LAS u32x4*)(Ks + lrow * KP + lch * 8) = kreg; }
__device__ __forceinline__ void stage_v2(LAS bf16_t* Vt, int rp, int c4, const u32x2& va, const u32x2& vb) {
    const int sw = ((c4 >> 1) & 7) << 3;
#pragma unroll
    for (int j = 0; j < 4; ++j) { const unsigned a = va[j >> 1], c = vb[j >> 1];
        const unsigned w = (j & 1) ? ((a >> 16) | (c & 0xffff0000u)) : ((a & 0xffffu) | (c << 16));
        *(LAS unsigned*)(Vt + (4 * c4 + j) * KP + ((2 * rp) ^ sw)) = w; }
}

__device__ __forceinline__ void fox_unit(const bf16_t* PROJ_, const float* FL_, bf16_t* FOXO_, LAS unsigned char* lds, int b, int h, int qb, int tid, int lane, int wave) {
    const GAS bf16_t* PROJ = (const GAS bf16_t*)PROJ_; const GAS float* FL = (const GAS float*)FL_; GAS bf16_t* FOXO = (GAS bf16_t*)FOXO_;
    LAS bf16_t* Ks = (LAS bf16_t*)lds; LAS bf16_t* Vt = (LAS bf16_t*)(lds + 9216); LAS float* cum = (LAS float*)(lds + 36864); LAS float* wtot = (LAS float*)(lds + 36864 + 8192);
    const int r32 = lane & 31, hi = lane >> 5;
    const int q1 = (qb + 1) * 256;
    __syncthreads();
    {
        float v[4]; const int s0 = 4 * tid;
#pragma unroll
        for (int i = 0; i < 4; ++i) v[i] = (s0 + i < q1) ? FL[((size_t)b * SEQ + s0 + i) * 8 + h] * LOG2E : 0.f;
        v[1] += v[0]; v[2] += v[1]; v[3] += v[2];
        const float tot = v[3]; float inc = tot;
#pragma unroll
        for (int off = 1; off < 64; off <<= 1) { const float t = __shfl_up(inc, off); if (lane >= off) inc += t; }
        if (lane == 63) wtot[wave] = inc;
        __syncthreads();
        float base = 0.f;
        for (int w = 0; w < wave; ++w) base += wtot[w];
        const float ex = base + inc - tot;
#pragma unroll
        for (int i = 0; i < 4; ++i) cum[s0 + i] = -(ex + v[i]);
    }
    __syncthreads();
    const int qrow0 = qb * 256 + wave * 32, qpos = qrow0 + r32;
    bf16x8 qf[4];
    { const GAS bf16_t* qp = PROJ + ((size_t)b * SEQ + qpos) * LDP + COL_FQ + h * 64 + hi * 8;
#pragma unroll
      for (int ds = 0; ds < 4; ++ds) qf[ds] = *(const GAS bf16x8*)(qp + ds * 16); }
    const float cq = 0.f;
    AttnSt st; attn_init(st);
    const int NT = q1 / 64, lrow = tid >> 3, lch = tid & 7, rp = tid >> 4, c4 = tid & 15;
    const GAS bf16_t* kg = PROJ + ((size_t)b * SEQ + lrow) * LDP + COL_FK + h * 64 + lch * 8;
    const GAS bf16_t* vg = PROJ + ((size_t)b * SEQ + 2 * rp) * LDP + COL_FV + h * 64 + c4 * 4;
    u32x4 kreg = *(const GAS u32x4*)kg; u32x2 va = *(const GAS u32x2*)vg, vb = *(const GAS u32x2*)(vg + LDP);
    stage_k(Ks, lrow, lch, kreg); stage_v2(Vt, rp, c4, va, vb);
    if (NT > 1) { kreg = *(const GAS u32x4*)(kg + (size_t)64 * LDP); va = *(const GAS u32x2*)(vg + (size_t)64 * LDP); vb = *(const GAS u32x2*)(vg + (size_t)65 * LDP); }
    __syncthreads();
    for (int kt = 0; kt < NT; ++kt) {
        LAS bf16_t* Kc = Ks + (kt & 1) * 9216; LAS bf16_t* Vc = Vt + (kt & 1) * 9216; LAS bf16_t* Kn = Ks + ((kt + 1) & 1) * 9216; LAS bf16_t* Vn = Vt + ((kt + 1) & 1) * 9216;
        if (kt + 1 < NT) { stage_k(Kn, lrow, lch, kreg); stage_v2(Vn, rp, c4, va, vb); }
        if (kt + 2 < NT) { kreg = *(const GAS u32x4*)(kg + (size_t)(kt + 2) * 64 * LDP); va = *(const GAS u32x2*)(vg + (size_t)(kt + 2) * 64 * LDP); vb = *(const GAS u32x2*)(vg + ((size_t)(kt + 2) * 64 + 1) * LDP); }
        if (kt * 64 <= qrow0 + 31) attn_tile<true>(st, qf, Kc, Vc, r32, hi, cq, cum + kt * 64, 0, qpos, kt * 64, kt * 64 + 63 > qrow0);
        __syncthreads();
    }
    const float l = st.l + __shfl_xor(st.l, 32);
    attn_store(st, 1.0f / l, (bf16_t*)(FOXO + ((size_t)b * SEQ + qpos) * 384 + h * 64), hi);
}

__device__ __forceinline__ void dsa_unit(const bf16_t* PROJ_, bf16_t* DSAO_, float* LSE_, LAS unsigned char* lds, int b, int hp, int pat, int res, int n, int tid, int lane, int wave) {
    const int job = wave >> 2, jw = wave & 3, h = 2 * hp + job, jt = tid & 255, r32 = lane & 31, hi = lane >> 5;
    const int d = (pat == 0) ? 1 : (pat == 1 ? 4 : 16);
    const GAS bf16_t* PROJ = (const GAS bf16_t*)PROJ_; GAS bf16_t* DSAO = (GAS bf16_t*)DSAO_; GAS float* LSE = (GAS float*)LSE_;
    LAS bf16_t* Ks = (LAS bf16_t*)(lds + job * 36864); LAS bf16_t* Vt = (LAS bf16_t*)(lds + job * 36864 + 9216);
    __syncthreads();
    const int qi = jw * 32 + r32;
    const size_t trow = (size_t)b * SEQ + (size_t)(n * 128 + qi) * d + res;
    bf16x8 qf[4];
    { const GAS bf16_t* qp = PROJ + trow * LDP + COL_DQ + h * 64 + hi * 8;
#pragma unroll
      for (int ds = 0; ds < 4; ++ds) qf[ds] = *(const GAS bf16x8*)(qp + ds * 16); }
    AttnSt st; attn_init(st);
    const int kt0 = (n == 0) ? 2 : 0, lch = jt & 7, lrow = jt >> 3, rp = jt >> 4, c4 = jt & 15;
    const GAS bf16_t* kbase = PROJ + ((size_t)b * SEQ + res) * LDP + COL_DK + h * 64 + lch * 8;
    const GAS bf16_t* vbase = PROJ + ((size_t)b * SEQ + res) * LDP + COL_DV + h * 64 + c4 * 4;
    const long rstep = (long)d * LDP;
    const long mk0 = (long)(n - 1) * 128 + lrow, mv0 = (long)(n - 1) * 128 + 2 * rp;
    u32x4 kreg0, kreg1; u32x2 va0, vb0, va1, vb1;
#define DSA_LOAD(kt_) do { const long o0 = (mk0 + 64 * (kt_)) * rstep, o1 = o0 + 32 * rstep, p0 = (mv0 + 64 * (kt_)) * rstep, p1 = p0 + 32 * rstep; \
        kreg0 = *(const GAS u32x4*)(kbase + o0); kreg1 = *(const GAS u32x4*)(kbase + o1); \
        va0 = *(const GAS u32x2*)(vbase + p0); vb0 = *(const GAS u32x2*)(vbase + p0 + rstep); va1 = *(const GAS u32x2*)(vbase + p1); vb1 = *(const GAS u32x2*)(vbase + p1 + rstep); } while (0)
#define DSA_STAGE(K_, V_) do { stage_k(K_, lrow, lch, kreg0); stage_k(K_, lrow + 32, lch, kreg1); stage_v2(V_, rp, c4, va0, vb0); stage_v2(V_, rp + 16, c4, va1, vb1); } while (0)
    DSA_LOAD(kt0);
    DSA_STAGE(Ks + (kt0 & 1) * 9216, Vt + (kt0 & 1) * 9216);
    DSA_LOAD(kt0 + 1);
    __syncthreads();
    const int q0 = jw * 32;
    for (int kt = kt0; kt < 4; ++kt) {
        LAS bf16_t* Kc = Ks + (kt & 1) * 9216; LAS bf16_t* Vc = Vt + (kt & 1) * 9216;
        if (kt + 1 < 4) DSA_STAGE(Ks + ((kt + 1) & 1) * 9216, Vt + ((kt + 1) & 1) * 9216);
        if (kt + 2 < 4) DSA_LOAD(kt + 2);
        const int k0 = 64 * kt;
        if (k0 + 63 >= q0 && k0 <= q0 + 31 + 128) {
            const bool allv = (k0 >= q0 + 31) && (k0 + 63 <= q0 + 128);
            attn_tile<false>(st, qf, Kc, Vc, r32, hi, 0.f, (const LAS float*)lds, qi, qi + 128, k0, !allv);
        }
        __syncthreads();
    }
#undef DSA_LOAD
#undef DSA_STAGE
    const float l = st.l + __shfl_xor(st.l, 32);
    attn_store(st, 1.0f / l, (bf16_t*)(DSAO + ((size_t)pat * M + trow) * 384 + h * 64), hi);
    if (hi == 0) LSE[((size_t)pat * M + trow) * 8 + h] = st.m * QK_C + __log2f(l);
}

__device__ __forceinline__ void merge_row(const bf16_t* SSMO, const bf16_t* DSAO, const float* LSE, const bf16_t* FOXO, const float* gm, bf16_t* OUT, size_t m, int lane) {
    float v[16];
    if (lane < 16) {
#pragma unroll
        for (int i = 0; i < 16; ++i) v[i] = 0.f;
    } else if (lane < 40) {
        const int c0 = 16 * lane - 256, h = c0 >> 6;
        const GAS float* LSEg = (const GAS float*)LSE; const float l0 = LSEg[(0 * (size_t)M + m) * 8 + h], l1 = LSEg[(1 * (size_t)M + m) * 8 + h], l2 = LSEg[(2 * (size_t)M + m) * 8 + h];
        const float mx = fmaxf(l0, fmaxf(l1, l2));
        float w0 = __builtin_amdgcn_exp2f(l0 - mx), w1 = __builtin_amdgcn_exp2f(l1 - mx), w2 = __builtin_amdgcn_exp2f(l2 - mx);
        const float inv = 1.0f / (w0 + w1 + w2); w0 *= inv; w1 *= inv; w2 *= inv;
#pragma unroll
        for (int i = 0; i < 16; ++i) v[i] = 0.f;
#pragma unroll
        for (int p = 0; p < 3; ++p) { const float w = (p == 0) ? w0 : (p == 1 ? w1 : w2); const GAS bf16_t* src = (const GAS bf16_t*)DSAO + ((size_t)p * M + m) * 384 + c0;
            const u32x4 a = *(const GAS u32x4*)src, c = *(const GAS u32x4*)(src + 8);
#pragma unroll
            for (int i = 0; i < 4; ++i) { v[2 * i] += w * bflo(a[i]); v[2 * i + 1] += w * bfhi(a[i]); v[8 + 2 * i] += w * bflo(c[i]); v[8 + 2 * i + 1] += w * bfhi(c[i]); } }
    } else {
        const int c0 = 16 * lane - 640;
        const u32x4 a = *(const GAS u32x4*)((const GAS bf16_t*)FOXO + m * 384 + c0), c = *(const GAS u32x4*)((const GAS bf16_t*)FOXO + m * 384 + c0 + 8);
#pragma unroll
        for (int i = 0; i < 4; ++i) { v[2 * i] = bflo(a[i]); v[2 * i + 1] = bfhi(a[i]); v[8 + 2 * i] = bflo(c[i]); v[8 + 2 * i + 1] = bfhi(c[i]); }
    }
    float ss = 0.f;
#pragma unroll
    for (int i = 0; i < 16; ++i) ss += v[i] * v[i];
    const int seg = (lane < 16) ? 0 : (lane < 40 ? 1 : 2);
    const float s0 = wave_sum(seg == 0 ? ss : 0.f), s1 = wave_sum(seg == 1 ? ss : 0.f), s2 = wave_sum(seg == 2 ? ss : 0.f);
    const float rs = (seg == 0) ? 1.0f / sqrtf(s0 * (1.0f / 256.0f) + EPS) : (seg == 1) ? 1.0f / sqrtf(s1 * (1.0f / 384.0f) + EPS) : 1.0f / sqrtf(s2 * (1.0f / 384.0f) + EPS);
    u32x4 o0, o1;
#pragma unroll
    for (int i = 0; i < 4; ++i) { const f32x4 g = *(const GAS f32x4*)((const GAS float*)gm + 16 * lane + 4 * i);
        const unsigned lo = cvtpk(v[4 * i] * rs * g[0], v[4 * i + 1] * rs * g[1]), hh = cvtpk(v[4 * i + 2] * rs * g[2], v[4 * i + 3] * rs * g[3]);
        if (i < 2) { o0[2 * i] = lo; o0[2 * i + 1] = hh; } else { o1[2 * (i - 2)] = lo; o1[2 * (i - 2) + 1] = hh; } }
    if (lane >= 16) { *(GAS u32x4*)((GAS bf16_t*)OUT + m * 1024 + 16 * lane) = o0; *(GAS u32x4*)((GAS bf16_t*)OUT + m * 1024 + 16 * lane + 8) = o1; }
}
template <int PH> __device__ __forceinline__ void run_phase(const Params& P, const int l, LAS unsigned char* lds, const int wave0, const int umax = 1 << 30) {
    constexpr size_t WS_PRM = 58 * MiB; constexpr int PRM_L = 8192, PR_GPOST = 0, PR_GPREF = 1024, PR_GPOSTF = 2048, PR_GMIX = 3072, PR_GPRE = 4096, PR_BGLU = 5120, PR_SD = 5376, PR_BF = 5632;
#define WSBASE() unsigned char* ws = P.ws; asm volatile("" : "+s"(ws)); float* const Pout = P.out; const float* const Px = P.in[I_X]; (void)Pout; (void)Px; int wave_s = wave0; asm volatile("" : "+s"(wave_s)); int lane_v; asm volatile("v_mbcnt_lo_u32_b32 %0, -1, 0\n\tv_mbcnt_hi_u32_b32 %0, -1, %0" : "=v"(lane_v)); const int tid = wave_s * 64 + lane_v; int bid = blockIdx.x; asm volatile("" : "+s"(bid)); int G = gridDim.x; asm volatile("" : "+s"(G)); const int lane = lane_v, wave = wave_s, gw = bid * 8 + wave, NGW = G * 8; (void)lane; (void)gw; (void)NGW
    if constexpr (PH == 0) {
    {
        WSBASE();
        bf16_t* WinT = (bf16_t*)(ws + WS_WIN); bf16_t* WoutT = (bf16_t*)(ws + WS_WOUT); bf16_t* WguT = (bf16_t*)(ws + WS_WGU); bf16_t* WdnT = (bf16_t*)(ws + WS_WDN); bf16_t* WgluT = (bf16_t*)(ws + WS_WGLU);
        float* ABAR = (float*)(ws + WS_ABAR); bf16_t* BB = (bf16_t*)(ws + WS_BB); bf16_t* CC = (bf16_t*)(ws + WS_CC); float* PRM = (float*)(ws + WS_PRM);
        LAS float* scr = (LAS float*)(lds + wave * 16384);
        constexpr int I_IN = 16 * 88, I_OUT = 16 * 32, I_GU = 16 * 176, I_DN = 44 * 32, I_GL = 4 * 8, I_ALL = I_IN + I_OUT + I_GU + I_DN + I_GL;
        for (int it = gw; it < 2 * I_ALL; it += NGW) {
            const int l = it / I_ALL; int r = it % I_ALL;
            if (r < I_IN) { const int kb = r / 88, nb = r % 88; tr_item(P.in[I_WIN] + (size_t)l * 1024 * NIN, 1024, NIN, WinT + (size_t)l * NINP * 1024, 64 * kb, 32 * nb, 32 * nb, scr, lane); continue; } r -= I_IN;
            if (r < I_OUT) { const int kb = r / 32, nb = r % 32; tr_item(P.in[I_WOUT] + (size_t)l * 1024 * 1024, 1024, 1024, WoutT + (size_t)l * 1024 * 1024, 64 * kb, 32 * nb, 32 * nb, scr, lane); continue; } r -= I_OUT;
            if (r < I_GU) { const int kb = r / 176, nb = r % 176, c0 = 32 * nb, half = (c0 >= DFF) ? 1 : 0, cc = c0 - half * DFF, dr = 256 * (cc / 128) + 128 * half + (cc % 128);
                tr_item(P.in[I_WGU] + (size_t)l * 1024 * NGU, 1024, NGU, WguT + (size_t)l * NGU * 1024, 64 * kb, c0, dr, scr, lane); continue; } r -= I_GU;
            if (r < I_DN) { const int kb = r / 32, nb = r % 32; tr_item(P.in[I_WDN] + (size_t)l * DFF * 1024, DFF, 1024, WdnT + (size_t)l * 1024 * DFF, 64 * kb, 32 * nb, 32 * nb, scr, lane); continue; } r -= I_DN;
            { const int kb = r / 8, nb = r % 8; tr_item(P.in[I_WGLU] + (size_t)l * 256 * 256, 256, 256, WgluT + (size_t)l * 256 * 256, 64 * kb, 32 * nb, 32 * nb, scr, lane); }
        }
        for (int e = bid * 512 + tid; e < 2 * 16 * 64; e += G * 512) {
            const int lg = e >> 6, p = e & 63;
            const float dt = expf(P.in[I_LDT][lg]), ar = P.in[I_ARE][e], ai = P.in[I_AIM][e];
            const float decay = expf(ar * dt); float sn, cs; sincos_rr(ai * dt, sn, cs);
            const float are = decay * cs, aim = decay * sn, mag2 = ar * ar + ai * ai;
            const float cre = ((are - 1.0f) * ar + aim * ai) / mag2, cim = (aim * ar - (are - 1.0f) * ai) / mag2;
            ABAR[2 * e] = are; ABAR[2 * e + 1] = aim;
            for (int c = 0; c < 16; ++c) { const float br = P.in[I_BRE][(size_t)e * 16 + c], bi = P.in[I_BIM][(size_t)e * 16 + c];
                BB[((size_t)lg * 128 + p) * 16 + c] = (bf16_t)(cvtpk(cre * br - cim * bi, 0.f) & 0xffffu);
                BB[((size_t)lg * 128 + 64 + p) * 16 + c] = (bf16_t)(cvtpk(cre * bi + cim * br, 0.f) & 0xffffu);
                *(unsigned*)(CC + ((size_t)lg * 16 + c) * 128 + 2 * p) = cvtpk(P.in[I_CRE][((size_t)lg * 16 + c) * 64 + p], -P.in[I_CIM][((size_t)lg * 16 + c) * 64 + p]); }
        }
        for (int e = bid * 512 + tid; e < 2 * 1024; e += G * 512) { const int l = e >> 10, c = e & 1023; float* pr = PRM + l * PRM_L;
            pr[PR_GPOST + c] = P.in[I_GPOST][e]; pr[PR_GPREF + c] = P.in[I_GPREF][e]; pr[PR_GPOSTF + c] = P.in[I_GPOSTF][e]; pr[PR_GMIX + c] = P.in[I_GMIX][e]; pr[PR_GPRE + c] = P.in[I_GPRE][e];
            if (c < 256) { pr[PR_BGLU + c] = P.in[I_BGLU][l * 256 + c]; pr[PR_SD + c] = P.in[I_SD][l * 256 + c]; }
            if (c < 8) pr[PR_BF + c] = (c < 6) ? P.in[I_BF][l * 6 + c] : 0.f; }
        row_phase<false, 0, 2>(Px, nullptr, (float*)(ws + 60 * MiB), (const bf16_t*)(ws + WS_BUFB), nullptr, nullptr, P.in[I_GPRE], (bf16_t*)(ws + WS_BUFA), gw, NGW, lane);
    }
    }
    if constexpr (PH == 1) {
        { WSBASE(); pg8::Gemm g{(bf16_t*)(ws + WS_BUFA), (bf16_t*)(ws + WS_WIN) + (size_t)l * NINP * 1024, M, NINP, 1024}; pg8::StaticOrder S; S.init(M, NINP, G, bid);
          pg8::EpiProj E{(bf16_t*)(ws + WS_PROJ), (float*)(ws + WS_FL), (const float*)(ws + WS_PRM) + l * PRM_L + PR_BF};
          pg8::gemm_phase<pg8::EpiProj, pg8::StaticOrder, true, true>(lds, g, S, E, wave); }
    }
    if constexpr (PH == 2) {
        {
            WSBASE();
            const bf16_t* PROJ = (const bf16_t*)(ws + WS_PROJ); float* FL = (float*)(ws + WS_FL);
            constexpr int NU_SSM = 64, NU_FOX = NB * 6 * 8, NU_DSA = NB * 3 * 48;
            unsigned* qctr = (unsigned*)(ws + WS_CTL) + 64 * l; LAS int* uq = (LAS int*)(lds + LDS_BYTES - 64);
#ifdef STATIC_Q
            (void)qctr; (void)uq;
            for (int u = bid; u < NU_SSM + NU_FOX + NU_DSA; u += G) {
#else
            for (;;) {
                __syncthreads();
                if (tid == 0) *uq = (int)__hip_atomic_fetch_add(qctr, 1u, __ATOMIC_RELAXED, __HIP_MEMORY_SCOPE_AGENT);
                __syncthreads();
                const int u = __builtin_amdgcn_readfirstlane(*uq);
                if (u >= NU_SSM + NU_FOX + NU_DSA || u >= umax) break;
#endif
                if (u < NU_SSM) { const int wu = u * 8 + wave;
                    ssm_wave(PROJ, (const float*)(ws + WS_ABAR) + (size_t)l * 16 * 64 * 2, (const bf16_t*)(ws + WS_BB) + (size_t)l * 16 * 128 * 16, (const bf16_t*)(ws + WS_CC) + (size_t)l * 16 * 16 * 128,
                             (const float*)(ws + WS_PRM) + l * PRM_L + PR_SD, (bf16_t*)(ws + WS_G), lds + wave * SSM_WAVE_LDS, wu >> 4, wu & 15, lane);
                } else if (u < NU_SSM + NU_FOX) { const int v = u - NU_SSM, qb = 7 - v / 192, bh = v % 192;
                    fox_unit(PROJ, FL, (bf16_t*)(ws + WS_FOXO), lds, bh / 6, bh % 6, qb, tid, lane, wave);
                } else { const int v = u - NU_SSM - NU_FOX, b = v / 144, rem = v % 144, hp = rem / 48, j = rem % 48, pat = j >> 4, jj = j & 15;
                    const int res = (pat == 0) ? 0 : (pat == 1 ? (jj & 3) : jj), n = (pat == 0) ? jj : (pat == 1 ? (jj >> 2) : 0);
                    dsa_unit(PROJ, (bf16_t*)(ws + WS_DSAO), (float*)(ws + WS_LSE), lds, b, hp, pat, res, n, tid, lane, wave);
                }
            }
        }
    }
    if constexpr (PH == 3) {
        { WSBASE(); int kglu = 256; asm volatile("" : "+s"(kglu)); pg8::Gemm g{(bf16_t*)(ws + WS_G), (bf16_t*)(ws + WS_WGLU) + (size_t)l * 256 * 256, M, 256, kglu}; pg8::StaticOrder S; S.init(M, 256, G, bid);
          pg8::EpiGLUNorm E{(bf16_t*)(ws + WS_G), (bf16_t*)(ws + WS_PROJ), (const float*)(ws + WS_PRM) + l * PRM_L + PR_BGLU, (const float*)(ws + WS_PRM) + l * PRM_L + PR_GMIX};
          pg8::gemm_phase<pg8::EpiGLUNorm, pg8::StaticOrder, false, true>(lds, g, S, E, wave);
          bf16_t* d_ = (bf16_t*)(ws + WS_DSAO); float* e_ = (float*)(ws + WS_LSE); bf16_t* f_ = (bf16_t*)(ws + WS_FOXO); const float* g_ = (const float*)(ws + WS_PRM) + l * PRM_L + PR_GMIX; bf16_t* o_ = (bf16_t*)(ws + WS_PROJ);
          for (int m = gw; m < M; m += 4 * NGW) { merge_row(nullptr, d_, e_, f_, g_, o_, (size_t)m, lane); if (m + NGW < M) merge_row(nullptr, d_, e_, f_, g_, o_, (size_t)(m + NGW), lane); if (m + 2 * NGW < M) merge_row(nullptr, d_, e_, f_, g_, o_, (size_t)(m + 2 * NGW), lane); if (m + 3 * NGW < M) merge_row(nullptr, d_, e_, f_, g_, o_, (size_t)(m + 3 * NGW), lane); } }
    }
    if constexpr (PH == 4) {
    }
    if constexpr (PH == 5) {
        { WSBASE(); const bool second = (umax == 1);
          int kk = second ? DFF : 1024; asm volatile("" : "+s"(kk));
          const bf16_t* bt = second ? (const bf16_t*)(ws + WS_WDN) + (size_t)l * 1024 * DFF : (const bf16_t*)(ws + WS_WOUT) + (size_t)l * 1024 * 1024;
          pg8::Gemm g{(bf16_t*)(ws + WS_PROJ), bt, M, 1024, kk}; pg8::StaticOrder S; S.init(M, 1024, G, bid);
          pg8::EpiBf16<0> E{(bf16_t*)(ws + WS_BUFB), 1024, nullptr, 0, 0, 1.f};
          pg8::gemm_phase<pg8::EpiBf16<0>, pg8::StaticOrder, true, true>(lds, g, S, E, wave); }
    }
    if constexpr (PH == 6) {
        { WSBASE(); const float* xin = (l == 0) ? Px : Pout; const float* pr = (const float*)(ws + WS_PRM) + l * PRM_L;
          (void)xin; float* rn = (float*)(ws + 60 * MiB);
          row_phase<true, 2, 2>((const bf16_t*)(ws + WS_BUFA), pr + PR_GPRE, rn, (const bf16_t*)(ws + WS_BUFB), pr + PR_GPOST, nullptr, pr + PR_GPREF, (bf16_t*)(ws + WS_BUFA), gw, NGW, lane); }
    }
    if constexpr (PH == 7) {
        { WSBASE(); pg8::Gemm g{(bf16_t*)(ws + WS_BUFA), (bf16_t*)(ws + WS_WGU) + (size_t)l * NGU * 1024, M, NGU, 1024}; pg8::StaticOrder S; S.init(M, NGU, G, bid);
          pg8::EpiSwiGLU E{(bf16_t*)(ws + WS_PROJ)};
          pg8::gemm_phase<pg8::EpiSwiGLU, pg8::StaticOrder, true, true>(lds, g, S, E, wave); }
    }
    if constexpr (PH == 8) {
        { WSBASE(); pg8::Gemm g{(bf16_t*)(ws + WS_PROJ), (bf16_t*)(ws + WS_WDN) + (size_t)l * 1024 * DFF, M, 1024, DFF}; pg8::StaticOrder S; S.init(M, 1024, G, bid);
          pg8::EpiBf16<0> E{(bf16_t*)(ws + WS_BUFB), 1024, nullptr, 0, 0, 1.f};
          pg8::gemm_phase<pg8::EpiBf16<0>, pg8::StaticOrder, true, true>(lds, g, S, E, wave); }
    }
    if constexpr (PH == 9) {
        { WSBASE(); const float* pr = (const float*)(ws + WS_PRM);
          float* rn = (float*)(ws + 60 * MiB); const bf16_t* xnb = (const bf16_t*)(ws + WS_BUFA);
          if (l == 0) row_phase<true, 2, 2>(xnb, pr + l * PRM_L + PR_GPREF, rn, (const bf16_t*)(ws + WS_BUFB), pr + l * PRM_L + PR_GPOSTF, nullptr, pr + PRM_L + PR_GPRE, (bf16_t*)(ws + WS_BUFA), gw, NGW, lane);
          else row_phase<true, 2, 0>(xnb, pr + l * PRM_L + PR_GPREF, rn, (const bf16_t*)(ws + WS_BUFB), pr + l * PRM_L + PR_GPOSTF, Pout, pr + PRM_L + PR_GPRE, nullptr, gw, NGW, lane); }
    }
#undef WSBASE
}

template <int PH> __global__ void __launch_bounds__(512, 2) phase_k(Params P, int l) {
    extern __shared__ __attribute__((aligned(16))) unsigned char lds_raw[];
    const int wave0 = __builtin_amdgcn_readfirstlane(threadIdx.x >> 6);
    run_phase<PH>(P, l, (LAS unsigned char*)lds_raw, wave0);
}
#ifdef MEGA
__global__ void __launch_bounds__(512, 2) mega(Params P) {
    extern __shared__ __attribute__((aligned(16))) unsigned char lds_raw[];
    LAS unsigned char* lds = (LAS unsigned char*)lds_raw;
    const int wave0 = __builtin_amdgcn_readfirstlane(threadIdx.x >> 6);
    volatile LAS unsigned* bst = (volatile LAS unsigned*)(lds + LDS_BYTES - 32);
    if (threadIdx.x < 2) bst[threadIdx.x] = 0u;
    __syncthreads();
    unsigned* barw; { GAS unsigned char* wsg_ = (GAS unsigned char*)P.ws; barw = (unsigned*)(unsigned char*)(wsg_ + WS_CTL) + 4096; }
    XcdBarrier xb = xcd_barrier_post(barw, bst, (int)threadIdx.x);
#define GRIDBAR() do { int lane_b; asm volatile("v_mbcnt_lo_u32_b32 %0, -1, 0\n\tv_mbcnt_hi_u32_b32 %0, -1, %0" : "=v"(lane_b)); xcd_barrier(xb, wave0 * 64 + lane_b); } while (0)
    cg::this_grid().sync();
    run_phase<0>(P, 0, lds, wave0);
    GRIDBAR();
    const int tidz = (int)(blockIdx.x * 512 + threadIdx.x); (void)tidz;
#pragma unroll 1
    for (int hl = 0; hl < 4; ++hl) {
        const int l = hl >> 1, second = hl & 1;
        if (!second) {
            run_phase<1>(P, l, lds, wave0); GRIDBAR();
            run_phase<2>(P, l, lds, wave0); GRIDBAR();
            run_phase<3>(P, l, lds, wave0); GRIDBAR();
        } else {
            run_phase<7>(P, l, lds, wave0); GRIDBAR();
        }
        run_phase<5>(P, l, lds, wave0, second); GRIDBAR();
        if (!second) { run_phase<6>(P, l, lds, wave0); GRIDBAR(); }
        else { run_phase<9>(P, l, lds, wave0); if (hl != 3) GRIDBAR(); }
    }
#undef GRIDBAR
}
#endif


__global__ void dbg_copy(const bf16_t* src, float* out, int ld, int ncol, int planes = 1) {
    const size_t m = blockIdx.x;
    for (int c = threadIdx.x; c < 1024; c += blockDim.x) { float a = 0.f; for (int pl = 0; pl < planes; ++pl) for (int k = c; k < ncol; k += 1024) a += bf2f(src[((size_t)pl * M + m) * ld + k]); out[m * 1024 + c] = a; }
}
__global__ void dbg_prm(const unsigned char* ws, float* out) {
    const int i = blockIdx.x * blockDim.x + threadIdx.x;
    if (i < 4096) out[i] = ((const float*)(ws + WS_ABAR))[i];
    else if (i < 4096 + 65536) out[i] = bf2f(((const bf16_t*)(ws + WS_BB))[i - 4096]);
    else if (i < 4096 + 131072) out[i] = bf2f(((const bf16_t*)(ws + WS_CC))[i - 4096 - 65536]);
    else if (i < 4096 + 131072 + 16384) out[i] = ((const float*)(ws + 58 * MiB))[i - 4096 - 131072];
}
template <int PH> static void launch_phase(const Params& p, int l, int grid, hipStream_t stream) {
    static bool attr = false;
    if (!attr) { (void)hipFuncSetAttribute((const void*)phase_k<PH>, hipFuncAttributeMaxDynamicSharedMemorySize, LDS_BYTES); attr = true; }
    hipLaunchKernelGGL(phase_k<PH>, dim3(grid), dim3(512), LDS_BYTES, stream, p, l);
}
extern "C" void kernel_launch(void* const* d_in, const int* in_sizes, int n_in, void* d_out, int out_size, void* d_ws, size_t ws_size, hipStream_t stream) {
    static int grid = 0;
    if (grid == 0) {
        if (n_in != 21 || in_sizes[0] != M * DM || out_size != M * DM || ws_size < WS_END) { fprintf(stderr, "kernel_launch: unexpected shapes: n_in %d in0 %d out %d ws %zu\n", n_in, n_in > 0 ? in_sizes[0] : -1, out_size, ws_size); grid = -1; return; }
        int dev = 0, cus = 0, per_cu = 1;
        (void)hipGetDevice(&dev); (void)hipDeviceGetAttribute(&cus, hipDeviceAttributeMultiprocessorCount, dev);
#ifdef MEGA
        if (hipFuncSetAttribute((const void*)mega, hipFuncAttributeMaxDynamicSharedMemorySize, LDS_BYTES) != hipSuccess) { fprintf(stderr, "kernel_launch: hipFuncSetAttribute failed\n"); grid = -1; return; }
        if (hipOccupancyMaxActiveBlocksPerMultiprocessor(&per_cu, (const void*)mega, 512, LDS_BYTES) != hipSuccess || per_cu < 1) { fprintf(stderr, "kernel_launch: occupancy query says %d\n", per_cu); per_cu = 1; }
        (void)hipGetLastError();
#endif
        grid = cus * per_cu;
    }
    if (grid < 0) return;
    if (hipMemsetAsync((char*)d_ws + WS_CTL, 0, 65536, stream) != hipSuccess) { fprintf(stderr, "kernel_launch: memset failed\n"); return; }
    Params p{};
    for (int i = 0; i < 21; ++i) p.in[i] = (const float*)d_in[i];
    p.out = (float*)d_out; p.ws = (unsigned char*)d_ws;
#ifdef MEGA
    void* args[] = {&p};
    hipError_t e = hipLaunchCooperativeKernel((const void*)mega, dim3(grid), dim3(512), args, LDS_BYTES, stream);
    if (e != hipSuccess) fprintf(stderr, "kernel_launch: cooperative launch failed: %s (grid %d)\n", hipGetErrorString(e), grid);
#else
    launch_phase<0>(p, 0, grid, stream);
#if defined(DBG_STOP) && DBG_STOP == 100
    hipLaunchKernelGGL(dbg_prm, dim3(640), dim3(256), 0, stream, (const unsigned char*)d_ws, (float*)d_out); return;
#endif
    for (int l = 0; l < 2; ++l) {
#if defined(DBG_STOP) && DBG_STOP == 1
        launch_phase<1>(p, l, grid, stream); hipLaunchKernelGGL(dbg_copy, dim3(M), dim3(256), 0, stream, (const bf16_t*)((unsigned char*)d_ws + WS_PROJ), (float*)d_out, LDP, LDP); return;
#endif
#if defined(DBG_STOP) && DBG_STOP == 21
        launch_phase<1>(p, l, grid, stream); launch_phase<2>(p, l, grid, stream); hipLaunchKernelGGL(dbg_copy, dim3(M), dim3(256), 0, stream, (const bf16_t*)((unsigned char*)d_ws + WS_FOXO), (float*)d_out, 384, 384, 1); return;
#endif
#if defined(DBG_STOP) && DBG_STOP == 22
        launch_phase<1>(p, l, grid, stream); launch_phase<2>(p, l, grid, stream); hipLaunchKernelGGL(dbg_copy, dim3(M), dim3(256), 0, stream, (const bf16_t*)((unsigned char*)d_ws + WS_DSAO), (float*)d_out, 384, 384, 3); return;
#endif
#if defined(DBG_STOP) && DBG_STOP == 23
        launch_phase<1>(p, l, grid, stream); launch_phase<2>(p, l, grid, stream); hipLaunchKernelGGL(dbg_copy, dim3(M), dim3(256), 0, stream, (const bf16_t*)((unsigned char*)d_ws + WS_G), (float*)d_out, 256, 256, 1); return;
#endif
#if defined(DBG_STOP) && DBG_STOP == 4
        launch_phase<1>(p, l, grid, stream); launch_phase<2>(p, l, grid, stream); launch_phase<3>(p, l, grid, stream); launch_phase<4>(p, l, grid, stream);
        hipLaunchKernelGGL(dbg_copy, dim3(M), dim3(256), 0, stream, (const bf16_t*)((unsigned char*)d_ws + WS_BUFA), (float*)d_out, 1024, 1024); return;
#endif
        launch_phase<1>(p, l, grid, stream); launch_phase<2>(p, l, grid, stream); launch_phase<3>(p, l, grid, stream); launch_phase<4>(p, l, grid, stream); launch_phase<5>(p, l, grid, stream);
        launch_phase<6>(p, l, grid, stream); launch_phase<7>(p, l, grid, stream); launch_phase<8>(p, l, grid, stream); launch_phase<9>(p, l, grid, stream);
    }
#endif
}
```

```cpp
#define MEGA 1
#include <hip/hip_runtime.h>
#include <hip/hip_cooperative_groups.h>
#include <cstdio>
#include <cstdint>
namespace cg = cooperative_groups;
namespace pg8 {
#define PG8_LAS __attribute__((address_space(3)))
typedef unsigned short bf16_t;
typedef short bf16x8 __attribute__((ext_vector_type(8)));
typedef float f32x4 __attribute__((ext_vector_type(4)));
typedef unsigned u32x4 __attribute__((ext_vector_type(4)));
constexpr int BM = 256, BK = 64, HALF = 128, HTB = HALF * BK * 2  , STAGE_BYTES = 8 * HTB, NXCD = 8, WGM = 8;

__host__ __device__ __forceinline__ int lds_byte(int r, int c) { const int st = (r >> 4) * 2 + (c >> 5), rr = r & 15, cc = c & 31, ob = rr * 64 + cc * 2; return st * 1024 + (ob ^ (((ob >> 9) & 1) << 5)); }
__host__ __device__ __forceinline__ void stage_rc(int b, int& R, int& C) { const int st = b / 1024, sb = b % 1024, swz = sb ^ (((sb >> 9) & 1) << 5); R = (st >> 1) * 16 + swz / 64; C = (st & 1) * 32 + (swz % 64) / 2; }
__host__ __device__ __forceinline__ int perm32(int rho) { const int n = rho >> 4, i = rho & 15; return 8 * (i >> 2) + 4 * n + (i & 3); }

struct Unit { int pm, pn; };
struct Gemm { const bf16_t* A; const bf16_t* Bt; int M, N, K; };

struct StaticOrder {
    int nM, nN, nwg, G, c;
    __host__ __device__ void init(int M, int N, int G_, int c_) { nM = M / BM; nN = N / BM; nwg = nM * nN; G = G_; c = c_; }
    __host__ __device__ bool next(int i, Unit& u) const {
        const long L = (long)i * G + c; if (L >= nwg) return false;
        int wgid = (int)L; { const int q = nwg / NXCD, r = nwg % NXCD, xcd = wgid % NXCD, off = wgid / NXCD; wgid = (xcd < r ? xcd * (q + 1) : r * (q + 1) + (xcd - r) * q) + off; }
        const int nig = WGM * nN, gid = wgid / nig, fm = gid * WGM, gsz = (nM - fm) < WGM ? (nM - fm) : WGM;
        u.pm = fm + ((wgid % nig) % gsz); u.pn = (wgid % nig) / gsz; return true;
    }
    __device__ __forceinline__ void a_ready(const Unit&) const {}
    __device__ __forceinline__ void done(const Unit&) const {}
};

__device__ __forceinline__ unsigned cvt_pk_bf16(float lo, float hi) { unsigned r; asm volatile("v_cvt_pk_bf16_f32 %0, %1, %2" : "=v"(r) : "v"(lo), "v"(hi)); return r; }
typedef float f32x2 __attribute__((ext_vector_type(2)));
__device__ __forceinline__ f32x2 gelu_pk(f32x2 v) {
    const f32x2 av = __builtin_elementwise_abs(v), d = av * 0.2316418882f + 1.0f;
    f32x2 t; t.x = __builtin_amdgcn_rcpf(d.x); t.y = __builtin_amdgcn_rcpf(d.y);
    f32x2 q = t * 0.5307027145f + (-0.7265760135f); q = q * t + 0.7107068705f; q = q * t + (-0.142248368f); q = q * t + 0.127414796f; q = q * t;
    const f32x2 s = (v * v) * (-0.72134752044f);
    f32x2 e; e.x = __builtin_amdgcn_exp2f(s.x); e.y = __builtin_amdgcn_exp2f(s.y);
    const f32x2 m = v * (q * e), r = v - m;
    f32x2 o; o.x = v.x < 0.f ? m.x : r.x; o.y = v.y < 0.f ? m.y : r.y; return o;
}

template <int ACT  > struct EpiBf16 {
    static constexpr bool PERM = true, AFTER_DRAIN = false; static_assert(ACT == 0 || ACT == 1, "EpiBf16: ACT is 0 (none) or 1 (gelu_pk)");
    bf16_t* O; int ldc; const float* bias; int split_cols; size_t split_stride; float scale0;
    __device__ __forceinline__ void operator()(const f32x4 (&acc)[2][2][4][2], const Unit& u, int wr, int wc, int fr, int fq) const {
        const int row0 = u.pm * BM + wr * 64 + fr; int colt = u.pn * BM; bf16_t* base = O;
        float sc = 1.f; if (split_cols) { const int t = colt / split_cols; base += (size_t)t * split_stride; colt -= t * split_cols; if (t == 0) sc = scale0; }
        const int col0 = colt + wc * 32 + 8 * fq, bcol0 = u.pn * BM + wc * 32 + 8 * fq;
        f32x4 bv[2][2];
#pragma unroll
        for (int bj = 0; bj < 2; ++bj)
#pragma unroll
            for (int n = 0; n < 2; ++n) bv[bj][n] = bias ? *(const f32x4*)(bias + bcol0 + bj * HALF + 4 * n) : (f32x4){0.f, 0.f, 0.f, 0.f};
#pragma unroll
        for (int ai = 0; ai < 2; ++ai)
#pragma unroll
            for (int m = 0; m < 4; ++m) { bf16_t* rowp = base + (size_t)(row0 + ai * HALF + m * 16) * ldc + col0;
#pragma unroll
                for (int bj = 0; bj < 2; ++bj) { f32x4 v0 = acc[ai][bj][m][0] + bv[bj][0], v1 = acc[ai][bj][m][1] + bv[bj][1];
                    if (ACT == 1) { f32x2 a = gelu_pk((f32x2){v0[0], v0[1]}), b = gelu_pk((f32x2){v0[2], v0[3]}), c = gelu_pk((f32x2){v1[0], v1[1]}), d = gelu_pk((f32x2){v1[2], v1[3]});
                        v0 = (f32x4){a.x, a.y, b.x, b.y}; v1 = (f32x4){c.x, c.y, d.x, d.y}; }
                    v0 = v0 * sc; v1 = v1 * sc; u32x4 w; w.x = cvt_pk_bf16(v0[0], v0[1]); w.y = cvt_pk_bf16(v0[2], v0[3]); w.z = cvt_pk_bf16(v1[0], v1[1]); w.w = cvt_pk_bf16(v1[2], v1[3]);
                    *(u32x4*)(rowp + bj * HALF) = w; } }
    }
};
template <class Epi, class Sched, bool ALIGN_EPI = false, bool SP2 = false>
__device__ __forceinline__ void gemm_phase(PG8_LAS unsigned char* lds, const Gemm g, const Sched& S, const Epi& E, const int wave_in) {
    int lane_l; asm volatile("v_mbcnt_lo_u32_b32 %0, -1, 0\n\tv_mbcnt_hi_u32_b32 %0, -1, %0" : "=v"(lane_l));
    const int wid = wave_in, lane = lane_l, tid = wid * 64 + lane, wr = wid >> 2, wc = wid & 3, fr = lane & 15, fq = lane >> 4;
    const int K = g.K, nt = K / BK;
    unsigned voffA[2], voffB[2];
#pragma unroll
    for (int i = 0; i < 2; ++i) { int R, C; stage_rc(tid * 16 + i * 8192, R, C); const int Rb = Epi::PERM ? ((R & ~31) + perm32(R & 31)) : R;
        voffA[i] = (unsigned)(R * K + C) * 2u; voffB[i] = (unsigned)(Rb * K + C) * 2u; }
    const size_t kstep = (size_t)(BK * 2);
    const size_t hstep = (size_t)HALF * K * 2;
    const size_t tstep = 2 * hstep;
    const unsigned ldsw = (unsigned)wid * 1024u;
    const int aoff = lds_byte(wr * 64 + fr, fq * 8), boff = lds_byte(wc * 32 + fr, fq * 8);
#define PG8_SA(b, h) (((b) * 2 + (h)) * HTB)
#define PG8_SB(b, h) ((4 + (b) * 2 + (h)) * HTB)
#define PG8_STAGE(bufoff, gbase, voff) do { _Pragma("unroll") for (int _i = 0; _i < 2; ++_i) \
        __builtin_amdgcn_global_load_lds((const unsigned*)((const char*)(gbase) + (voff)[_i]), (PG8_LAS unsigned*)(lds + (bufoff) + ldsw + _i * 8192), 16, 0, 0); } while (0)
#define PG8_LDA(dst, b, h) do { _Pragma("unroll") for (int m = 0; m < 4; ++m) _Pragma("unroll") for (int k = 0; k < 2; ++k) dst[m][k] = *(const PG8_LAS bf16x8*)(lds + PG8_SA(b, h) + aoff + m * 2048 + k * 1024); } while (0)
#define PG8_LDB(dst, b, h) do { _Pragma("unroll") for (int n = 0; n < 2; ++n) _Pragma("unroll") for (int k = 0; k < 2; ++k) dst[n][k] = *(const PG8_LAS bf16x8*)(lds + PG8_SB(b, h) + boff + n * 2048 + k * 1024); } while (0)
#define PG8_MMA(ai, bj, At, Bt) do { __builtin_amdgcn_s_setprio(1); _Pragma("unroll") for (int m = 0; m < 4; ++m) _Pragma("unroll") for (int n = 0; n < 2; ++n) _Pragma("unroll") for (int k = 0; k < 2; ++k) \
        acc[ai][bj][m][n] = __builtin_amdgcn_mfma_f32_16x16x32_bf16(Bt[n][k], At[m][k], acc[ai][bj][m][n], 0, 0, 0); __builtin_amdgcn_s_setprio(0); } while (0)
#define PG8_WAIT_V(n) asm volatile("s_waitcnt vmcnt(" #n ")" ::: "memory")
#define PG8_WAIT_L(n) asm volatile("s_waitcnt lgkmcnt(" #n ")" ::: "memory")
#define PG8_BAR __builtin_amdgcn_s_barrier()
#define PG8_SCHED __builtin_amdgcn_sched_barrier(0)
    Unit cur, nxt; int ui = 0;
    if (!S.next(0, cur)) return;
    f32x4 acc[2][2][4][2];
#pragma unroll
    for (int a = 0; a < 2; ++a)
#pragma unroll
        for (int b = 0; b < 2; ++b)
#pragma unroll
            for (int m = 0; m < 4; ++m)
#pragma unroll
                for (int n = 0; n < 2; ++n) acc[a][b][m][n] = (f32x4){0.f, 0.f, 0.f, 0.f};
    bf16x8 At[4][2], B0[2][2], B1[2][2];
    const char* cA = (const char*)g.A + (size_t)cur.pm * tstep; const char* cB = (const char*)g.Bt + (size_t)cur.pn * tstep;
    S.a_ready(cur);
    if constexpr (SP2) {
        PG8_STAGE(PG8_SB(0, 0), cB, voffB); PG8_STAGE(PG8_SB(0, 1), cB + hstep, voffB); PG8_STAGE(PG8_SA(0, 0), cA, voffA); PG8_STAGE(PG8_SA(0, 1), cA + hstep, voffA);
        if (wr == 1) PG8_BAR;
        PG8_WAIT_V(2); PG8_BAR;
        PG8_STAGE(PG8_SB(1, 0), cB + kstep, voffB); PG8_STAGE(PG8_SA(1, 0), cA + kstep, voffA); PG8_STAGE(PG8_SB(1, 1), cB + hstep + kstep, voffB);
        PG8_WAIT_V(6); PG8_BAR;
    } else {
        PG8_STAGE(PG8_SB(0, 0), cB, voffB); PG8_STAGE(PG8_SA(0, 0), cA, voffA); PG8_STAGE(PG8_SB(0, 1), cB + hstep, voffB); PG8_STAGE(PG8_SA(0, 1), cA + hstep, voffA);
        if (wr == 1) PG8_BAR;
        PG8_WAIT_V(4); PG8_BAR;
        PG8_STAGE(PG8_SB(1, 0), cB + kstep, voffB); PG8_STAGE(PG8_SA(1, 0), cA + kstep, voffA); PG8_STAGE(PG8_SB(1, 1), cB + hstep + kstep, voffB);
        PG8_WAIT_V(6); PG8_BAR;
    }
    for (;;) {
        const bool has_next = S.next(ui + 1, nxt);
        const char* nA = has_next ? (const char*)g.A + (size_t)nxt.pm * tstep : cA; const char* nB = has_next ? (const char*)g.Bt + (size_t)nxt.pn * tstep : cB;
        for (int t = 0; t < nt; t += 2) {
            const bool last = (t == nt - 2);
            const char* a1 = cA + (size_t)(t + 1) * kstep;
            const char* a2 = last ? nA : cA + (size_t)(t + 2) * kstep; const char* b2 = last ? nB : cB + (size_t)(t + 2) * kstep;
            const char* a3 = a2 + kstep; const char* b3 = b2 + kstep;
            if (last && has_next) S.a_ready(nxt);
            if constexpr (SP2) {
            PG8_LDB(B0, 0, 0); PG8_LDB(B1, 0, 1); PG8_SCHED; PG8_LDA(At, 0, 0); PG8_STAGE(PG8_SA(1, 1), a1 + hstep, voffA);
            PG8_WAIT_V(8); PG8_WAIT_L(0); PG8_BAR; PG8_MMA(0, 0, At, B0); PG8_MMA(0, 1, At, B1); PG8_BAR; PG8_SCHED;
            PG8_LDA(At, 0, 1); PG8_STAGE(PG8_SB(0, 0), b2, voffB); PG8_STAGE(PG8_SB(0, 1), b2 + hstep, voffB); PG8_STAGE(PG8_SA(0, 0), a2, voffA);
            PG8_WAIT_V(8); PG8_WAIT_L(0); PG8_BAR; PG8_MMA(1, 0, At, B0); PG8_MMA(1, 1, At, B1); PG8_BAR; PG8_SCHED;
            PG8_LDB(B0, 1, 0); PG8_LDB(B1, 1, 1); PG8_SCHED; PG8_LDA(At, 1, 0); PG8_STAGE(PG8_SA(0, 1), a2 + hstep, voffA);
            PG8_WAIT_V(8); PG8_WAIT_L(0); PG8_BAR; PG8_MMA(0, 0, At, B0); PG8_MMA(0, 1, At, B1); PG8_BAR; PG8_SCHED;
            PG8_LDA(At, 1, 1); PG8_STAGE(PG8_SB(1, 0), b3, voffB); PG8_STAGE(PG8_SB(1, 1), b3 + hstep, voffB); PG8_STAGE(PG8_SA(1, 0), a3, voffA);
            PG8_WAIT_V(8); PG8_WAIT_L(0); PG8_BAR; PG8_MMA(1, 0, At, B0); PG8_MMA(1, 1, At, B1); PG8_BAR; PG8_SCHED;
            } else {
            PG8_LDB(B0, 0, 0); PG8_SCHED; PG8_LDA(At, 0, 0); PG8_STAGE(PG8_SA(1, 1), a1 + hstep, voffA);
            PG8_WAIT_L(8); PG8_BAR; PG8_WAIT_L(0); PG8_MMA(0, 0, At, B0); PG8_BAR; PG8_SCHED;
            PG8_LDB(B1, 0, 1); PG8_STAGE(PG8_SB(0, 0), b2, voffB);
            PG8_BAR; PG8_WAIT_L(0); PG8_MMA(0, 1, At, B1); PG8_BAR;
            PG8_LDA(At, 0, 1); PG8_STAGE(PG8_SA(0, 0), a2, voffA);
            PG8_BAR; PG8_WAIT_L(0); PG8_MMA(1, 0, At, B0); PG8_BAR; PG8_SCHED;
            PG8_STAGE(PG8_SB(0, 1), b2 + hstep, voffB);
            PG8_WAIT_V(6); PG8_BAR; PG8_MMA(1, 1, At, B1); PG8_BAR;
            PG8_LDB(B0, 1, 0); PG8_SCHED; PG8_LDA(At, 1, 0); PG8_STAGE(PG8_SA(0, 1), a2 + hstep, voffA);
            PG8_WAIT_L(8); PG8_BAR; PG8_WAIT_L(0); PG8_MMA(0, 0, At, B0); PG8_BAR; PG8_SCHED;
            PG8_LDB(B1, 1, 1); PG8_STAGE(PG8_SB(1, 0), b3, voffB);
            PG8_BAR; PG8_WAIT_L(0); PG8_MMA(0, 1, At, B1); PG8_BAR;
            PG8_LDA(At, 1, 1); PG8_STAGE(PG8_SA(1, 0), a3, voffA);
            PG8_BAR; PG8_WAIT_L(0); PG8_MMA(1, 0, At, B0); PG8_BAR; PG8_SCHED;
            PG8_STAGE(PG8_SB(1, 1), b3 + hstep, voffB);
            PG8_WAIT_V(6); PG8_BAR; PG8_MMA(1, 1, At, B1); PG8_BAR;
            }
        }
        if constexpr (ALIGN_EPI) { if (wr == 0) PG8_BAR; }
        if constexpr (!Epi::AFTER_DRAIN) { E(acc, cur, wr, wc, fr, fq); S.done(cur); }
        if (!has_next) break;
#pragma unroll
        for (int a = 0; a < 2; ++a)
#pragma unroll
            for (int b = 0; b < 2; ++b)
#pragma unroll
                for (int m = 0; m < 4; ++m)
#pragma unroll
                    for (int n = 0; n < 2; ++n) acc[a][b][m][n] = (f32x4){0.f, 0.f, 0.f, 0.f};
        cur = nxt; cA = nA; cB = nB; ++ui;
        if constexpr (ALIGN_EPI) { if (wr == 1) PG8_BAR; }
    }
    PG8_WAIT_V(0);
    if constexpr (!ALIGN_EPI) { if (wr == 0) PG8_BAR; }
    PG8_BAR;
    if constexpr (Epi::AFTER_DRAIN) { E.fused(acc, cur, wr, wc, fr, fq, lds, wid, lane); S.done(cur); }
#undef PG8_SA
#undef PG8_SB
#undef PG8_STAGE
#undef PG8_LDA
#undef PG8_LDB
#undef PG8_MMA
#undef PG8_WAIT_V
#undef PG8_WAIT_L
#undef PG8_BAR
#undef PG8_SCHED
}
}
#define LAS __attribute__((address_space(3)))
#define GAS __attribute__((address_space(1)))
typedef unsigned short bf16_t;
typedef short bf16x8 __attribute__((ext_vector_type(8)));
typedef float f32x4 __attribute__((ext_vector_type(4)));
typedef float f32x16 __attribute__((ext_vector_type(16)));
typedef unsigned u32x4 __attribute__((ext_vector_type(4)));
typedef unsigned u32x2 __attribute__((ext_vector_type(2)));
constexpr int NB = 32, SEQ = 2048, DM = 1024, M = NB * SEQ;
constexpr int NIN = 2566, NINP = 2816, DFF = 2816, NGU = 5632, LDP = 2816;
constexpr int COL_DQ = 256, COL_DK = 640, COL_DV = 1024, COL_FQ = 1408, COL_FK = 1792, COL_FV = 2176;
constexpr float EPS = 1e-6f, LOG2E = 1.4426950408889634f, QK_C = 0.125f * 1.4426950408889634f;
constexpr size_t MiB = (size_t)1 << 20;
constexpr size_t WS_WIN = 0, WS_WOUT = 11 * MiB, WS_WGU = 15 * MiB, WS_WDN = 37 * MiB, WS_WGLU = 48 * MiB;
constexpr size_t WS_ABAR = 49 * MiB, WS_BB = 49 * MiB + 65536, WS_CC = 49 * MiB + 262144, WS_FL = 50 * MiB, WS_LSE = 52 * MiB;
constexpr size_t WS_BUFA = 64 * MiB, WS_BUFB = 192 * MiB, WS_PROJ = 320 * MiB, WS_DSAO = 672 * MiB, WS_FOXO = 816 * MiB, WS_G = 864 * MiB, WS_SSMO = 896 * MiB, WS_END = 928 * MiB;
constexpr int LDS_BYTES = 147456;
constexpr size_t WS_CTL = 59 * MiB;

struct Params { const float* in[21]; float* out; unsigned char* ws; };
enum { I_X = 0, I_GPRE, I_WIN, I_BF, I_LDT, I_ARE, I_AIM, I_BRE, I_BIM, I_CRE, I_CIM, I_SD, I_WGLU, I_BGLU, I_GMIX, I_WOUT, I_GPOST, I_GPREF, I_WGU, I_WDN, I_GPOSTF };

__device__ __forceinline__ unsigned cvtpk(float lo, float hi) { typedef float f2 __attribute__((ext_vector_type(2))); typedef __bf16 b2 __attribute__((ext_vector_type(2))); f2 v = {lo, hi}; b2 b = __builtin_convertvector(v, b2); return __builtin_bit_cast(unsigned, b); }
__device__ __forceinline__ float bf2f(unsigned v) { return __uint_as_float(v << 16); }
__device__ __forceinline__ float bflo(unsigned w) { return __uint_as_float(w << 16); }
__device__ __forceinline__ float bfhi(unsigned w) { return __uint_as_float(w & 0xffff0000u); }
__device__ __forceinline__ float wave_sum(float v) {
#pragma unroll
    for (int o = 1; o < 64; o <<= 1) v += __shfl_xor(v, o);
    return v;
}
__device__ __forceinline__ float sigmoidf_(float x) { return __builtin_amdgcn_rcpf(1.0f + __expf(-x)); }
__device__ __forceinline__ float gelu_tanh(float y) { const float u = 0.7978845608028654f * (y + 0.044715f * y * y * y); return y * __builtin_amdgcn_rcpf(1.0f + __expf(-2.0f * u)); }
__device__ __forceinline__ float logsig(float z) { return fminf(z, 0.f) - __logf(1.0f + __expf(-fabsf(z))); }
#define LDS_WAIT() asm volatile("s_waitcnt lgkmcnt(0)" ::: "memory")

namespace pg8 {
struct EpiProj {
    static constexpr bool PERM = true, AFTER_DRAIN = false;
    bf16_t* O; float* FL; const float* bf;
    __device__ __forceinline__ void operator()(const f32x4 (&acc)[2][2][4][2], const Unit& u, int wr, int wc, int fr, int fq) const {
        const int row0 = u.pm * BM + wr * 64 + fr, col0 = u.pn * BM + wc * 32 + 8 * fq;
#pragma unroll
        for (int ai = 0; ai < 2; ++ai)
#pragma unroll
            for (int m = 0; m < 4; ++m) { bf16_t* rowp = O + (size_t)(row0 + ai * HALF + m * 16) * LDP + col0;
#pragma unroll
                for (int bj = 0; bj < 2; ++bj) { const f32x4 v0 = acc[ai][bj][m][0], v1 = acc[ai][bj][m][1];
                    u32x4 w; w.x = cvtpk(v0[0], v0[1]); w.y = cvtpk(v0[2], v0[3]); w.z = cvtpk(v1[0], v1[1]); w.w = cvtpk(v1[2], v1[3]);
                    *(u32x4*)(rowp + bj * HALF) = w; } }
        if (u.pn == 10 && wc == 0 && fq == 0) {
            float b6[6];
#pragma unroll
            for (int j = 0; j < 6; ++j) b6[j] = bf[j];
#pragma unroll
            for (int ai = 0; ai < 2; ++ai)
#pragma unroll
                for (int m = 0; m < 4; ++m) { float* fp = FL + (size_t)(row0 + ai * HALF + m * 16) * 8; const f32x4 v0 = acc[ai][0][m][0], v1 = acc[ai][0][m][1];
                    f32x4 o0, o1; o0[0] = logsig(v0[0] + b6[0]); o0[1] = logsig(v0[1] + b6[1]); o0[2] = logsig(v0[2] + b6[2]); o0[3] = logsig(v0[3] + b6[3]);
                    o1[0] = logsig(v1[0] + b6[4]); o1[1] = logsig(v1[1] + b6[5]); o1[2] = 0.f; o1[3] = 0.f;
                    *(f32x4*)fp = o0; *(f32x4*)(fp + 4) = o1; }
        }
    }
};
struct EpiSwiGLU {
    static constexpr bool PERM = true, AFTER_DRAIN = false;
    bf16_t* H;
    __device__ __forceinline__ void operator()(const f32x4 (&acc)[2][2][4][2], const Unit& u, int wr, int wc, int fr, int fq) const {
        const int row0 = u.pm * BM + wr * 64 + fr, col0 = u.pn * HALF + wc * 32 + 8 * fq;
#pragma unroll
        for (int ai = 0; ai < 2; ++ai)
#pragma unroll
            for (int m = 0; m < 4; ++m) { bf16_t* rowp = H + (size_t)(row0 + ai * HALF + m * 16) * DFF + col0;
                float h[8];
#pragma unroll
                for (int n = 0; n < 2; ++n)
#pragma unroll
                    for (int i = 0; i < 4; ++i) { const float g = acc[ai][0][m][n][i], up = acc[ai][1][m][n][i]; h[n * 4 + i] = g * sigmoidf_(g) * up; }
                u32x4 w; w.x = cvtpk(h[0], h[1]); w.y = cvtpk(h[2], h[3]); w.z = cvtpk(h[4], h[5]); w.w = cvtpk(h[6], h[7]);
                *(u32x4*)rowp = w; }
    }
};
struct EpiGLU {
    static constexpr bool PERM = true, AFTER_DRAIN = false;
    const bf16_t* G; bf16_t* O; const float* bg;
    __device__ __forceinline__ void operator()(const f32x4 (&acc)[2][2][4][2], const Unit& u, int wr, int wc, int fr, int fq) const {
        const int row0 = u.pm * BM + wr * 64 + fr, col0 = wc * 32 + 8 * fq;
#pragma unroll
        for (int bj = 0; bj < 2; ++bj) {
#pragma unroll
            for (int ai = 0; ai < 2; ++ai)
#pragma unroll
                for (int m = 0; m < 4; ++m) { const size_t off = (size_t)(row0 + ai * HALF + m * 16) * 256 + col0 + bj * HALF;
                    const f32x4 b0 = *(const f32x4*)(bg + col0 + bj * HALF), b1 = *(const f32x4*)(bg + col0 + bj * HALF + 4);
                    const u32x4 gw = *(const u32x4*)(G + off); const f32x4 v0 = acc[ai][bj][m][0] + b0, v1 = acc[ai][bj][m][1] + b1;
                    u32x4 w; w.x = cvtpk(bflo(gw.x) * sigmoidf_(v0[0]), bfhi(gw.x) * sigmoidf_(v0[1])); w.y = cvtpk(bflo(gw.y) * sigmoidf_(v0[2]), bfhi(gw.y) * sigmoidf_(v0[3]));
                    w.z = cvtpk(bflo(gw.z) * sigmoidf_(v1[0]), bfhi(gw.z) * sigmoidf_(v1[1])); w.w = cvtpk(bflo(gw.w) * sigmoidf_(v1[2]), bfhi(gw.w) * sigmoidf_(v1[3]));
                    *(u32x4*)(O + off) = w; asm volatile("" ::: "memory"); } }
    }
};
struct EpiGLUNorm {
    static constexpr bool PERM = true, AFTER_DRAIN = true;
    const bf16_t* G; bf16_t* MIX; const float* bg; const float* gm;
    __device__ __forceinline__ void fused(f32x4 (&acc)[2][2][4][2], const Unit& u, int wr, int wc, int fr, int fq, PG8_LAS unsigned char* lds, int wid, int lane) const {
        PG8_LAS float* Pss = (PG8_LAS float*)lds;
        const int row0 = u.pm * BM + wr * 64 + fr, col0 = wc * 32 + 8 * fq;
#pragma unroll
        for (int bj = 0; bj < 2; ++bj) { const f32x4 b0 = *(const f32x4*)(bg + col0 + bj * HALF), b1 = *(const f32x4*)(bg + col0 + bj * HALF + 4);
#pragma unroll
            for (int ai = 0; ai < 2; ++ai)
#pragma unroll
                for (int m = 0; m < 4; ++m) { const size_t off = (size_t)(row0 + ai * HALF + m * 16) * 256 + col0 + bj * HALF;
                    const u32x4 gw = *(const u32x4*)(G + off); const f32x4 v0 = acc[ai][bj][m][0] + b0, v1 = acc[ai][bj][m][1] + b1;
                    acc[ai][bj][m][0] = (f32x4){bflo(gw.x) * sigmoidf_(v0[0]), bfhi(gw.x) * sigmoidf_(v0[1]), bflo(gw.y) * sigmoidf_(v0[2]), bfhi(gw.y) * sigmoidf_(v0[3])};
                    acc[ai][bj][m][1] = (f32x4){bflo(gw.z) * sigmoidf_(v1[0]), bfhi(gw.z) * sigmoidf_(v1[1]), bflo(gw.w) * sigmoidf_(v1[2]), bfhi(gw.w) * sigmoidf_(v1[3])};
                    asm volatile("" ::: "memory"); } }
#pragma unroll
        for (int ai = 0; ai < 2; ++ai)
#pragma unroll
            for (int m = 0; m < 4; ++m) { float ss = 0.f;
#pragma unroll
                for (int bj = 0; bj < 2; ++bj)
#pragma unroll
                    for (int n = 0; n < 2; ++n) { const f32x4 x = acc[ai][bj][m][n]; ss += (x[0] * x[0] + x[1] * x[1]) + (x[2] * x[2] + x[3] * x[3]); }
                ss += __shfl_xor(ss, 16); ss += __shfl_xor(ss, 32);
                if (fq == 0) Pss[(ai * HALF + wr * 64 + m * 16 + fr) * 4 + wc] = ss; }
        asm volatile("s_waitcnt lgkmcnt(0)" ::: "memory"); __builtin_amdgcn_s_barrier(); asm volatile("" ::: "memory");
#pragma unroll
        for (int ai = 0; ai < 2; ++ai)
#pragma unroll
            for (int m = 0; m < 4; ++m) { const f32x4 q = *(const PG8_LAS f32x4*)(Pss + (ai * HALF + wr * 64 + m * 16 + fr) * 4);
                const float rs = 1.0f / sqrtf(((q[0] + q[1]) + (q[2] + q[3])) * (1.0f / 256.0f) + 1e-6f);
#pragma unroll
                for (int bj = 0; bj < 2; ++bj) { const f32x4 g0 = *(const f32x4*)(gm + col0 + bj * HALF), g1 = *(const f32x4*)(gm + col0 + bj * HALF + 4);
                    const f32x4 o0 = acc[ai][bj][m][0] * rs * g0, o1 = acc[ai][bj][m][1] * rs * g1;
                    u32x4 w; w.x = cvtpk(o0[0], o0[1]); w.y = cvtpk(o0[2], o0[3]); w.z = cvtpk(o1[0], o1[1]); w.w = cvtpk(o1[2], o1[3]);
                    *(u32x4*)(MIX + (size_t)(row0 + ai * HALF + m * 16) * 1024 + col0 + bj * HALF) = w; } }
        asm volatile("s_waitcnt lgkmcnt(0)" ::: "memory"); __builtin_amdgcn_s_barrier(); asm volatile("" ::: "memory");
    }
};
}
#define XB_TMO      128
#define XB_XCNT(j)  (256  + 64 * (j))
#define XB_XSUB(j)  (1280 + 64 * (j))
#define XB_XGEN(j)  (2304 + 64 * (j))
#define XB_TOP      3328
#define XB_TOPGEN   3392
#define XCD_BAR_WORDS 3456
#define XB_SPIN_CAP (1u << 18)

__device__ __forceinline__ unsigned xb_ld(unsigned* p)              { return __hip_atomic_load(p, __ATOMIC_RELAXED, __HIP_MEMORY_SCOPE_AGENT); }
__device__ __forceinline__ unsigned xb_add(unsigned* p, unsigned v) { return __hip_atomic_fetch_add(p, v, __ATOMIC_RELAXED, __HIP_MEMORY_SCOPE_AGENT); }
__device__ __forceinline__ unsigned xb_xcc_id() { return (unsigned)__builtin_amdgcn_s_getreg((3 << 11) | 20) & 0xFu; }
#define XB_SPIN(cond, bar) do { unsigned _sp = 0; while (cond) { __builtin_amdgcn_s_sleep(1); \
    if ((++_sp & 255u) == 0u) { if (xb_ld(&(bar)[XB_TMO])) break; if (_sp > XB_SPIN_CAP) { atomicAdd(&(bar)[XB_TMO], 1u); break; } } } } while (0)

struct XcdBarrier {
    unsigned* bar; unsigned x;
    volatile LAS unsigned* st;
};

__device__ __forceinline__ XcdBarrier xcd_barrier_post(unsigned* bar, volatile LAS unsigned* st, const int tid) {
    XcdBarrier b; b.bar = bar; b.x = xb_xcc_id(); b.st = st;
    if (tid == 0) (void)xb_add(&bar[XB_XCNT(b.x)], 1u);
    return b;
}
__device__ __forceinline__ void xcd_barrier_complete(unsigned* bar, unsigned x, unsigned& nloc, unsigned& nx) {
    const unsigned G = gridDim.x * gridDim.y * gridDim.z;
    unsigned sum, cnt, mine, sp = 0u;
    for (;;) {
        sum = 0u; cnt = 0u; mine = 0u;
#pragma unroll
        for (unsigned j = 0; j < 16; ++j) { const unsigned c = xb_ld(&bar[XB_XCNT(j)]); sum += c; cnt += (c > 0u) ? 1u : 0u; mine = (j == x) ? c : mine; }
        if (sum == G) break;
        __builtin_amdgcn_s_sleep(1);
        if ((++sp & 255u) == 0u) { if (xb_ld(&bar[XB_TMO])) break; if (sp > XB_SPIN_CAP) { atomicAdd(&bar[XB_TMO], 1u); break; } }
    }
    nloc = mine > 0u ? mine : 1u; nx = cnt > 0u ? cnt : 1u;
}

__device__ __forceinline__ void xcd_barrier(const XcdBarrier& b, const int tid) {
    asm volatile("s_waitcnt vmcnt(0)" ::: "memory");
    __syncthreads();
    if (tid == 0) {
        unsigned* bar = b.bar;
        __builtin_amdgcn_s_waitcnt(0);
        unsigned nloc = b.st[0], nx = b.st[1];
        if (nloc == 0u) { xcd_barrier_complete(bar, b.x, nloc, nx); b.st[0] = nloc; b.st[1] = nx; }
        const unsigned old = xb_add(&bar[XB_XSUB(b.x)], 1u);
        const unsigned gen = old / nloc;
        if (old + 1u == (gen + 1u) * nloc) {
            __builtin_amdgcn_fence(__ATOMIC_RELEASE, "agent");
            asm volatile("s_waitcnt vmcnt(0)" ::: "memory");
            const unsigned og = xb_add(&bar[XB_TOP], 1u);
            const unsigned tg = og / nx;
            if (og + 1u == (tg + 1u) * nx) xb_add(&bar[XB_TOPGEN], 1u);
            else XB_SPIN(xb_ld(&bar[XB_TOPGEN]) == tg, bar);
            __builtin_amdgcn_fence(__ATOMIC_ACQUIRE, "agent");
            xb_add(&bar[XB_XGEN(b.x)], 1u);
            asm volatile("s_waitcnt vmcnt(0)" ::: "memory");
        } else {
            XB_SPIN(xb_ld(&bar[XB_XGEN(b.x)]) == gen, bar);
            __builtin_amdgcn_fence(__ATOMIC_ACQUIRE, "agent");
            asm volatile("s_waitcnt vmcnt(0)" ::: "memory");
        }
    }
    __syncthreads();
}
__device__ __forceinline__ void tr_item(const float* W, int K, int N, bf16_t* WT, int k0, int n0, int drow0, LAS float* scr, int lane) {
    const int n = n0 + (lane & 31);
#pragma unroll 8
    for (int i = 0; i < 32; ++i) { const int kk = 2 * i + (lane >> 5); scr[kk * 33 + (lane & 31)] = (n < N) ? W[(size_t)(k0 + kk) * N + n] : 0.f; }
    LDS_WAIT(); __builtin_amdgcn_wave_barrier();
    const int c = lane & 7;
#pragma unroll
    for (int j = 0; j < 4; ++j) { const int nn = (lane >> 3) + 8 * j; const LAS float* s = scr + (8 * c) * 33 + nn;
        u32x4 o; o.x = cvtpk(s[0 * 33], s[1 * 33]); o.y = cvtpk(s[2 * 33], s[3 * 33]); o.z = cvtpk(s[4 * 33], s[5 * 33]); o.w = cvtpk(s[6 * 33], s[7 * 33]);
        *(u32x4*)(WT + (size_t)(drow0 + nn) * K + k0 + 8 * c) = o; }
    LDS_WAIT(); __builtin_amdgcn_wave_barrier();
}
__device__ __forceinline__ void sincos_rr(float x, float& s, float& c) {
    const float q = rintf(x * 0.6366197723675814f);
    float r = fmaf(-q, 1.57079637050628662109375f, x); r = fmaf(-q, -4.37113900018624283e-8f, r);
    const float r2 = r * r;
    const float sp = r + r * r2 * (-1.6666654611e-1f + r2 * (8.3321608736e-3f + r2 * (-1.9515295891e-4f)));
    const float cp = 1.0f - 0.5f * r2 + r2 * r2 * (4.166664568298827e-2f + r2 * (-1.388731625493765e-3f + r2 * 2.443315711809948e-5f));
    const int n = ((int)q) & 3;
    s = (n == 0) ? sp : (n == 1) ? cp : (n == 2) ? -sp : -cp;
    c = (n == 0) ? cp : (n == 1) ? -sp : (n == 2) ? -cp : sp;
}
struct RowIn { f32x4 x[4]; u32x2 xb[4]; u32x2 y[4]; float rinv; };
template <bool HAS_Y, int XIN> __device__ __forceinline__ void row_load(RowIn& r, const void* xin, const float* rn, size_t m, const bf16_t* y, int lane) {
#pragma unroll
    for (int j = 0; j < 4; ++j) {
        if (XIN != 0) r.xb[j] = *(const GAS u32x2*)((const GAS bf16_t*)xin + m * 1024 + 4 * lane + 256 * j); else r.x[j] = *(const GAS f32x4*)((const GAS float*)xin + m * 1024 + 4 * lane + 256 * j);
        if (HAS_Y) r.y[j] = *(const GAS u32x2*)((const GAS bf16_t*)y + m * 1024 + 4 * lane + 256 * j); }
    if (XIN == 2) r.rinv = ((const GAS float*)rn)[m];
}
template <bool HAS_Y, int XIN, int XOUT> __device__ __forceinline__ void row_compute(const RowIn& r, const f32x4 (&gi)[4], const f32x4 (&gp)[4], void* xout, float* rn, size_t m, const f32x4 (&gq)[4], bf16_t* xn, int lane) {
    f32x4 xv[4];
#pragma unroll
    for (int j = 0; j < 4; ++j) { if (XIN != 0) { const u32x2 w = r.xb[j]; xv[j] = (f32x4){bflo(w.x), bfhi(w.x), bflo(w.y), bfhi(w.y)}; if (XIN == 2) xv[j] = xv[j] * r.rinv * gi[j]; } else xv[j] = r.x[j]; }
    if (HAS_Y) {
        f32x4 yv[4]; float ss = 0.f;
#pragma unroll
        for (int j = 0; j < 4; ++j) { const u32x2 w = r.y[j]; yv[j] = (f32x4){bflo(w.x), bfhi(w.x), bflo(w.y), bfhi(w.y)};
            ss += (yv[j][0] * yv[j][0] + yv[j][1] * yv[j][1]) + (yv[j][2] * yv[j][2] + yv[j][3] * yv[j][3]); }
        const float ry = 1.0f / sqrtf(wave_sum(ss) * (1.0f / 1024.0f) + EPS);
#pragma unroll
        for (int j = 0; j < 4; ++j) { xv[j] = xv[j] + yv[j] * ry * gp[j];
            if (XOUT == 1) { u32x2 w; w.x = cvtpk(xv[j][0], xv[j][1]); w.y = cvtpk(xv[j][2], xv[j][3]); *(GAS u32x2*)((GAS bf16_t*)xout + m * 1024 + 4 * lane + 256 * j) = w; }
            if (XOUT == 0) *(GAS f32x4*)((GAS float*)xout + m * 1024 + 4 * lane + 256 * j) = xv[j]; }
    }
    if (xn) {
        float ss = 0.f;
#pragma unroll
        for (int j = 0; j < 4; ++j) ss += (xv[j][0] * xv[j][0] + xv[j][1] * xv[j][1]) + (xv[j][2] * xv[j][2] + xv[j][3] * xv[j][3]);
        const float ms = wave_sum(ss) * (1.0f / 1024.0f) + EPS, rx = 1.0f / sqrtf(ms);
        if (XOUT == 2 && lane == 0) ((GAS float*)rn)[m] = sqrtf(ms);
#pragma unroll
        for (int j = 0; j < 4; ++j) { const f32x4 o = xv[j] * rx * gq[j];
            u32x2 w; w.x = cvtpk(o[0], o[1]); w.y = cvtpk(o[2], o[3]); *(GAS u32x2*)((GAS bf16_t*)xn + m * 1024 + 4 * lane + 256 * j) = w; }
    }
}
template <bool HAS_Y, int XIN, int XOUT> __device__ __forceinline__ void row_phase(const void* xin, const float* gin, float* rn, const bf16_t* y, const float* gpost, void* xout, const float* gpre, bf16_t* xn, int gw, int NGW, int lane) {
    f32x4 gp[4], gq[4], gi[4];
#pragma unroll
    for (int j = 0; j < 4; ++j) { gp[j] = HAS_Y ? *(const GAS f32x4*)((const GAS float*)gpost + 4 * lane + 256 * j) : (f32x4){0.f, 0.f, 0.f, 0.f}; gq[j] = xn ? *(const GAS f32x4*)((const GAS float*)gpre + 4 * lane + 256 * j) : (f32x4){0.f, 0.f, 0.f, 0.f};
        if (XIN == 2) { const f32x4 g = *(const GAS f32x4*)((const GAS float*)gin + 4 * lane + 256 * j); gi[j] = (f32x4){1.0f / g[0], 1.0f / g[1], 1.0f / g[2], 1.0f / g[3]}; } else gi[j] = (f32x4){1.f, 1.f, 1.f, 1.f}; }
    RowIn cur, nxt, nx2;
    int m = gw;
    if (m < M) row_load<HAS_Y, XIN>(cur, xin, rn, (size_t)m, y, lane);
    if (m + NGW < M) row_load<HAS_Y, XIN>(nxt, xin, rn, (size_t)(m + NGW), y, lane);
    for (; m < M; m += NGW) {
        const int m2 = m + 2 * NGW;
        if (m2 < M) row_load<HAS_Y, XIN>(nx2, xin, rn, (size_t)m2, y, lane);
        row_compute<HAS_Y, XIN, XOUT>(cur, gi, gp, xout, rn, (size_t)m, gq, xn, lane);
        cur = nxt; nxt = nx2;
    }
}

constexpr int XP = 132, HP = 136, SSM_WAVE_LDS = 16 * XP * 4 + 16 * HP * 2;
__device__ __forceinline__ void ssm_wave(const bf16_t* PROJ_, const float* ABAR, const bf16_t* BB, const bf16_t* CC, const float* dsk, bf16_t* G_, LAS unsigned char* wl, int b, int g, int lane) {
    LAS float* XT = (LAS float*)wl; LAS bf16_t* HT = (LAS bf16_t*)(wl + 16 * XP * 4);
    const GAS bf16_t* PROJg = (const GAS bf16_t*)PROJ_; GAS bf16_t* Gg = (GAS bf16_t*)G_;
#define PROJ PROJg
#define G Gg
    const int c16 = lane & 15, q4 = lane >> 4;
    const float ar = ABAR[(g * 64 + lane) * 2], ai = ABAR[(g * 64 + lane) * 2 + 1];
    bf16x8 bfr[8], cfr[4]; const bf16x8 zero8 = {0, 0, 0, 0, 0, 0, 0, 0};
#pragma unroll
    for (int j = 0; j < 8; ++j) bfr[j] = (q4 < 2) ? *(const bf16x8*)(BB + ((size_t)g * 128 + 16 * j + c16) * 16 + 8 * q4) : zero8;
#pragma unroll
    for (int ks = 0; ks < 4; ++ks) cfr[ks] = *(const bf16x8*)(CC + ((size_t)g * 16 + c16) * 128 + 32 * ks + 8 * q4);
    const float dk = dsk[g * 16 + c16];
    float hr = 0.f, hi = 0.f;
    const size_t m0 = (size_t)b * SEQ;
    const GAS bf16_t* up = PROJ + (m0 + c16) * LDP + g * 16 + 8 * (q4 & 1);
    bf16x8 anext = *(const GAS bf16x8*)up;
    const GAS bf16_t* usk = PROJ + (m0 + 4 * q4) * LDP + g * 16 + c16;
    unsigned short un0 = usk[0], un1 = usk[LDP], un2 = usk[2 * LDP], un3 = usk[3 * LDP];
    for (int tile = 0; tile < SEQ / 16; ++tile) {
        const bf16x8 acur = (q4 < 2) ? anext : zero8;
        if (tile + 1 < SEQ / 16) anext = *(const GAS bf16x8*)(up + (size_t)(tile + 1) * 16 * LDP);
        const float uc[4] = {bf2f(un0), bf2f(un1), bf2f(un2), bf2f(un3)};
        if (tile + 1 < SEQ / 16) { const GAS bf16_t* q = usk + (size_t)(tile + 1) * 16 * LDP; un0 = q[0]; un1 = q[LDP]; un2 = q[2 * LDP]; un3 = q[3 * LDP]; }
f32x4 xa[8];
#pragma unroll
        for (int j = 0; j < 8; ++j) xa[j] = __builtin_amdgcn_mfma_f32_16x16x32_bf16(acur, bfr[j], (f32x4){0.f, 0.f, 0.f, 0.f}, 0, 0, 0);
        asm volatile("s_nop 15\n\ts_nop 15" : "+v"(xa[0]), "+v"(xa[1]), "+v"(xa[2]), "+v"(xa[3]), "+v"(xa[4]), "+v"(xa[5]), "+v"(xa[6]), "+v"(xa[7]));
#pragma unroll
        for (int j = 0; j < 8; ++j)
#pragma unroll
            for (int i = 0; i < 4; ++i) XT[(4 * q4 + i) * XP + 16 * j + c16] = xa[j][i];
        LDS_WAIT(); __builtin_amdgcn_wave_barrier();
#pragma unroll
        for (int t = 0; t < 16; ++t) { const float xr = XT[t * XP + lane], xi = XT[t * XP + 64 + lane];
            const float nr = fmaf(ar, hr, fmaf(-ai, hi, xr)), ni = fmaf(ar, hi, fmaf(ai, hr, xi)); hr = nr; hi = ni;
            *(LAS unsigned*)(HT + t * HP + 2 * lane) = cvtpk(hr, hi); }
        LDS_WAIT(); __builtin_amdgcn_wave_barrier();
        f32x4 ya = {0.f, 0.f, 0.f, 0.f};
#pragma unroll
        for (int ks = 0; ks < 4; ++ks) { const bf16x8 a = *(const LAS bf16x8*)(HT + c16 * HP + 32 * ks + 8 * q4); ya = __builtin_amdgcn_mfma_f32_16x16x32_bf16(a, cfr[ks], ya, 0, 0, 0); }
        asm volatile("s_nop 15\n\ts_nop 15" : "+v"(ya));
#pragma unroll
        for (int i = 0; i < 4; ++i) { const size_t mrow = m0 + tile * 16 + 4 * q4 + i; const float u = uc[i];
            const float yv = ya[i] + dk * u; G[mrow * 256 + g * 16 + c16] = (bf16_t)(cvtpk(gelu_tanh(yv), 0.f) & 0xffffu); }
        LDS_WAIT(); __builtin_amdgcn_wave_barrier();
    }
}

#undef PROJ
#undef G
constexpr int KP = 72;
struct AttnSt { f32x16 o0, o1; float m, l; };
__device__ __forceinline__ bf16x8 pack8(const f32x16& p, int s) { u32x4 w; w.x = cvtpk(p[8 * s + 0], p[8 * s + 1]); w.y = cvtpk(p[8 * s + 2], p[8 * s + 3]); w.z = cvtpk(p[8 * s + 4], p[8 * s + 5]); w.w = cvtpk(p[8 * s + 6], p[8 * s + 7]); return __builtin_bit_cast(bf16x8, w); }
typedef float f32x2_ __attribute__((ext_vector_type(2)));
template <bool BIAS>
__device__ __forceinline__ void attn_tile(AttnSt& st, const bf16x8 (&qf)[4], const LAS bf16_t* Ks, const LAS bf16_t* Vt, int r32, int hi,
                                          float cq, const LAS float* ck, int klo, int khi, int kbase, bool need_mask) {
    f32x16 p0, p1;
#pragma unroll
    for (int r = 0; r < 16; ++r) { p0[r] = 0.f; p1[r] = 0.f; }
#pragma unroll
    for (int ds = 0; ds < 4; ++ds) { const bf16x8 a0 = *(const LAS bf16x8*)(Ks + r32 * KP + ds * 16 + hi * 8), a1 = *(const LAS bf16x8*)(Ks + (32 + r32) * KP + ds * 16 + hi * 8);
        p0 = __builtin_amdgcn_mfma_f32_32x32x16_bf16(a0, qf[ds], p0, 0, 0, 0); p1 = __builtin_amdgcn_mfma_f32_32x32x16_bf16(a1, qf[ds], p1, 0, 0, 0); }
    if (BIAS) {
#pragma unroll
        for (int g = 0; g < 4; ++g) {
            const f32x4 c0 = *(const LAS f32x4*)(ck + 8 * g + 4 * hi), c1 = *(const LAS f32x4*)(ck + 32 + 8 * g + 4 * hi);
#pragma unroll
            for (int i = 0; i < 4; i += 2) { const int r = 4 * g + i;
                const f32x2_ a2 = (f32x2_){p0[r], p0[r + 1]} * QK_C + (f32x2_){c0[i], c0[i + 1]}, b2 = (f32x2_){p1[r], p1[r + 1]} * QK_C + (f32x2_){c1[i], c1[i + 1]};
                p0[r] = a2.x; p0[r + 1] = a2.y; p1[r] = b2.x; p1[r + 1] = b2.y; }
        }
    }
    if (need_mask) {
        const unsigned nml = (unsigned)(kbase + 4 * hi - klo), range = (unsigned)(khi - klo);
#pragma unroll
        for (int r = 0; r < 16; ++r) { const unsigned c = (unsigned)((r & 3) + 8 * (r >> 2));
            if (nml + c > range) p0[r] = -INFINITY;
            if (nml + (c + 32u) > range) p1[r] = -INFINITY; }
    }
#define MX3(a, b, c) __builtin_fmaxf(__builtin_fmaxf((a), (b)), (c))
    float rm;
    { float ma = MX3(p0[0], p0[1], p1[0]), mb = MX3(p0[2], p0[3], p1[1]); ma = MX3(ma, p1[2], p1[3]);
#pragma unroll
      for (int r = 4; r < 16; r += 4) { ma = MX3(ma, p0[r], p0[r + 1]); mb = MX3(mb, p0[r + 2], p0[r + 3]); ma = MX3(ma, p1[r], p1[r + 1]); mb = MX3(mb, p1[r + 2], p1[r + 3]); }
      rm = __builtin_fmaxf(ma, mb); }
#undef MX3
    rm = fmaxf(rm, __shfl_xor(rm, 32));
    const float mnew = fmaxf(st.m, rm);
    const float SC = BIAS ? 1.0f : QK_C;
    const float alpha = __builtin_amdgcn_exp2f((st.m - mnew) * SC), nm = -mnew * SC;
    st.m = mnew;
    f32x2_ sum2 = {0.f, 0.f};
#pragma unroll
    for (int r = 0; r < 16; r += 2) {
        const f32x2_ a2 = BIAS ? (f32x2_){p0[r], p0[r + 1]} + nm : (f32x2_){p0[r], p0[r + 1]} * QK_C + nm, b2 = BIAS ? (f32x2_){p1[r], p1[r + 1]} + nm : (f32x2_){p1[r], p1[r + 1]} * QK_C + nm;
        p0[r] = __builtin_amdgcn_exp2f(a2.x); p0[r + 1] = __builtin_amdgcn_exp2f(a2.y); p1[r] = __builtin_amdgcn_exp2f(b2.x); p1[r + 1] = __builtin_amdgcn_exp2f(b2.y);
        sum2 += (f32x2_){p0[r], p0[r + 1]} + (f32x2_){p1[r], p1[r + 1]}; }
    st.l = st.l * alpha + (sum2.x + sum2.y);
#pragma unroll
    for (int r = 0; r < 16; ++r) { st.o0[r] *= alpha; st.o1[r] *= alpha; }
    const int sw0 = ((r32 >> 3) & 7) << 3, sw1 = (((32 + r32) >> 3) & 7) << 3;
#pragma unroll
    for (int T = 0; T < 2; ++T)
#pragma unroll
        for (int s = 0; s < 2; ++s) { const bf16x8 pf = pack8(T == 0 ? p0 : p1, s); const int kvb = 32 * T + 16 * s + 4 * hi;
            { const u32x2 lo = *(const LAS u32x2*)(Vt + r32 * KP + (kvb ^ sw0)), hh = *(const LAS u32x2*)(Vt + r32 * KP + ((kvb + 8) ^ sw0));
              const u32x4 v = {lo.x, lo.y, hh.x, hh.y}; st.o0 = __builtin_amdgcn_mfma_f32_32x32x16_bf16(__builtin_bit_cast(bf16x8, v), pf, st.o0, 0, 0, 0); }
            { const u32x2 lo = *(const LAS u32x2*)(Vt + (32 + r32) * KP + (kvb ^ sw1)), hh = *(const LAS u32x2*)(Vt + (32 + r32) * KP + ((kvb + 8) ^ sw1));
              const u32x4 v = {lo.x, lo.y, hh.x, hh.y}; st.o1 = __builtin_amdgcn_mfma_f32_32x32x16_bf16(__builtin_bit_cast(bf16x8, v), pf, st.o1, 0, 0, 0); }
        }
}
__device__ __forceinline__ void attn_init(AttnSt& st) {
#pragma unroll
    for (int r = 0; r < 16; ++r) { st.o0[r] = 0.f; st.o1[r] = 0.f; }
    st.m = -1e30f; st.l = 0.f;
}
__device__ __forceinline__ void attn_store(const AttnSt& st, float inv, bf16_t* orow, int hi) {
#pragma unroll
    for (int g = 0; g < 4; ++g) {
        u32x2 w0, w1; w0.x = cvtpk(st.o0[4 * g] * inv, st.o0[4 * g + 1] * inv); w0.y = cvtpk(st.o0[4 * g + 2] * inv, st.o0[4 * g + 3] * inv);
        w1.x = cvtpk(st.o1[4 * g] * inv, st.o1[4 * g + 1] * inv); w1.y = cvtpk(st.o1[4 * g + 2] * inv, st.o1[4 * g + 3] * inv);
        *(u32x2*)(orow + 8 * g + 4 * hi) = w0; *(u32x2*)(orow + 32 + 8 * g + 4 * hi) = w1; }
}
__device__ __forceinline__ void stage_k(LAS bf16_t* Ks, int lrow, int lch, const u32x4& kreg) { *(LAS u32x4*)(Ks + lrow * KP + lch * 8) = kreg; }
__device__ __forceinline__ void stage_v2(LAS bf16_t* Vt, int rp, int c4, const u32x2& va, const u32x2& vb) {
    const int sw = ((c4 >> 1) & 7) << 3;
#pragma unroll
    for (int j = 0; j < 4; ++j) { const unsigned a = va[j >> 1], c = vb[j >> 1];
        const unsigned w = (j & 1) ? ((a >> 16) | (c & 0xffff0000u)) : ((a & 0xffffu) | (c << 16));
        *(LAS unsigned*)(Vt + (4 * c4 + j) * KP + ((2 * rp) ^ sw)) = w; }
}

__device__ __forceinline__ void fox_unit(const bf16_t* PROJ_, const float* FL_, bf16_t* FOXO_, LAS unsigned char* lds, int b, int h, int qb, int tid, int lane, int wave) {
    const GAS bf16_t* PROJ = (const GAS bf16_t*)PROJ_; const GAS float* FL = (const GAS float*)FL_; GAS bf16_t* FOXO = (GAS bf16_t*)FOXO_;
    LAS bf16_t* Ks = (LAS bf16_t*)lds; LAS bf16_t* Vt = (LAS bf16_t*)(lds + 9216); LAS float* cum = (LAS float*)(lds + 36864); LAS float* wtot = (LAS float*)(lds + 36864 + 8192);
    const int r32 = lane & 31, hi = lane >> 5;
    const int q1 = (qb + 1) * 256;
    __syncthreads();
    {
        float v[4]; const int s0 = 4 * tid;
#pragma unroll
        for (int i = 0; i < 4; ++i) v[i] = (s0 + i < q1) ? FL[((size_t)b * SEQ + s0 + i) * 8 + h] * LOG2E : 0.f;
        v[1] += v[0]; v[2] += v[1]; v[3] += v[2];
        const float tot = v[3]; float inc = tot;
#pragma unroll
        for (int off = 1; off < 64; off <<= 1) { const float t = __shfl_up(inc, off); if (lane >= off) inc += t; }
        if (lane == 63) wtot[wave] = inc;
        __syncthreads();
        float base = 0.f;
        for (int w = 0; w < wave; ++w) base += wtot[w];
        const float ex = base + inc - tot;
#pragma unroll
        for (int i = 0; i < 4; ++i) cum[s0 + i] = -(ex + v[i]);
    }
    __syncthreads();
    const int qrow0 = qb * 256 + wave * 32, qpos = qrow0 + r32;
    bf16x8 qf[4];
    { const GAS bf16_t* qp = PROJ + ((size_t)b * SEQ + qpos) * LDP + COL_FQ + h * 64 + hi * 8;
#pragma unroll
      for (int ds = 0; ds < 4; ++ds) qf[ds] = *(const GAS bf16x8*)(qp + ds * 16); }
    const float cq = 0.f;
    AttnSt st; attn_init(st);
    const int NT = q1 / 64, lrow = tid >> 3, lch = tid & 7, rp = tid >> 4, c4 = tid & 15;
    const GAS bf16_t* kg = PROJ + ((size_t)b * SEQ + lrow) * LDP + COL_FK + h * 64 + lch * 8;
    const GAS bf16_t* vg = PROJ + ((size_t)b * SEQ + 2 * rp) * LDP + COL_FV + h * 64 + c4 * 4;
    u32x4 kreg = *(const GAS u32x4*)kg; u32x2 va = *(const GAS u32x2*)vg, vb = *(const GAS u32x2*)(vg + LDP);
    stage_k(Ks, lrow, lch, kreg); stage_v2(Vt, rp, c4, va, vb);
    if (NT > 1) { kreg = *(const GAS u32x4*)(kg + (size_t)64 * LDP); va = *(const GAS u32x2*)(vg + (size_t)64 * LDP); vb = *(const GAS u32x2*)(vg + (size_t)65 * LDP); }
    __syncthreads();
    for (int kt = 0; kt < NT; ++kt) {
        LAS bf16_t* Kc = Ks + (kt & 1) * 9216; LAS bf16_t* Vc = Vt + (kt & 1) * 9216; LAS bf16_t* Kn = Ks + ((kt + 1) & 1) * 9216; LAS bf16_t* Vn = Vt + ((kt + 1) & 1) * 9216;
        if (kt + 1 < NT) { stage_k(Kn, lrow, lch, kreg); stage_v2(Vn, rp, c4, va, vb); }
        if (kt + 2 < NT) { kreg = *(const GAS u32x4*)(kg + (size_t)(kt + 2) * 64 * LDP); va = *(const GAS u32x2*)(vg + (size_t)(kt + 2) * 64 * LDP); vb = *(const GAS u32x2*)(vg + ((size_t)(kt + 2) * 64 + 1) * LDP); }
        if (kt * 64 <= qrow0 + 31) attn_tile<true>(st, qf, Kc, Vc, r32, hi, cq, cum + kt * 64, 0, qpos, kt * 64, kt * 64 + 63 > qrow0);
        __syncthreads();
    }
    const float l = st.l + __shfl_xor(st.l, 32);
    attn_store(st, 1.0f / l, (bf16_t*)(FOXO + ((size_t)b * SEQ + qpos) * 384 + h * 64), hi);
}

__device__ __forceinline__ void dsa_unit(const bf16_t* PROJ_, bf16_t* DSAO_, float* LSE_, LAS unsigned char* lds, int b, int hp, int pat, int res, int n, int tid, int lane, int wave) {
    const int job = wave >> 2, jw = wave & 3, h = 2 * hp + job, jt = tid & 255, r32 = lane & 31, hi = lane >> 5;
    const int d = (pat == 0) ? 1 : (pat == 1 ? 4 : 16);
    const GAS bf16_t* PROJ = (const GAS bf16_t*)PROJ_; GAS bf16_t* DSAO = (GAS bf16_t*)DSAO_; GAS float* LSE = (GAS float*)LSE_;
    LAS bf16_t* Ks = (LAS bf16_t*)(lds + job * 36864); LAS bf16_t* Vt = (LAS bf16_t*)(lds + job * 36864 + 9216);
    __syncthreads();
    const int qi = jw * 32 + r32;
    const size_t trow = (size_t)b * SEQ + (size_t)(n * 128 + qi) * d + res;
    bf16x8 qf[4];
    { const GAS bf16_t* qp = PROJ + trow * LDP + COL_DQ + h * 64 + hi * 8;
#pragma unroll
      for (int ds = 0; ds < 4; ++ds) qf[ds] = *(const GAS bf16x8*)(qp + ds * 16); }
    AttnSt st; attn_init(st);
    const int kt0 = (n == 0) ? 2 : 0, lch = jt & 7, lrow = jt >> 3, rp = jt >> 4, c4 = jt & 15;
    const GAS bf16_t* kbase = PROJ + ((size_t)b * SEQ + res) * LDP + COL_DK + h * 64 + lch * 8;
    const GAS bf16_t* vbase = PROJ + ((size_t)b * SEQ + res) * LDP + COL_DV + h * 64 + c4 * 4;
    const long rstep = (long)d * LDP;
    const long mk0 = (long)(n - 1) * 128 + lrow, mv0 = (long)(n - 1) * 128 + 2 * rp;
    u32x4 kreg0, kreg1; u32x2 va0, vb0, va1, vb1;
#define DSA_LOAD(kt_) do { const long o0 = (mk0 + 64 * (kt_)) * rstep, o1 = o0 + 32 * rstep, p0 = (mv0 + 64 * (kt_)) * rstep, p1 = p0 + 32 * rstep; \
        kreg0 = *(const GAS u32x4*)(kbase + o0); kreg1 = *(const GAS u32x4*)(kbase + o1); \
        va0 = *(const GAS u32x2*)(vbase + p0); vb0 = *(const GAS u32x2*)(vbase + p0 + rstep); va1 = *(const GAS u32x2*)(vbase + p1); vb1 = *(const GAS u32x2*)(vbase + p1 + rstep); } while (0)
#define DSA_STAGE(K_, V_) do { stage_k(K_, lrow, lch, kreg0); stage_k(K_, lrow + 32, lch, kreg1); stage_v2(V_, rp, c4, va0, vb0); stage_v2(V_, rp + 16, c4, va1, vb1); } while (0)
    DSA_LOAD(kt0);
    DSA_STAGE(Ks + (kt0 & 1) * 9216, Vt + (kt0 & 1) * 9216);
    DSA_LOAD(kt0 + 1);
    __syncthreads();
    const int q0 = jw * 32;
    for (int kt = kt0; kt < 4; ++kt) {
        LAS bf16_t* Kc = Ks + (kt & 1) * 9216; LAS bf16_t* Vc = Vt + (kt & 1) * 9216;
        if (kt + 1 < 4) DSA_STAGE(Ks + ((kt + 1) & 1) * 9216, Vt + ((kt + 1) & 1) * 9216);
        if (kt + 2 < 4) DSA_LOAD(kt + 2);
        const int k0 = 64 * kt;
        if (k0 + 63 >= q0 && k0 <= q0 + 31 + 128) {
            const bool allv = (k0 >= q0 + 31) && (k0 + 63 <= q0 + 128);
            attn_tile<false>(st, qf, Kc, Vc, r32, hi, 0.f, (const LAS float*)lds, qi, qi + 128, k0, !allv);
        }
        __syncthreads();
    }
#undef DSA_LOAD
#undef DSA_STAGE
    const float l = st.l + __shfl_xor(st.l, 32);
    attn_store(st, 1.0f / l, (bf16_t*)(DSAO + ((size_t)pat * M + trow) * 384 + h * 64), hi);
    if (hi == 0) LSE[((size_t)pat * M + trow) * 8 + h] = st.m * QK_C + __log2f(l);
}

__device__ __forceinline__ void merge_row(const bf16_t* SSMO, const bf16_t* DSAO, const float* LSE, const bf16_t* FOXO, const float* gm, bf16_t* OUT, size_t m, int lane) {
    float v[16];
    if (lane < 16) {
#pragma unroll
        for (int i = 0; i < 16; ++i) v[i] = 0.f;
    } else if (lane < 40) {
        const int c0 = 16 * lane - 256, h = c0 >> 6;
        const GAS float* LSEg = (const GAS float*)LSE; const float l0 = LSEg[(0 * (size_t)M + m) * 8 + h], l1 = LSEg[(1 * (size_t)M + m) * 8 + h], l2 = LSEg[(2 * (size_t)M + m) * 8 + h];
        const float mx = fmaxf(l0, fmaxf(l1, l2));
        float w0 = __builtin_amdgcn_exp2f(l0 - mx), w1 = __builtin_amdgcn_exp2f(l1 - mx), w2 = __builtin_amdgcn_exp2f(l2 - mx);
        const float inv = 1.0f / (w0 + w1 + w2); w0 *= inv; w1 *= inv; w2 *= inv;
#pragma unroll
        for (int i = 0; i < 16; ++i) v[i] = 0.f;
#pragma unroll
        for (int p = 0; p < 3; ++p) { const float w = (p == 0) ? w0 : (p == 1 ? w1 : w2); const GAS bf16_t* src = (const GAS bf16_t*)DSAO + ((size_t)p * M + m) * 384 + c0;
            const u32x4 a = *(const GAS u32x4*)src, c = *(const GAS u32x4*)(src + 8);
#pragma unroll
            for (int i = 0; i < 4; ++i) { v[2 * i] += w * bflo(a[i]); v[2 * i + 1] += w * bfhi(a[i]); v[8 + 2 * i] += w * bflo(c[i]); v[8 + 2 * i + 1] += w * bfhi(c[i]); } }
    } else {
        const int c0 = 16 * lane - 640;
        const u32x4 a = *(const GAS u32x4*)((const GAS bf16_t*)FOXO + m * 384 + c0), c = *(const GAS u32x4*)((const GAS bf16_t*)FOXO + m * 384 + c0 + 8);
#pragma unroll
        for (int i = 0; i < 4; ++i) { v[2 * i] = bflo(a[i]); v[2 * i + 1] = bfhi(a[i]); v[8 + 2 * i] = bflo(c[i]); v[8 + 2 * i + 1] = bfhi(c[i]); }
    }
    float ss = 0.f;
#pragma unroll
    for (int i = 0; i < 16; ++i) ss += v[i] * v[i];
    const int seg = (lane < 16) ? 0 : (lane < 40 ? 1 : 2);
    const float s0 = wave_sum(seg == 0 ? ss : 0.f), s1 = wave_sum(seg == 1 ? ss : 0.f), s2 = wave_sum(seg == 2 ? ss : 0.f);
    const float rs = (seg == 0) ? 1.0f / sqrtf(s0 * (1.0f / 256.0f) + EPS) : (seg == 1) ? 1.0f / sqrtf(s1 * (1.0f / 384.0f) + EPS) : 1.0f / sqrtf(s2 * (1.0f / 384.0f) + EPS);
    u32x4 o0, o1;
#pragma unroll
    for (int i = 0; i < 4; ++i) { const f32x4 g = *(const GAS f32x4*)((const GAS float*)gm + 16 * lane + 4 * i);
        const unsigned lo = cvtpk(v[4 * i] * rs * g[0], v[4 * i + 1] * rs * g[1]), hh = cvtpk(v[4 * i + 2] * rs * g[2], v[4 * i + 3] * rs * g[3]);
        if (i < 2) { o0[2 * i] = lo; o0[2 * i + 1] = hh; } else { o1[2 * (i - 2)] = lo; o1[2 * (i - 2) + 1] = hh; } }
    if (lane >= 16) { *(GAS u32x4*)((GAS bf16_t*)OUT + m * 1024 + 16 * lane) = o0; *(GAS u32x4*)((GAS bf16_t*)OUT + m * 1024 + 16 * lane + 8) = o1; }
}
template <int PH> __device__ __forceinline__ void run_phase(const Params& P, const int l, LAS unsigned char* lds, const int wave0, const int umax = 1 << 30) {
    constexpr size_t WS_PRM = 58 * MiB; constexpr int PRM_L = 8192, PR_GPOST = 0, PR_GPREF = 1024, PR_GPOSTF = 2048, PR_GMIX = 3072, PR_GPRE = 4096, PR_BGLU = 5120, PR_SD = 5376, PR_BF = 5632;
#define WSBASE() unsigned char* ws = P.ws; asm volatile("" : "+s"(ws)); float* const Pout = P.out; const float* const Px = P.in[I_X]; (void)Pout; (void)Px; int wave_s = wave0; asm volatile("" : "+s"(wave_s)); int lane_v; asm volatile("v_mbcnt_lo_u32_b32 %0, -1, 0\n\tv_mbcnt_hi_u32_b32 %0, -1, %0" : "=v"(lane_v)); const int tid = wave_s * 64 + lane_v; int bid = blockIdx.x; asm volatile("" : "+s"(bid)); int G = gridDim.x; asm volatile("" : "+s"(G)); const int lane = lane_v, wave = wave_s, gw = bid * 8 + wave, NGW = G * 8; (void)lane; (void)gw; (void)NGW
    if constexpr (PH == 0) {
    {
        WSBASE();
        bf16_t* WinT = (bf16_t*)(ws + WS_WIN); bf16_t* WoutT = (bf16_t*)(ws + WS_WOUT); bf16_t* WguT = (bf16_t*)(ws + WS_WGU); bf16_t* WdnT = (bf16_t*)(ws + WS_WDN); bf16_t* WgluT = (bf16_t*)(ws + WS_WGLU);
        float* ABAR = (float*)(ws + WS_ABAR); bf16_t* BB = (bf16_t*)(ws + WS_BB); bf16_t* CC = (bf16_t*)(ws + WS_CC); float* PRM = (float*)(ws + WS_PRM);
        LAS float* scr = (LAS float*)(lds + wave * 16384);
        constexpr int I_IN = 16 * 88, I_OUT = 16 * 32, I_GU = 16 * 176, I_DN = 44 * 32, I_GL = 4 * 8, I_ALL = I_IN + I_OUT + I_GU + I_DN + I_GL;
        for (int it = gw; it < 2 * I_ALL; it += NGW) {
            const int l = it / I_ALL; int r = it % I_ALL;
            if (r < I_IN) { const int kb = r / 88, nb = r % 88; tr_item(P.in[I_WIN] + (size_t)l * 1024 * NIN, 1024, NIN, WinT + (size_t)l * NINP * 1024, 64 * kb, 32 * nb, 32 * nb, scr, lane); continue; } r -= I_IN;
            if (r < I_OUT) { const int kb = r / 32, nb = r % 32; tr_item(P.in[I_WOUT] + (size_t)l * 1024 * 1024, 1024, 1024, WoutT + (size_t)l * 1024 * 1024, 64 * kb, 32 * nb, 32 * nb, scr, lane); continue; } r -= I_OUT;
            if (r < I_GU) { const int kb = r / 176, nb = r % 176, c0 = 32 * nb, half = (c0 >= DFF) ? 1 : 0, cc = c0 - half * DFF, dr = 256 * (cc / 128) + 128 * half + (cc % 128);
                tr_item(P.in[I_WGU] + (size_t)l * 1024 * NGU, 1024, NGU, WguT + (size_t)l * NGU * 1024, 64 * kb, c0, dr, scr, lane); continue; } r -= I_GU;
            if (r < I_DN) { const int kb = r / 32, nb = r % 32; tr_item(P.in[I_WDN] + (size_t)l * DFF * 1024, DFF, 1024, WdnT + (size_t)l * 1024 * DFF, 64 * kb, 32 * nb, 32 * nb, scr, lane); continue; } r -= I_DN;
            { const int kb = r / 8, nb = r % 8; tr_item(P.in[I_WGLU] + (size_t)l * 256 * 256, 256, 256, WgluT + (size_t)l * 256 * 256, 64 * kb, 32 * nb, 32 * nb, scr, lane); }
        }
        for (int e = bid * 512 + tid; e < 2 * 16 * 64; e += G * 512) {
            const int lg = e >> 6, p = e & 63;
            const float dt = expf(P.in[I_LDT][lg]), ar = P.in[I_ARE][e], ai = P.in[I_AIM][e];
            const float decay = expf(ar * dt); float sn, cs; sincos_rr(ai * dt, sn, cs);
            const float are = decay * cs, aim = decay * sn, mag2 = ar * ar + ai * ai;
            const float cre = ((are - 1.0f) * ar + aim * ai) / mag2, cim = (aim * ar - (are - 1.0f) * ai) / mag2;
            ABAR[2 * e] = are; ABAR[2 * e + 1] = aim;
            for (int c = 0; c < 16; ++c) { const float br = P.in[I_BRE][(size_t)e * 16 + c], bi = P.in[I_BIM][(size_t)e * 16 + c];
                BB[((size_t)lg * 128 + p) * 16 + c] = (bf16_t)(cvtpk(cre * br - cim * bi, 0.f) & 0xffffu);
                BB[((size_t)lg * 128 + 64 + p) * 16 + c] = (bf16_t)(cvtpk(cre * bi + cim * br, 0.f) & 0xffffu);
                *(unsigned*)(CC + ((size_t)lg * 16 + c) * 128 + 2 * p) = cvtpk(P.in[I_CRE][((size_t)lg * 16 + c) * 64 + p], -P.in[I_CIM][((size_t)lg * 16 + c) * 64 + p]); }
        }
        for (int e = bid * 512 + tid; e < 2 * 1024; e += G * 512) { const int l = e >> 10, c = e & 1023; float* pr = PRM + l * PRM_L;
            pr[PR_GPOST + c] = P.in[I_GPOST][e]; pr[PR_GPREF + c] = P.in[I_GPREF][e]; pr[PR_GPOSTF + c] = P.in[I_GPOSTF][e]; pr[PR_GMIX + c] = P.in[I_GMIX][e]; pr[PR_GPRE + c] = P.in[I_GPRE][e];
            if (c < 256) { pr[PR_BGLU + c] = P.in[I_BGLU][l * 256 + c]; pr[PR_SD + c] = P.in[I_SD][l * 256 + c]; }
            if (c < 8) pr[PR_BF + c] = (c < 6) ? P.in[I_BF][l * 6 + c] : 0.f; }
        row_phase<false, 0, 2>(Px, nullptr, (float*)(ws + 60 * MiB), (const bf16_t*)(ws + WS_BUFB), nullptr, nullptr, P.in[I_GPRE], (bf16_t*)(ws + WS_BUFA), gw, NGW, lane);
    }
    }
    if constexpr (PH == 1) {
        { WSBASE(); pg8::Gemm g{(bf16_t*)(ws + WS_BUFA), (bf16_t*)(ws + WS_WIN) + (size_t)l * NINP * 1024, M, NINP, 1024}; pg8::StaticOrder S; S.init(M, NINP, G, bid);
          pg8::EpiProj E{(bf16_t*)(ws + WS_PROJ), (float*)(ws + WS_FL), (const float*)(ws + WS_PRM) + l * PRM_L + PR_BF};
          pg8::gemm_phase<pg8::EpiProj, pg8::StaticOrder, true, true>(lds, g, S, E, wave); }
    }
    if constexpr (PH == 2) {
        {
            WSBASE();
            const bf16_t* PROJ = (const bf16_t*)(ws + WS_PROJ); float* FL = (float*)(ws + WS_FL);
            constexpr int NU_SSM = 64, NU_FOX = NB * 6 * 8, NU_DSA = NB * 3 * 48;
            unsigned* qctr = (unsigned*)(ws + WS_CTL) + 64 * l; LAS int* uq = (LAS int*)(lds + LDS_BYTES - 64);
#ifdef STATIC_Q
            (void)qctr; (void)uq;
            for (int u = bid; u < NU_SSM + NU_FOX + NU_DSA; u += G) {
#else
            for (;;) {
                __syncthreads();
                if (tid == 0) *uq = (int)__hip_atomic_fetch_add(qctr, 1u, __ATOMIC_RELAXED, __HIP_MEMORY_SCOPE_AGENT);
                __syncthreads();
                const int u = __builtin_amdgcn_readfirstlane(*uq);
                if (u >= NU_SSM + NU_FOX + NU_DSA || u >= umax) break;
#endif
                if (u < NU_SSM) { const int wu = u * 8 + wave;
                    ssm_wave(PROJ, (const float*)(ws + WS_ABAR) + (size_t)l * 16 * 64 * 2, (const bf16_t*)(ws + WS_BB) + (size_t)l * 16 * 128 * 16, (const bf16_t*)(ws + WS_CC) + (size_t)l * 16 * 16 * 128,
                             (const float*)(ws + WS_PRM) + l * PRM_L + PR_SD, (bf16_t*)(ws + WS_G), lds + wave * SSM_WAVE_LDS, wu >> 4, wu & 15, lane);
                } else if (u < NU_SSM + NU_FOX) { const int v = u - NU_SSM, qb = 7 - v / 192, bh = v % 192;
                    fox_unit(PROJ, FL, (bf16_t*)(ws + WS_FOXO), lds, bh / 6, bh % 6, qb, tid, lane, wave);
                } else { const int v = u - NU_SSM - NU_FOX, b = v / 144, rem = v % 144, hp = rem / 48, j = rem % 48, pat = j >> 4, jj = j & 15;
                    const int res = (pat == 0) ? 0 : (pat == 1 ? (jj & 3) : jj), n = (pat == 0) ? jj : (pat == 1 ? (jj >> 2) : 0);
                    dsa_unit(PROJ, (bf16_t*)(ws + WS_DSAO), (float*)(ws + WS_LSE), lds, b, hp, pat, res, n, tid, lane, wave);
                }
            }
        }
    }
    if constexpr (PH == 3) {
        { WSBASE(); int kglu = 256; asm volatile("" : "+s"(kglu)); pg8::Gemm g{(bf16_t*)(ws + WS_G), (bf16_t*)(ws + WS_WGLU) + (size_t)l * 256 * 256, M, 256, kglu}; pg8::StaticOrder S; S.init(M, 256, G, bid);
          pg8::EpiGLUNorm E{(bf16_t*)(ws + WS_G), (bf16_t*)(ws + WS_PROJ), (const float*)(ws + WS_PRM) + l * PRM_L + PR_BGLU, (const float*)(ws + WS_PRM) + l * PRM_L + PR_GMIX};
          pg8::gemm_phase<pg8::EpiGLUNorm, pg8::StaticOrder, false, true>(lds, g, S, E, wave);
          bf16_t* d_ = (bf16_t*)(ws + WS_DSAO); float* e_ = (float*)(ws + WS_LSE); bf16_t* f_ = (bf16_t*)(ws + WS_FOXO); const float* g_ = (const float*)(ws + WS_PRM) + l * PRM_L + PR_GMIX; bf16_t* o_ = (bf16_t*)(ws + WS_PROJ);
          for (int m = gw; m < M; m += 8 * NGW) {
#pragma unroll
            for (int r = 0; r < 8; ++r) if (m + r * NGW < M) merge_row(nullptr, d_, e_, f_, g_, o_, (size_t)(m + r * NGW), lane); } }
    }
    if constexpr (PH == 4) {
    }
    if constexpr (PH == 5) {
        { WSBASE(); const bool second = (umax == 1);
          int kk = second ? DFF : 1024; asm volatile("" : "+s"(kk));
          const bf16_t* bt = second ? (const bf16_t*)(ws + WS_WDN) + (size_t)l * 1024 * DFF : (const bf16_t*)(ws + WS_WOUT) + (size_t)l * 1024 * 1024;
          pg8::Gemm g{(bf16_t*)(ws + WS_PROJ), bt, M, 1024, kk}; pg8::StaticOrder S; S.init(M, 1024, G, bid);
          pg8::EpiBf16<0> E{(bf16_t*)(ws + WS_BUFB), 1024, nullptr, 0, 0, 1.f};
          pg8::gemm_phase<pg8::EpiBf16<0>, pg8::StaticOrder, true, true>(lds, g, S, E, wave); }
    }
    if constexpr (PH == 6) {
        { WSBASE(); const float* xin = (l == 0) ? Px : Pout; const float* pr = (const float*)(ws + WS_PRM) + l * PRM_L;
          (void)xin; float* rn = (float*)(ws + 60 * MiB);
          row_phase<true, 2, 2>((const bf16_t*)(ws + WS_BUFA), pr + PR_GPRE, rn, (const bf16_t*)(ws + WS_BUFB), pr + PR_GPOST, nullptr, pr + PR_GPREF, (bf16_t*)(ws + WS_BUFA), gw, NGW, lane); }
    }
    if constexpr (PH == 7) {
        { WSBASE(); pg8::Gemm g{(bf16_t*)(ws + WS_BUFA), (bf16_t*)(ws + WS_WGU) + (size_t)l * NGU * 1024, M, NGU, 1024}; pg8::StaticOrder S; S.init(M, NGU, G, bid);
          pg8::EpiSwiGLU E{(bf16_t*)(ws + WS_PROJ)};
          pg8::gemm_phase<pg8::EpiSwiGLU, pg8::StaticOrder, true, true>(lds, g, S, E, wave); }
    }
    if constexpr (PH == 8) {
        { WSBASE(); pg8::Gemm g{(bf16_t*)(ws + WS_PROJ), (bf16_t*)(ws + WS_WDN) + (size_t)l * 1024 * DFF, M, 1024, DFF}; pg8::StaticOrder S; S.init(M, 1024, G, bid);
          pg8::EpiBf16<0> E{(bf16_t*)(ws + WS_BUFB), 1024, nullptr, 0, 0, 1.f};
          pg8::gemm_phase<pg8::EpiBf16<0>, pg8::StaticOrder, true, true>(lds, g, S, E, wave); }
    }
    if constexpr (PH == 9) {
        { WSBASE(); const float* pr = (const float*)(ws + WS_PRM);
          float* rn = (float*)(ws + 60 * MiB); const bf16_t* xnb = (const bf16_t*)(ws + WS_BUFA);
          if (l == 0) row_phase<true, 2, 2>(xnb, pr + l * PRM_L + PR_GPREF, rn, (const bf16_t*)(ws + WS_BUFB), pr + l * PRM_L + PR_GPOSTF, nullptr, pr + PRM_L + PR_GPRE, (bf16_t*)(ws + WS_BUFA), gw, NGW, lane);
          else row_phase<true, 2, 0>(xnb, pr + l * PRM_L + PR_GPREF, rn, (const bf16_t*)(ws + WS_BUFB), pr + l * PRM_L + PR_GPOSTF, Pout, pr + PRM_L + PR_GPRE, nullptr, gw, NGW, lane); }
    }
#undef WSBASE
}

template <int PH> __global__ void __launch_bounds__(512, 2) phase_k(Params P, int l) {
    extern __shared__ __attribute__((aligned(16))) unsigned char lds_raw[];
    const int wave0 = __builtin_amdgcn_readfirstlane(threadIdx.x >> 6);
    run_phase<PH>(P, l, (LAS unsigned char*)lds_raw, wave0);
}
#ifdef MEGA
__global__ void __launch_bounds__(512, 2) mega(Params P) {
    extern __shared__ __attribute__((aligned(16))) unsigned char lds_raw[];
    LAS unsigned char* lds = (LAS unsigned char*)lds_raw;
    const int wave0 = __builtin_amdgcn_readfirstlane(threadIdx.x >> 6);
    volatile LAS unsigned* bst = (volatile LAS unsigned*)(lds + LDS_BYTES - 32);
    if (threadIdx.x < 2) bst[threadIdx.x] = 0u;
    __syncthreads();
    unsigned* barw; { GAS unsigned char* wsg_ = (GAS unsigned char*)P.ws; barw = (unsigned*)(unsigned char*)(wsg_ + WS_CTL) + 4096; }
    XcdBarrier xb = xcd_barrier_post(barw, bst, (int)threadIdx.x);
#define GRIDBAR() do { int lane_b; asm volatile("v_mbcnt_lo_u32_b32 %0, -1, 0\n\tv_mbcnt_hi_u32_b32 %0, -1, %0" : "=v"(lane_b)); xcd_barrier(xb, wave0 * 64 + lane_b); } while (0)
    cg::this_grid().sync();
    run_phase<0>(P, 0, lds, wave0);
    GRIDBAR();
    const int tidz = (int)(blockIdx.x * 512 + threadIdx.x); (void)tidz;
#pragma unroll 1
    for (int hl = 0; hl < 4; ++hl) {
        const int l = hl >> 1, second = hl & 1;
        if (!second) {
            run_phase<1>(P, l, lds, wave0); GRIDBAR();
            run_phase<2>(P, l, lds, wave0); GRIDBAR();
            run_phase<3>(P, l, lds, wave0); GRIDBAR();
        } else {
            run_phase<7>(P, l, lds, wave0); GRIDBAR();
        }
        run_phase<5>(P, l, lds, wave0, second); GRIDBAR();
        if (!second) { run_phase<6>(P, l, lds, wave0); GRIDBAR(); }
        else { run_phase<9>(P, l, lds, wave0); if (hl != 3) GRIDBAR(); }
    }
#undef GRIDBAR
}
#endif


__global__ void dbg_copy(const bf16_t* src, float* out, int ld, int ncol, int planes = 1) {
    const size_t m = blockIdx.x;
    for (int c = threadIdx.x; c < 1024; c += blockDim.x) { float a = 0.f; for (int pl = 0; pl < planes; ++pl) for (int k = c; k < ncol; k += 1024) a += bf2f(src[((size_t)pl * M + m) * ld + k]); out[m * 1024 + c] = a; }
}
__global__ void dbg_prm(const unsigned char* ws, float* out) {
    const int i = blockIdx.x * blockDim.x + threadIdx.x;
    if (i < 4096) out[i] = ((const float*)(ws + WS_ABAR))[i];
    else if (i < 4096 + 65536) out[i] = bf2f(((const bf16_t*)(ws + WS_BB))[i - 4096]);
    else if (i < 4096 + 131072) out[i] = bf2f(((const bf16_t*)(ws + WS_CC))[i - 4096 - 65536]);
    else if (i < 4096 + 131072 + 16384) out[i] = ((const float*)(ws + 58 * MiB))[i - 4096 - 131072];
}
template <int PH> static void launch_phase(const Params& p, int l, int grid, hipStream_t stream) {
    static bool attr = false;
    if (!attr) { (void)hipFuncSetAttribute((const void*)phase_k<PH>, hipFuncAttributeMaxDynamicSharedMemorySize, LDS_BYTES); attr = true; }
    hipLaunchKernelGGL(phase_k<PH>, dim3(grid), dim3(512), LDS_BYTES, stream, p, l);
}
extern "C" void kernel_launch(void* const* d_in, const int* in_sizes, int n_in, void* d_out, int out_size, void* d_ws, size_t ws_size, hipStream_t stream) {
    static int grid = 0;
    if (grid == 0) {
        if (n_in != 21 || in_sizes[0] != M * DM || out_size != M * DM || ws_size < WS_END) { fprintf(stderr, "kernel_launch: unexpected shapes: n_in %d in0 %d out %d ws %zu\n", n_in, n_in > 0 ? in_sizes[0] : -1, out_size, ws_size); grid = -1; return; }
        int dev = 0, cus = 0, per_cu = 1;
        (void)hipGetDevice(&dev); (void)hipDeviceGetAttribute(&cus, hipDeviceAttributeMultiprocessorCount, dev);
#ifdef MEGA
        if (hipFuncSetAttribute((const void*)mega, hipFuncAttributeMaxDynamicSharedMemorySize, LDS_BYTES) != hipSuccess) { fprintf(stderr, "kernel_launch: hipFuncSetAttribute failed\n"); grid = -1; return; }
        if (hipOccupancyMaxActiveBlocksPerMultiprocessor(&per_cu, (const void*)mega, 512, LDS_BYTES) != hipSuccess || per_cu < 1) { fprintf(stderr, "kernel_launch: occupancy query says %d\n", per_cu); per_cu = 1; }
        (void)hipGetLastError();
#endif
        grid = cus * per_cu;
    }
    if (grid < 0) return;
    if (hipMemsetAsync((char*)d_ws + WS_CTL, 0, 65536, stream) != hipSuccess) { fprintf(stderr, "kernel_launch: memset failed\n"); return; }
    Params p{};
    for (int i = 0; i < 21; ++i) p.in[i] = (const float*)d_in[i];
    p.out = (float*)d_out; p.ws = (unsigned char*)d_ws;
#ifdef MEGA
    void* args[] = {&p};
    hipError_t e = hipLaunchCooperativeKernel((const void*)mega, dim3(grid), dim3(512), args, LDS_BYTES, stream);
    if (e != hipSuccess) fprintf(stderr, "kernel_launch: cooperative launch failed: %s (grid %d)\n", hipGetErrorString(e), grid);
#else
    launch_phase<0>(p, 0, grid, stream);
#if defined(DBG_STOP) && DBG_STOP == 100
    hipLaunchKernelGGL(dbg_prm, dim3(640), dim3(256), 0, stream, (const unsigned char*)d_ws, (float*)d_out); return;
#endif
    for (int l = 0; l < 2; ++l) {
#if defined(DBG_STOP) && DBG_STOP == 1
        launch_phase<1>(p, l, grid, stream); hipLaunchKernelGGL(dbg_copy, dim3(M), dim3(256), 0, stream, (const bf16_t*)((unsigned char*)d_ws + WS_PROJ), (float*)d_out, LDP, LDP); return;
#endif
#if defined(DBG_STOP) && DBG_STOP == 21
        launch_phase<1>(p, l, grid, stream); launch_phase<2>(p, l, grid, stream); hipLaunchKernelGGL(dbg_copy, dim3(M), dim3(256), 0, stream, (const bf16_t*)((unsigned char*)d_ws + WS_FOXO), (float*)d_out, 384, 384, 1); return;
#endif
#if defined(DBG_STOP) && DBG_STOP == 22
        launch_phase<1>(p, l, grid, stream); launch_phase<2>(p, l, grid, stream); hipLaunchKernelGGL(dbg_copy, dim3(M), dim3(256), 0, stream, (const bf16_t*)((unsigned char*)d_ws + WS_DSAO), (float*)d_out, 384, 384, 3); return;
#endif
#if defined(DBG_STOP) && DBG_STOP == 23
        launch_phase<1>(p, l, grid, stream); launch_phase<2>(p, l, grid, stream); hipLaunchKernelGGL(dbg_copy, dim3(M), dim3(256), 0, stream, (const bf16_t*)((unsigned char*)d_ws + WS_G), (float*)d_out, 256, 256, 1); return;
#endif
#if defined(DBG_STOP) && DBG_STOP == 4
        launch_phase<1>(p, l, grid, stream); launch_phase<2>(p, l, grid, stream); launch_phase<3>(p, l, grid, stream); launch_phase<4>(p, l, grid, stream);
        hipLaunchKernelGGL(dbg_copy, dim3(M), dim3(256), 0, stream, (const bf16_t*)((unsigned char*)d_ws + WS_BUFA), (float*)d_out, 1024, 1024); return;
#endif
        launch_phase<1>(p, l, grid, stream); launch_phase<2>(p, l, grid, stream); launch_phase<3>(p, l, grid, stream); launch_phase<4>(p, l, grid, stream); launch_phase<5>(p, l, grid, stream);
        launch_phase<6>(p, l, grid, stream); launch_phase<7>(p, l, grid, stream); launch_phase<8>(p, l, grid, stream); launch_phase<9>(p, l, grid, stream);
    }
#endif
}
```
